# Optimizing an MI355X kernel written in HIP

```python
import math
import jax, jax.numpy as jnp
from jax import lax
import numpy as np

D_MODEL = 1024
BATCH = 2
SEQ = 8192
DEPTH = 2

GRID_W = 64
CTX_LEN = 256
HEAD_DIM = 64
ROPE_THETA = 10000.0
RMS_EPS = 1e-6
NEG_INF = -1e30
BLOCK = 128
A_HQ = 8
A_HKV = 2
A_GROUP = A_HQ // A_HKV
WINDOW = 128
B_H = 4
B_HD = HEAD_DIM
B_VD = 2 * HEAD_DIM
C_H = 4
C_DK = 128
C_DV = 128
CHUNK = 64
N_BRANCH = 3
BRANCH_W = 512
A_Q_W = A_HQ * HEAD_DIM
A_KV_W = A_HKV * HEAD_DIM
B_QK_W = B_H * 2 * B_HD
B_V_W = B_H * B_VD
C_K_W = C_H * C_DK
C_V_W = C_H * C_DV
GATE_W = N_BRANCH * D_MODEL
SPLITS = (A_Q_W, A_KV_W, A_KV_W, B_QK_W, B_QK_W, B_V_W, C_K_W, C_V_W, C_K_W, C_K_W, C_V_W, GATE_W)
IN_W = sum(SPLITS)
SPLIT_IDX = tuple(int(v) for v in np.cumsum(SPLITS)[:-1])
N_EXPERTS = 32
TOP_K = 4
EXPERT_FF = D_MODEL
SWIGLU_LIMIT = 7.0
SWIGLU_ALPHA = 1.702
MOE_BLOCK = 128

kernel_name = "hybrid_diffusion_gqa_diff_hgrn2_moe"


def rms_norm(x, g):
    xf = x.astype(jnp.float32)
    y = xf * lax.rsqrt(jnp.mean(xf * xf, axis=-1, keepdims=True) + RMS_EPS)
    return (y * g.astype(jnp.float32)).astype(x.dtype)


def modulate(x, g, shift, scale):
    return rms_norm(x, g) * (1 + scale[:, None, :]) + shift[:, None, :]


def axial_rope_tables(rows, dtype):
    row = jnp.repeat(jnp.arange(rows, dtype=jnp.float32), GRID_W)
    col = jnp.tile(jnp.arange(GRID_W, dtype=jnp.float32), rows)
    n_freq = HEAD_DIM // 4
    inv = ROPE_THETA ** (-jnp.arange(n_freq, dtype=jnp.float32) / n_freq)
    ang_r = row[:, None] * inv
    ang_c = col[:, None] * inv
    return (jnp.cos(ang_r).astype(dtype), jnp.sin(ang_r).astype(dtype),
            jnp.cos(ang_c).astype(dtype), jnp.sin(ang_c).astype(dtype))


def apply_axial_rope(x, tabs):
    cos_r, sin_r, cos_c, sin_c = tabs
    n = HEAD_DIM // 4
    half = HEAD_DIM // 2
    shape = (1, x.shape[1]) + (1,) * (x.ndim - 3) + (n,)

    def rot(xa, cos, sin):
        cos = cos.reshape(shape)
        sin = sin.reshape(shape)
        x1, x2 = xa[..., :n], xa[..., n:]
        return jnp.concatenate([x1 * cos - x2 * sin, x2 * cos + x1 * sin], axis=-1)

    return jnp.concatenate([rot(x[..., :half], cos_r, sin_r), rot(x[..., half:], cos_c, sin_c)], axis=-1)


def window_gqa_latent(q, k, v, kc, vc, sink):
    B, S = q.shape[:2]
    L = kc.shape[1]
    nb = S // BLOCK
    scale = HEAD_DIM ** -0.5
    qb = q.reshape(B, nb, BLOCK, A_HKV, A_GROUP, HEAD_DIM)

    def band(t):
        tp = jnp.pad(t, ((0, 0), (BLOCK, BLOCK), (0, 0), (0, 0))).reshape(B, nb + 2, BLOCK, A_HKV, HEAD_DIM)
        return jnp.concatenate([tp[:, :-2], tp[:, 1:-1], tp[:, 2:]], axis=2)

    kw, vw = band(k), band(v)
    s_loc = jnp.einsum('bnqhgd,bnkhd->bnhgqk', qb, kw).astype(jnp.float32) * scale
    s_ctx = jnp.einsum('bnqhgd,blhd->bnhgql', qb, kc).astype(jnp.float32) * scale
    qi = jnp.arange(BLOCK)[:, None]
    kj = jnp.arange(3 * BLOCK)[None, :]
    rel = kj - BLOCK - qi
    kpos = jnp.arange(nb)[:, None, None] * BLOCK + kj[None] - BLOCK
    valid = (jnp.abs(rel) <= WINDOW)[None] & (kpos >= 0) & (kpos < S)
    s_loc = jnp.where(valid[None, :, None, None], s_loc, NEG_INF)
    s_sink = jnp.broadcast_to(sink.astype(jnp.float32).reshape(1, 1, A_HKV, A_GROUP, 1, 1), s_loc.shape[:-1] + (1,))
    p = jax.nn.softmax(jnp.concatenate([s_loc, s_ctx, s_sink], axis=-1), axis=-1).astype(v.dtype)
    o = (jnp.einsum('bnhgqk,bnkhd->bnqhgd', p[..., :3 * BLOCK], vw)
         + jnp.einsum('bnhgql,blhd->bnqhgd', p[..., 3 * BLOCK:3 * BLOCK + L], vc))
    return o.reshape(B, S, A_Q_W)


def sink_attn_context(qc, kc, vc, sink):
    B, L = qc.shape[:2]
    qg = qc.reshape(B, L, A_HKV, A_GROUP, HEAD_DIM)
    s = jnp.einsum('blhgd,bmhd->bhglm', qg, kc).astype(jnp.float32) * HEAD_DIM ** -0.5
    s_sink = jnp.broadcast_to(sink.astype(jnp.float32).reshape(1, A_HKV, A_GROUP, 1, 1), s.shape[:-1] + (1,))
    p = jax.nn.softmax(jnp.concatenate([s, s_sink], axis=-1), axis=-1)[..., :L].astype(vc.dtype)
    return jnp.einsum('bhglm,bmhd->blhgd', p, vc).reshape(B, L, A_Q_W)


def diff_attend(q, keys, vals, lam):
    s = jnp.einsum('bqhcd,bkhcd->bhcqk', q, keys).astype(jnp.float32) * B_HD ** -0.5
    p = jax.nn.softmax(s, axis=-1)
    a = (p[:, :, 0] - lam * p[:, :, 1]).astype(vals.dtype)
    return jnp.einsum('bhqk,bkhe->bqhe', a, vals)


def diff_attn_latent(q, k, v, kc, vc, lam):
    B, S = q.shape[:2]
    nb = S // BLOCK
    keys = jnp.concatenate([k, kc], axis=1)
    vals = jnp.concatenate([v, vc], axis=1)
    qb = jnp.moveaxis(q.reshape(B, nb, BLOCK, B_H, 2, B_HD), 1, 0)
    o = lax.map(lambda qq: diff_attend(qq, keys, vals, lam), qb)
    return jnp.moveaxis(o, 0, 1).reshape(B, S, B_H, B_VD)


def diff_head_out(o, w, lam_init):
    B, T = o.shape[:2]
    return (rms_norm(o, w) * (1 - lam_init)).reshape(B, T, B_V_W)


def hgrn2_log_forget(z, lb):
    lbf = lb.astype(jnp.float32)
    return jnp.logaddexp(jnp.log(lbf), jnp.log1p(-lbf) + jax.nn.log_sigmoid(z.astype(jnp.float32)))


def hgrn2_scan(q, k, logf, v, state):
    B, T = q.shape[:2]
    nc = T // CHUNK

    def chunks(t):
        return t.astype(jnp.float32).reshape(B, nc, CHUNK, C_H, t.shape[-1]).transpose(1, 0, 3, 2, 4)

    tri = jnp.tril(jnp.ones((CHUNK, CHUNK), dtype=bool))

    def step(S_prev, inp):
        qc, kc, gc, vc = inp
        b = jnp.cumsum(gc, axis=2)
        o_inter = jnp.einsum('bhtd,bhde->bhte', qc * jnp.exp(b), S_prev)
        diff = jnp.where(tri[:, :, None], b[:, :, :, None, :] - b[:, :, None, :, :], NEG_INF)
        att = jnp.einsum('bhtsd,bhsd->bhts', qc[:, :, :, None, :] * jnp.exp(diff), kc)
        o_intra = jnp.einsum('bhts,bhse->bhte', att, vc)
        b_last = b[:, :, -1:, :]
        S_new = (jnp.exp(b_last[:, :, 0, :])[..., None] * S_prev
                 + jnp.einsum('bhsd,bhse->bhde', kc * jnp.exp(b_last - b), vc))
        return S_new, o_inter + o_intra

    S_fin, o = lax.scan(step, state, (chunks(q), chunks(k), chunks(logf), chunks(v)))
    return S_fin, o.transpose(1, 0, 3, 2, 4).reshape(B, T, C_H, C_DV)


def hgrn2_prep(cq, ci, cff, cfb, lb):
    B, T, _ = cq.shape
    shp = (B, T, C_H, C_DK)
    q = jax.nn.silu(cq).reshape(shp)
    i = ci.reshape(B, T, C_H, C_DV)
    lf_f = hgrn2_log_forget(cff, lb[0]).reshape(shp)
    lf_b = hgrn2_log_forget(cfb, lb[1]).reshape(shp)
    return q, i, lf_f, lf_b


def hgrn2_bidir(q, i, lf_f, lf_b, s_f, s_b):
    k_f = -jnp.expm1(lf_f)
    k_b = -jnp.expm1(lf_b)
    sf, o_f = hgrn2_scan(q, k_f, lf_f, i, s_f)
    rev = lambda t: jnp.flip(t, axis=1)
    sb, o_b = hgrn2_scan(rev(q), rev(k_b), rev(lf_b), rev(i), s_b)
    return sf, sb, o_f + rev(o_b)


def hgrn2_out(o, g, w):
    B, T = o.shape[:2]
    y = rms_norm(o, w) * jax.nn.silu(g.reshape(o.shape).astype(jnp.float32))
    return y.reshape(B, T, C_V_W).astype(g.dtype)


def merge_branches(o_a, o_b, o_c, gates, w_br, w_o):
    g = gates.reshape(gates.shape[:-1] + (N_BRANCH, D_MODEL))
    y = jax.nn.sigmoid(g[..., 0, :]) * (o_a @ w_br[0])
    y = y + jax.nn.sigmoid(g[..., 1, :]) * (o_b @ w_br[1])
    y = y + jax.nn.sigmoid(g[..., 2, :]) * (o_c @ w_br[2])
    return y @ w_o


def hybrid_mixer(h, hc, tabs, lb, w_in, sink, lam_par, lam_init, diff_w, hgrn_w, w_br, w_o, with_ctx):
    B, S, _ = h.shape
    L = hc.shape[1]
    (aq, ak, av, bq, bk, bv, cq, ci, cff, cfb, cg, gt) = jnp.split(h @ w_in, SPLIT_IDX, axis=-1)
    (aqc, akc, avc, bqc, bkc, bvc, cqc, cic, cffc, cfbc, cgc, gtc) = jnp.split(hc @ w_in, SPLIT_IDX, axis=-1)

    ka_c = akc.reshape(B, L, A_HKV, HEAD_DIM)
    va_c = avc.reshape(B, L, A_HKV, HEAD_DIM)
    o_a = window_gqa_latent(apply_axial_rope(aq.reshape(B, S, A_HQ, HEAD_DIM), tabs),
                            apply_axial_rope(ak.reshape(B, S, A_HKV, HEAD_DIM), tabs),
                            av.reshape(B, S, A_HKV, HEAD_DIM), ka_c, va_c, sink)

    lp = lam_par.astype(jnp.float32)
    lam = jnp.exp(jnp.sum(lp[0] * lp[1])) - jnp.exp(jnp.sum(lp[2] * lp[3])) + lam_init
    kb_c = bkc.reshape(B, L, B_H, 2, B_HD)
    vb_c = bvc.reshape(B, L, B_H, B_VD)
    o_b = diff_attn_latent(apply_axial_rope(bq.reshape(B, S, B_H, 2, B_HD), tabs),
                           apply_axial_rope(bk.reshape(B, S, B_H, 2, B_HD), tabs),
                           bv.reshape(B, S, B_H, B_VD), kb_c, vb_c, lam)
    o_b = diff_head_out(o_b, diff_w, lam_init)

    zero = jnp.zeros((B, C_H, C_DK, C_DV), jnp.float32)
    qcc, icc, lfc_f, lfc_b = hgrn2_prep(cqc, cic, cffc, cfbc, lb)
    s_f, s_b, oc_c = hgrn2_bidir(qcc, icc, lfc_f, lfc_b, zero, zero)
    q_c, i_c, lf_f, lf_b = hgrn2_prep(cq, ci, cff, cfb, lb)
    _, _, o_c = hgrn2_bidir(q_c, i_c, lf_f, lf_b, s_f, s_b)
    o_c = hgrn2_out(o_c, cg, hgrn_w)

    y = merge_branches(o_a, o_b, o_c, gt, w_br, w_o)
    if not with_ctx:
        return y, None
    oa_c = sink_attn_context(aqc.reshape(B, L, A_HQ, HEAD_DIM), ka_c, va_c, sink)
    ob_c = diff_head_out(diff_attend(bqc.reshape(B, L, B_H, 2, B_HD), kb_c, vb_c, lam), diff_w, lam_init)
    oc_c = hgrn2_out(oc_c, cgc, hgrn_w)
    yc = merge_branches(oa_c, ob_c, oc_c, gtc, w_br, w_o)
    return y, yc


def moe_ffn(h, w_router, b_router, w_gu, b_gu, w_dn, b_dn):
    N, D = h.shape
    NK = N * TOP_K
    logits = (h @ w_router + b_router).astype(jnp.float32)
    top_v, top_e = lax.top_k(logits, TOP_K)
    gates = jax.nn.softmax(top_v, axis=-1)
    flat_e = top_e.reshape(-1).astype(jnp.int32)
    order = jnp.argsort(flat_e)
    sorted_e = flat_e[order]
    counts = jnp.bincount(flat_e, length=N_EXPERTS).astype(jnp.int32)
    padded = (counts + MOE_BLOCK - 1) // MOE_BLOCK * MOE_BLOCK
    pad_end = jnp.cumsum(padded)
    pad_start = pad_end - padded
    grp_start = jnp.cumsum(counts) - counts
    rank = jnp.arange(NK, dtype=jnp.int32) - grp_start[sorted_e]
    dest = jnp.zeros((NK,), jnp.int32).at[order].set(pad_start[sorted_e] + rank)
    n_blk = (NK + MOE_BLOCK - 1) // MOE_BLOCK + N_EXPERTS
    R = n_blk * MOE_BLOCK
    buf = jnp.zeros((R, D), h.dtype).at[dest].set(jnp.repeat(h, TOP_K, axis=0))
    blk_e = jnp.clip(jnp.searchsorted(pad_end, jnp.arange(n_blk, dtype=jnp.int32) * MOE_BLOCK, side='right'),
                     0, N_EXPERTS - 1)

    def expert_block(args):
        xb, e = args
        gu = xb @ w_gu[e] + b_gu[e]
        g, u = gu[:, :EXPERT_FF], gu[:, EXPERT_FF:]
        g = jnp.minimum(g, SWIGLU_LIMIT)
        u = jnp.clip(u, -SWIGLU_LIMIT, SWIGLU_LIMIT)
        return ((u + 1) * (g * jax.nn.sigmoid(SWIGLU_ALPHA * g))) @ w_dn[e] + b_dn[e]

    y = lax.map(expert_block, (buf.reshape(n_blk, MOE_BLOCK, D), blk_e)).reshape(R, D)
    return jnp.sum(y[dest].reshape(N, TOP_K, D) * gates[..., None].astype(y.dtype), axis=1)


def setup_inputs(seed: int = 0) -> dict:
    key = jax.random.key(seed)
    ks = jax.random.split(key, 21)
    D = D_MODEL

    def nrm(k, shape, scale):
        return jax.random.normal(k, shape, jnp.float32) * scale

    return {
        "x": nrm(ks[0], (BATCH, SEQ, D), 1.0),
        "c": nrm(ks[1], (BATCH, D), 1.0),
        "ctx": nrm(ks[2], (BATCH, CTX_LEN, D), 1.0),
        "c_ctx": nrm(ks[3], (D,), 1.0),
        "w_mod": nrm(ks[4], (DEPTH, D, 6 * D), 0.3 * D ** -0.5),
        "b_mod": nrm(ks[5], (DEPTH, 6 * D), 0.02),
        "norm_g": 1.0 + nrm(ks[6], (DEPTH, 4, D), 0.02),
        "w_in": nrm(ks[7], (DEPTH, D, IN_W), D ** -0.5),
        "attn_sink": nrm(ks[8], (DEPTH, A_HQ), 0.5),
        "diff_lambda": nrm(ks[9], (DEPTH, 4, B_HD), 0.1),
        "diff_norm_w": 1.0 + nrm(ks[10], (DEPTH, B_VD), 0.02),
        "hgrn_lb_logits": nrm(ks[11], (DEPTH, 2, C_H * C_DK), 0.5),
        "hgrn_norm_w": 1.0 + nrm(ks[12], (DEPTH, C_DV), 0.02),
        "w_branch": nrm(ks[13], (DEPTH, N_BRANCH, BRANCH_W, D), BRANCH_W ** -0.5),
        "w_out": nrm(ks[14], (DEPTH, D, D), D ** -0.5),
        "w_router": nrm(ks[15], (DEPTH, D, N_EXPERTS), D ** -0.5),
        "b_router": nrm(ks[16], (DEPTH, N_EXPERTS), 0.01),
        "w_gate_up": nrm(ks[17], (DEPTH, N_EXPERTS, D, 2 * EXPERT_FF), D ** -0.5),
        "b_gate_up": nrm(ks[18], (DEPTH, N_EXPERTS, 2 * EXPERT_FF), 0.01),
        "w_down": nrm(ks[19], (DEPTH, N_EXPERTS, EXPERT_FF, D), EXPERT_FF ** -0.5),
        "b_down": nrm(ks[20], (DEPTH, N_EXPERTS, D), 0.01),
    }


def reference(x, c, ctx, c_ctx, w_mod, b_mod, norm_g, w_in, attn_sink, diff_lambda, diff_norm_w,
              hgrn_lb_logits, hgrn_norm_w, w_branch, w_out, w_router, b_router, w_gate_up, b_gate_up,
              w_down, b_down):
    B, S, D = x.shape
    L = ctx.shape[1]
    ROWS = S // GRID_W
    tabs = axial_rope_tables(ROWS, x.dtype)
    lb_cum = jnp.cumsum(jax.nn.softmax(hgrn_lb_logits.astype(jnp.float32), axis=0), axis=0)
    lower_bounds = lb_cum - lb_cum[0:1]
    xc = ctx
    for l in range(DEPTH):
        last = l == DEPTH - 1
        lam_init = 0.8 - 0.6 * math.exp(-0.3 * l)
        mod = (jax.nn.silu(c) @ w_mod[l] + b_mod[l]).reshape(B, 6, D)
        mod_c = (jax.nn.silu(c_ctx)[None] @ w_mod[l] + b_mod[l]).reshape(1, 6, D)
        h = modulate(x, norm_g[l, 0], mod[:, 0], mod[:, 1])
        hc = modulate(xc, norm_g[l, 0], mod_c[:, 0], mod_c[:, 1])
        y, yc = hybrid_mixer(h, hc, tabs, lower_bounds[l], w_in[l], attn_sink[l], diff_lambda[l], lam_init,
                             diff_norm_w[l], hgrn_norm_w[l], w_branch[l], w_out[l], not last)
        x = x + mod[:, 2][:, None, :] * rms_norm(y, norm_g[l, 1])
        h = modulate(x, norm_g[l, 2], mod[:, 3], mod[:, 4])
        if last:
            f = moe_ffn(h.reshape(B * S, D), w_router[l], b_router[l], w_gate_up[l], b_gate_up[l],
                        w_down[l], b_down[l]).reshape(B, S, D)
        else:
            xc = xc + mod_c[:, 2][:, None, :] * rms_norm(yc, norm_g[l, 1])
            hc = modulate(xc, norm_g[l, 2], mod_c[:, 3], mod_c[:, 4])
            tok = jnp.concatenate([h.reshape(B * S, D), hc.reshape(B * L, D)], axis=0)
            ft = moe_ffn(tok, w_router[l], b_router[l], w_gate_up[l], b_gate_up[l], w_down[l], b_down[l])
            f = ft[:B * S].reshape(B, S, D)
            fc = ft[B * S:].reshape(B, L, D)
            xc = xc + mod_c[:, 5][:, None, :] * rms_norm(fc, norm_g[l, 3])
        x = x + mod[:, 5][:, None, :] * rms_norm(f, norm_g[l, 3])
    return x
```

```cpp
#include <hip/hip_runtime.h>
#include <cstdio>
#include <cstdint>
namespace pg8 {
#define PG8_LAS __attribute__((address_space(3)))
typedef unsigned short bf16_t;
typedef short bf16x8 __attribute__((ext_vector_type(8)));
typedef float f32x4 __attribute__((ext_vector_type(4)));
typedef unsigned u32x4 __attribute__((ext_vector_type(4)));
constexpr int BM = 256, BK = 64, HALF = 128, HTB = HALF * BK * 2  , STAGE_BYTES = 8 * HTB, NXCD = 8, WGM = 8;

__host__ __device__ __forceinline__ int lds_byte(int r, int c) { const int st = (r >> 4) * 2 + (c >> 5), rr = r & 15, cc = c & 31, ob = rr * 64 + cc * 2; return st * 1024 + (ob ^ (((ob >> 9) & 1) << 5)); }
__host__ __device__ __forceinline__ void stage_rc(int b, int& R, int& C) { const int st = b / 1024, sb = b % 1024, swz = sb ^ (((sb >> 9) & 1) << 5); R = (st >> 1) * 16 + swz / 64; C = (st & 1) * 32 + (swz % 64) / 2; }
__host__ __device__ __forceinline__ int perm32(int rho) { const int n = rho >> 4, i = rho & 15; return 8 * (i >> 2) + 4 * n + (i & 3); }

struct Unit { int pm, pn; };
struct Gemm { const bf16_t* A; const bf16_t* Bt; int M, N, K; };

struct StaticOrder {
    int nM, nN, nwg, G, c;
    __host__ __device__ void init(int M, int N, int G_, int c_) { nM = M / BM; nN = N / BM; nwg = nM * nN; G = G_; c = c_; }
    __host__ __device__ bool next(int i, Unit& u) const {
        const long L = (long)i * G + c; if (L >= nwg) return false;
        int wgid = (int)L; { const int q = nwg / NXCD, r = nwg % NXCD, xcd = wgid % NXCD, off = wgid / NXCD; wgid = (xcd < r ? xcd * (q + 1) : r * (q + 1) + (xcd - r) * q) + off; }
        const int nig = WGM * nN, gid = wgid / nig, fm = gid * WGM, gsz = (nM - fm) < WGM ? (nM - fm) : WGM;
        u.pm = fm + ((wgid % nig) % gsz); u.pn = (wgid % nig) / gsz; return true;
    }
    __device__ __forceinline__ void a_ready(const Unit&) const {}
    __device__ __forceinline__ void done(const Unit&) const {}
};

template <class Epi, class Sched, bool ALIGN_EPI = false, bool SP2 = false>
__device__ __forceinline__ void gemm_phase(PG8_LAS unsigned char* lds, const Gemm g, const Sched& S, const Epi& E) {
    int tid_ = threadIdx.x; asm volatile("" : "+v"(tid_));
    const int tid = tid_, wid = __builtin_amdgcn_readfirstlane(tid >> 6), lane = tid & 63, wr = wid >> 2, wc = wid & 3, fr = lane & 15, fq = lane >> 4;
    const int K = g.K, nt = K / BK;
    unsigned voffA[2], voffB[2];
#pragma unroll
    for (int i = 0; i < 2; ++i) { int R, C; stage_rc(tid * 16 + i * 8192, R, C); const int Rb = Epi::PERM ? ((R & ~31) + perm32(R & 31)) : R;
        voffA[i] = (unsigned)(R * K + C) * 2u; voffB[i] = (unsigned)(Rb * K + C) * 2u; }
    const size_t kstep = (size_t)(BK * 2);
    const size_t hstep = (size_t)HALF * K * 2;
    const size_t tstep = 2 * hstep;
    const unsigned ldsw = (unsigned)wid * 1024u;
    const int aoff = lds_byte(wr * 64 + fr, fq * 8), boff = lds_byte(wc * 32 + fr, fq * 8);
#define PG8_SA(b, h) (((b) * 2 + (h)) * HTB)
#define PG8_SB(b, h) ((4 + (b) * 2 + (h)) * HTB)
#define PG8_STAGE(bufoff, gbase, voff) do { _Pragma("unroll") for (int _i = 0; _i < 2; ++_i) \
        __builtin_amdgcn_global_load_lds((const unsigned*)((const char*)(gbase) + (voff)[_i]), (PG8_LAS unsigned*)(lds + (bufoff) + ldsw + _i * 8192), 16, 0, 0); } while (0)
#define PG8_LDA(dst, b, h) do { _Pragma("unroll") for (int m = 0; m < 4; ++m) _Pragma("unroll") for (int k = 0; k < 2; ++k) dst[m][k] = *(const PG8_LAS bf16x8*)(lds + PG8_SA(b, h) + aoff + m * 2048 + k * 1024); } while (0)
#define PG8_LDB(dst, b, h) do { _Pragma("unroll") for (int n = 0; n < 2; ++n) _Pragma("unroll") for (int k = 0; k < 2; ++k) dst[n][k] = *(const PG8_LAS bf16x8*)(lds + PG8_SB(b, h) + boff + n * 2048 + k * 1024); } while (0)
#define PG8_MMA(ai, bj, At, Bt) do { __builtin_amdgcn_s_setprio(1); _Pragma("unroll") for (int m = 0; m < 4; ++m) _Pragma("unroll") for (int n = 0; n < 2; ++n) _Pragma("unroll") for (int k = 0; k < 2; ++k) \
        acc[ai][bj][m][n] = __builtin_amdgcn_mfma_f32_16x16x32_bf16(Bt[n][k], At[m][k], acc[ai][bj][m][n], 0, 0, 0); __builtin_amdgcn_s_setprio(0); } while (0)
#define PG8_WAIT_V(n) asm volatile("s_waitcnt vmcnt(" #n ")" ::: "memory")
#define PG8_WAIT_L(n) asm volatile("s_waitcnt lgkmcnt(" #n ")" ::: "memory")
#define PG8_BAR __builtin_amdgcn_s_barrier()
#define PG8_SCHED __builtin_amdgcn_sched_barrier(0)
    Unit cur, nxt; int ui = 0;
    if (!S.next(0, cur)) return;
    f32x4 acc[2][2][4][2];
#pragma unroll
    for (int a = 0; a < 2; ++a)
#pragma unroll
        for (int b = 0; b < 2; ++b)
#pragma unroll
            for (int m = 0; m < 4; ++m)
#pragma unroll
                for (int n = 0; n < 2; ++n) acc[a][b][m][n] = (f32x4){0.f, 0.f, 0.f, 0.f};
    bf16x8 At[4][2], B0[2][2], B1[2][2];
    const char* cA = (const char*)g.A + (size_t)cur.pm * tstep; const char* cB = (const char*)g.Bt + (size_t)cur.pn * tstep;
    S.a_ready(cur);
    if constexpr (SP2) {
        PG8_STAGE(PG8_SB(0, 0), cB, voffB); PG8_STAGE(PG8_SB(0, 1), cB + hstep, voffB); PG8_STAGE(PG8_SA(0, 0), cA, voffA); PG8_STAGE(PG8_SA(0, 1), cA + hstep, voffA);
        if (wr == 1) PG8_BAR;
        PG8_WAIT_V(2); PG8_BAR;
        PG8_STAGE(PG8_SB(1, 0), cB + kstep, voffB); PG8_STAGE(PG8_SA(1, 0), cA + kstep, voffA); PG8_STAGE(PG8_SB(1, 1), cB + hstep + kstep, voffB);
        PG8_WAIT_V(6); PG8_BAR;
    } else {
        PG8_STAGE(PG8_SB(0, 0), cB, voffB); PG8_STAGE(PG8_SA(0, 0), cA, voffA); PG8_STAGE(PG8_SB(0, 1), cB + hstep, voffB); PG8_STAGE(PG8_SA(0, 1), cA + hstep, voffA);
        if (wr == 1) PG8_BAR;
        PG8_WAIT_V(4); PG8_BAR;
        PG8_STAGE(PG8_SB(1, 0), cB + kstep, voffB); PG8_STAGE(PG8_SA(1, 0), cA + kstep, voffA); PG8_STAGE(PG8_SB(1, 1), cB + hstep + kstep, voffB);
        PG8_WAIT_V(6); PG8_BAR;
    }
    for (;;) {
        const bool has_next = S.next(ui + 1, nxt);
        const char* nA = has_next ? (const char*)g.A + (size_t)nxt.pm * tstep : cA; const char* nB = has_next ? (const char*)g.Bt + (size_t)nxt.pn * tstep : cB;
        for (int t = 0; t < nt; t += 2) {
            const bool last = (t == nt - 2);
            const char* a1 = cA + (size_t)(t + 1) * kstep;
            const char* a2 = last ? nA : cA + (size_t)(t + 2) * kstep; const char* b2 = last ? nB : cB + (size_t)(t + 2) * kstep;
            const char* a3 = a2 + kstep; const char* b3 = b2 + kstep;
            if (last && has_next) S.a_ready(nxt);
            if constexpr (SP2) {
            PG8_LDB(B0, 0, 0); PG8_LDB(B1, 0, 1); PG8_SCHED; PG8_LDA(At, 0, 0); PG8_STAGE(PG8_SA(1, 1), a1 + hstep, voffA);
            PG8_WAIT_V(8); PG8_WAIT_L(0); PG8_BAR; PG8_MMA(0, 0, At, B0); PG8_MMA(0, 1, At, B1); PG8_BAR; PG8_SCHED;
            PG8_LDA(At, 0, 1); PG8_STAGE(PG8_SB(0, 0), b2, voffB); PG8_STAGE(PG8_SB(0, 1), b2 + hstep, voffB); PG8_STAGE(PG8_SA(0, 0), a2, voffA);
            PG8_WAIT_V(8); PG8_WAIT_L(0); PG8_BAR; PG8_MMA(1, 0, At, B0); PG8_MMA(1, 1, At, B1); PG8_BAR; PG8_SCHED;
            PG8_LDB(B0, 1, 0); PG8_LDB(B1, 1, 1); PG8_SCHED; PG8_LDA(At, 1, 0); PG8_STAGE(PG8_SA(0, 1), a2 + hstep, voffA);
            PG8_WAIT_V(8); PG8_WAIT_L(0); PG8_BAR; PG8_MMA(0, 0, At, B0); PG8_MMA(0, 1, At, B1); PG8_BAR; PG8_SCHED;
            PG8_LDA(At, 1, 1); PG8_STAGE(PG8_SB(1, 0), b3, voffB); PG8_STAGE(PG8_SB(1, 1), b3 + hstep, voffB); PG8_STAGE(PG8_SA(1, 0), a3, voffA);
            PG8_WAIT_V(8); PG8_WAIT_L(0); PG8_BAR; PG8_MMA(1, 0, At, B0); PG8_MMA(1, 1, At, B1); PG8_BAR; PG8_SCHED;
            } else {
            PG8_LDB(B0, 0, 0); PG8_SCHED; PG8_LDA(At, 0, 0); PG8_STAGE(PG8_SA(1, 1), a1 + hstep, voffA);
            PG8_WAIT_L(8); PG8_BAR; PG8_WAIT_L(0); PG8_MMA(0, 0, At, B0); PG8_BAR; PG8_SCHED;
            PG8_LDB(B1, 0, 1); PG8_STAGE(PG8_SB(0, 0), b2, voffB);
            PG8_BAR; PG8_WAIT_L(0); PG8_MMA(0, 1, At, B1); PG8_BAR;
            PG8_LDA(At, 0, 1); PG8_STAGE(PG8_SA(0, 0), a2, voffA);
            PG8_BAR; PG8_WAIT_L(0); PG8_MMA(1, 0, At, B0); PG8_BAR; PG8_SCHED;
            PG8_STAGE(PG8_SB(0, 1), b2 + hstep, voffB);
            PG8_WAIT_V(6); PG8_BAR; PG8_MMA(1, 1, At, B1); PG8_BAR;
            PG8_LDB(B0, 1, 0); PG8_SCHED; PG8_LDA(At, 1, 0); PG8_STAGE(PG8_SA(0, 1), a2 + hstep, voffA);
            PG8_WAIT_L(8); PG8_BAR; PG8_WAIT_L(0); PG8_MMA(0, 0, At, B0); PG8_BAR; PG8_SCHED;
            PG8_LDB(B1, 1, 1); PG8_STAGE(PG8_SB(1, 0), b3, voffB);
            PG8_BAR; PG8_WAIT_L(0); PG8_MMA(0, 1, At, B1); PG8_BAR;
            PG8_LDA(At, 1, 1); PG8_STAGE(PG8_SA(1, 0), a3, voffA);
            PG8_BAR; PG8_WAIT_L(0); PG8_MMA(1, 0, At, B0); PG8_BAR; PG8_SCHED;
            PG8_STAGE(PG8_SB(1, 1), b3 + hstep, voffB);
            PG8_WAIT_V(6); PG8_BAR; PG8_MMA(1, 1, At, B1); PG8_BAR;
            }
        }
        if constexpr (ALIGN_EPI) { if (wr == 0) PG8_BAR; }
        if constexpr (!Epi::AFTER_DRAIN) { E(acc, cur, wr, wc, fr, fq); S.done(cur); }
        if (!has_next) break;
#pragma unroll
        for (int a = 0; a < 2; ++a)
#pragma unroll
            for (int b = 0; b < 2; ++b)
#pragma unroll
                for (int m = 0; m < 4; ++m)
#pragma unroll
                    for (int n = 0; n < 2; ++n) acc[a][b][m][n] = (f32x4){0.f, 0.f, 0.f, 0.f};
        cur = nxt; cA = nA; cB = nB; ++ui;
        if constexpr (ALIGN_EPI) { if (wr == 1) PG8_BAR; }
    }
    PG8_WAIT_V(0);
    if constexpr (!ALIGN_EPI) { if (wr == 0) PG8_BAR; }
    PG8_BAR;
    if constexpr (Epi::AFTER_DRAIN) { E.fused(acc, cur, wr, wc, fr, fq, lds, wid, lane); S.done(cur); }
#undef PG8_SA
#undef PG8_SB
#undef PG8_STAGE
#undef PG8_LDA
#undef PG8_LDB
#undef PG8_MMA
#undef PG8_WAIT_V
#undef PG8_WAIT_L
#undef PG8_BAR
#undef PG8_SCHED
}
}
#define GAS __attribute__((address_space(1)))
#define LAS __attribute__((address_space(3)))
typedef unsigned short bf16;
typedef unsigned v4u __attribute__((ext_vector_type(4)));
typedef float f32x4 __attribute__((ext_vector_type(4)));
typedef short bf16x8 __attribute__((ext_vector_type(8)));
typedef GAS unsigned gu32;
typedef GAS unsigned long long gu64;
#define RLX_AGENT __ATOMIC_RELAXED, __HIP_MEMORY_SCOPE_AGENT
#define LDS_WAIT() asm volatile("s_waitcnt lgkmcnt(0)" ::: "memory")
#define VM_WAIT() asm volatile("s_waitcnt vmcnt(0)" ::: "memory")
__device__ __forceinline__ unsigned long long rt() { return __builtin_amdgcn_s_memrealtime(); }
__device__ __forceinline__ unsigned f2bf(float f) { unsigned u = __builtin_bit_cast(unsigned, f); return (u + 0x7fffu + ((u >> 16) & 1u)) >> 16; }
__device__ __forceinline__ unsigned pk2(float lo, float hi) { return f2bf(lo) | (f2bf(hi) << 16); }

#define XB_TMO      128
#define XB_XCNT(j)  (256  + 64 * (j))
#define XB_XSUB(j)  (1280 + 64 * (j))
#define XB_XGEN(j)  (2304 + 64 * (j))
#define XB_TOP      3328
#define XB_TOPGEN   3392
#define XCD_BAR_WORDS 3456
#define XB_SPIN_CAP (1u << 18)

__device__ __forceinline__ unsigned xb_ld(unsigned* p)              { return __hip_atomic_load(p, __ATOMIC_RELAXED, __HIP_MEMORY_SCOPE_AGENT); }
__device__ __forceinline__ unsigned xb_add(unsigned* p, unsigned v) { return __hip_atomic_fetch_add(p, v, __ATOMIC_RELAXED, __HIP_MEMORY_SCOPE_AGENT); }
__device__ __forceinline__ unsigned xb_xcc_id() { return (unsigned)__builtin_amdgcn_s_getreg((3 << 11) | 20) & 0xFu; }
#define XB_SPIN(cond, bar) do { unsigned _sp = 0; while (cond) { __builtin_amdgcn_s_sleep(1); \
    if ((++_sp & 255u) == 0u) { if (xb_ld(&(bar)[XB_TMO])) break; if (_sp > XB_SPIN_CAP) { atomicAdd(&(bar)[XB_TMO], 1u); break; } } } } while (0)

struct XcdBarrier {
    unsigned* bar; unsigned x;
    volatile LAS unsigned* st;
};

__device__ __forceinline__ XcdBarrier xcd_barrier_post(unsigned* bar, volatile LAS unsigned* st) {
    XcdBarrier b; b.bar = bar; b.x = xb_xcc_id(); b.st = st;
    if (threadIdx.x == 0) (void)xb_add(&bar[XB_XCNT(b.x)], 1u);
    return b;
}
__device__ __forceinline__ void xcd_barrier_complete(unsigned* bar, unsigned x, unsigned& nloc, unsigned& nx) {
    const unsigned G = gridDim.x * gridDim.y * gridDim.z;
    unsigned sum, cnt, mine, sp = 0u;
    for (;;) {
        sum = 0u; cnt = 0u; mine = 0u;
#pragma unroll
        for (unsigned j = 0; j < 16; ++j) { const unsigned c = xb_ld(&bar[XB_XCNT(j)]); sum += c; cnt += (c > 0u) ? 1u : 0u; mine = (j == x) ? c : mine; }
        if (sum == G) break;
        __builtin_amdgcn_s_sleep(1);
        if ((++sp & 255u) == 0u) { if (xb_ld(&bar[XB_TMO])) break; if (sp > XB_SPIN_CAP) { atomicAdd(&bar[XB_TMO], 1u); break; } }
    }
    nloc = mine > 0u ? mine : 1u; nx = cnt > 0u ? cnt : 1u;
}

__device__ __forceinline__ void xcd_barrier(const XcdBarrier& b) {
    asm volatile("s_waitcnt vmcnt(0)" ::: "memory");
    __syncthreads();
    if (threadIdx.x == 0) {
        unsigned* bar = b.bar;
        __builtin_amdgcn_s_waitcnt(0);
        unsigned nloc = b.st[0], nx = b.st[1];
        if (nloc == 0u) { xcd_barrier_complete(bar, b.x, nloc, nx); b.st[0] = nloc; b.st[1] = nx; }
        const unsigned old = xb_add(&bar[XB_XSUB(b.x)], 1u);
        const unsigned gen = old / nloc;
        if (old + 1u == (gen + 1u) * nloc) {
            __builtin_amdgcn_fence(__ATOMIC_RELEASE, "agent");
            asm volatile("s_waitcnt vmcnt(0)" ::: "memory");
            const unsigned og = xb_add(&bar[XB_TOP], 1u);
            const unsigned tg = og / nx;
            if (og + 1u == (tg + 1u) * nx) xb_add(&bar[XB_TOPGEN], 1u);
            else XB_SPIN(xb_ld(&bar[XB_TOPGEN]) == tg, bar);
            __builtin_amdgcn_fence(__ATOMIC_ACQUIRE, "agent");
            xb_add(&bar[XB_XGEN(b.x)], 1u);
            asm volatile("s_waitcnt vmcnt(0)" ::: "memory");
        } else {
            XB_SPIN(xb_ld(&bar[XB_XGEN(b.x)]) == gen, bar);
            __builtin_amdgcn_fence(__ATOMIC_ACQUIRE, "agent");
            asm volatile("s_waitcnt vmcnt(0)" ::: "memory");
        }
    }
    __syncthreads();
}

#define DI __device__ __forceinline__
constexpr int DM = 1024, NB = 2, SEQ = 8192, CTXL = 256, DEPTH = 2;
constexpr int NLAT = NB * SEQ, NCTX = NB * CTXL, NTOK = NLAT + NCTX;
constexpr int INW = 7936;
constexpr int C_AQ = 0, C_AK = 512, C_AV = 640, C_BQ = 768, C_BK = 1280, C_BV = 1792, C_CQ = 2304, C_CI = 2816, C_CFF = 3328, C_CFB = 3840, C_CG = 4352, C_GT = 4864;
constexpr int NEXP = 32, EFF = 1024, NCH = 132;
constexpr float RMS_EPS = 1e-6f, LOG2E = 1.4426950408889634f, QSCALE = 0.125f * 1.4426950408889634f;
constexpr int XG_ROWS = 75776;
constexpr int NWAVES = 8, NTHR = 512;

constexpr size_t MiB = 1u << 20;
constexpr size_t WS_CTL = 0, CTL_ZERO_BYTES = 1 * MiB;
constexpr size_t WS_SMALL = 1 * MiB;
constexpr size_t WS_WIN = 2 * MiB, WS_WBR = 33 * MiB, WS_WO = 39 * MiB, WS_WGU = 43 * MiB, WS_WDN = 299 * MiB;
constexpr size_t WS_XA = 427 * MiB, WS_H = 493 * MiB, WS_P = 526 * MiB, WS_LF = 782 * MiB, WS_O3 = 848 * MiB, WS_HU = 898 * MiB, WS_HD = 1030 * MiB, WS_HS = 1032 * MiB;
constexpr size_t WS_YF = 1098 * MiB, WS_Y = 1164 * MiB, WS_YO = 1197 * MiB, WS_ROUTE = 1230 * MiB, WS_END = 1232 * MiB;
constexpr size_t WS_XG = 526 * MiB, WS_ACT = 674 * MiB, WS_YS = 822 * MiB;
static_assert(WS_YS + (size_t)XG_ROWS * 1024 * 2 <= WS_HD, "moe overlay");
static_assert(WS_P + (size_t)NTOK * INW * 2 <= WS_LF && WS_HU + (size_t)2112 * 16384 * 4 <= WS_HD && WS_HS + (size_t)2112 * 16384 * 2 <= WS_YF, "ws map");
constexpr int SM_MOD = 0;
constexpr int SM_LB = 36864;
constexpr int SM_TAB = 38912;
constexpr int SM_LAM = 45056;
constexpr int CW_BAR = 4096;
constexpr int CW_CNT = 16384;

constexpr int RING_BYTES = 131072, LDSCTL_OFF = RING_BYTES, MISC_OFF = LDSCTL_OFF + 320, LDS_BYTES = 147456;

typedef float f32x16 __attribute__((ext_vector_type(16)));
typedef float f32x2 __attribute__((ext_vector_type(2)));
typedef short s16x4 __attribute__((ext_vector_type(4)));
typedef unsigned u32x2 __attribute__((ext_vector_type(2)));
typedef __bf16 bf16x2_t __attribute__((ext_vector_type(2)));
DI unsigned cvtpk(float lo, float hi) { f32x2 v = {lo, hi}; bf16x2_t b = __builtin_convertvector(v, bf16x2_t); return __builtin_bit_cast(unsigned, b); }
DI float bf2f(unsigned short u) { return __uint_as_float(((unsigned)u) << 16); }
DI float bflo(unsigned u) { return __uint_as_float(u << 16); }
DI float bfhi(unsigned u) { return __uint_as_float(u & 0xffff0000u); }
DI float wave_sum(float v) {
#pragma unroll
    for (int o = 1; o < 64; o <<= 1) v += __shfl_xor(v, o);
    return v;
}
DI float silu_f(float v) { return v / (1.f + __expf(-v)); }
DI float sigm_f(float v) { return 1.f / (1.f + __expf(-v)); }
DI bf16x8 pack8(float a0, float a1, float a2, float a3, float a4, float a5, float a6, float a7) {
    v4u p; p.x = cvtpk(a0, a1); p.y = cvtpk(a2, a3); p.z = cvtpk(a4, a5); p.w = cvtpk(a6, a7); return __builtin_bit_cast(bf16x8, p);
}
typedef short v4i16_t __attribute__((ext_vector_type(4)));
DI s16x4 tr_read(LAS const char* p) { return __builtin_bit_cast(s16x4, __builtin_amdgcn_ds_read_tr16_b64_v4i16((LAS v4i16_t*)p)); }
DI bf16x8 cat8(s16x4 lo, s16x4 hi) { return __builtin_shufflevector(lo, hi, 0, 1, 2, 3, 4, 5, 6, 7); }
#define MFMA32(a, b, c) __builtin_amdgcn_mfma_f32_32x32x16_bf16((a), (b), (c), 0, 0, 0)
#define MFMA16(a, b, c) __builtin_amdgcn_mfma_f32_16x16x32_bf16((a), (b), (c), 0, 0, 0)
DI int tid_opaque() { int t = threadIdx.x; asm volatile("" : "+v"(t)); return t; }
DI int crow(int r, int hi) { return (r & 3) + 8 * (r >> 2) + 4 * hi; }

DI void ph_mod(LAS unsigned char* lds, const float* c, const float* cctx, const float* wmod, const float* bmod, float* MOD, int vcu, int G) {
    LAS float* red = (LAS float*)lds;
    const int tid = tid_opaque(), col = tid & 31, ks = tid >> 5;
    for (int tile = vcu; tile < 2 * 192; tile += G) {
        const int l = tile / 192, n0 = (tile % 192) * 32;
        const float* W = wmod + (size_t)l * 1024 * 6144 + n0 + col;
        float a0 = 0.f, a1 = 0.f, a2 = 0.f;
#pragma unroll 8
        for (int k = ks * 64; k < ks * 64 + 64; ++k) {
            const float w = W[(size_t)k * 6144];
            a0 += silu_f(c[k]) * w; a1 += silu_f(c[1024 + k]) * w; a2 += silu_f(cctx[k]) * w;
        }
        red[(ks * 3 + 0) * 32 + col] = a0; red[(ks * 3 + 1) * 32 + col] = a1; red[(ks * 3 + 2) * 32 + col] = a2;
        __syncthreads();
        if (tid < 96) { const int j = tid >> 5, cc = tid & 31; float s = 0.f;
#pragma unroll
            for (int k2 = 0; k2 < 16; ++k2) s += red[(k2 * 3 + j) * 32 + cc];
            MOD[(l * 3 + j) * 6144 + n0 + cc] = s + bmod[l * 6144 + n0 + cc]; }
        __syncthreads();
    }
}
DI void sincos_tab(double a, float& s, float& c) {
    const double TWO_PI = 6.283185307179586476925;
    const double k = rint(a / TWO_PI), r = a - k * TWO_PI, r2 = r * r;
    double ts = r, ss = r, tc = 1.0, cs = 1.0;
    for (int n = 1; n <= 15; ++n) { ts *= -r2 / (double)((2 * n) * (2 * n + 1)); ss += ts; tc *= -r2 / (double)((2 * n - 1) * (2 * n)); cs += tc; }
    s = (float)ss; c = (float)cs;
}
DI void ph_tables(float* SM, const float* lb_logits, const float* dlam, int vcu, int G) {
    const int gt = vcu * NTHR + tid_opaque(), NT = G * NTHR;
    for (int i = gt; i < 192 * 16; i += NT) {
        const int pos = i >> 4, f = i & 15;
        const float invf = f == 0 ? 1.0f : f == 1 ? 0.5623413324356079f : f == 2 ? 0.3162277638912201f : f == 3 ? 0.17782793939113617f : f == 4 ? 0.10000000149011612f : f == 5 ? 0.05623413249850273f
                         : f == 6 ? 0.03162277489900589f : f == 7 ? 0.017782794311642647f : f == 8 ? 0.009999999776482582f : f == 9 ? 0.005623413249850273f : f == 10 ? 0.003162277629598975f
                         : f == 11 ? 0.0017782794311642647f : f == 12 ? 0.0010000000474974513f : f == 13 ? 0.000562341301701963f : f == 14 ? 0.0003162277571391314f : 0.00017782794020604342f;
        const int p = pos < 128 ? pos : pos - 128;
        const float ang = (float)p * invf;
        float s, c; sincos_tab((double)ang, s, c);
        if (pos < 128) { SM[SM_TAB + p * 16 + f] = c; SM[SM_TAB + 2048 + p * 16 + f] = s; }
        else { SM[SM_TAB + 4096 + p * 16 + f] = c; SM[SM_TAB + 4096 + 1024 + p * 16 + f] = s; }
    }
    for (int i = gt; i < 1024; i += NT) {
        const float l0 = lb_logits[i], l1 = lb_logits[1024 + i];
        SM[SM_LB + i] = 0.f; SM[SM_LB + 1024 + i] = 1.f / (1.f + expf(l0 - l1));
    }
    if (gt < 2) { const float* lp = dlam + gt * 256; float s0 = 0.f, s1 = 0.f;
        for (int d = 0; d < 64; ++d) { s0 += lp[d] * lp[64 + d]; s1 += lp[128 + d] * lp[192 + d]; }
        const float li = 0.8f - 0.6f * expf(-0.3f * (float)gt);
        SM[SM_LAM + gt] = expf(s0) - expf(s1) + li; SM[SM_LAM + 2 + gt] = li; }
}
DI void p0_transpose_item(const float* W, int K, int N, bf16* WT, int gu, LAS float* scr, int item, int lane) {
    const int nblk = N / 32, kb = item / nblk, nb = item % nblk, k0 = 64 * kb, n0 = 32 * nb;
#pragma unroll 8
    for (int i = 0; i < 32; ++i) { const int kk = 2 * i + (lane >> 5); scr[kk * 33 + (lane & 31)] = W[(size_t)(k0 + kk) * N + n0 + (lane & 31)]; }
    LDS_WAIT(); asm volatile("" ::: "memory");
    const int c = lane & 7;
    const int r0 = gu ? (256 * ((n0 & 1023) >> 7) + 128 * (n0 >> 10) + (n0 & 127)) : n0;
#pragma unroll
    for (int j = 0; j < 4; ++j) { const int n = (lane >> 3) + 8 * j; const LAS float* s = scr + (8 * c) * 33 + n;
        v4u o; o.x = pk2(s[0 * 33], s[1 * 33]); o.y = pk2(s[2 * 33], s[3 * 33]); o.z = pk2(s[4 * 33], s[5 * 33]); o.w = pk2(s[6 * 33], s[7 * 33]);
        *(GAS v4u*)(WT + (size_t)(r0 + n) * K + k0 + 8 * c) = o; }
    LDS_WAIT(); asm volatile("" ::: "memory");
}
struct TGroup { const float* src; bf16* dst; int K, N, nmat, gu; };
DI bool p0_group(const TGroup& g, int& r, LAS float* scr, int lane) {
    const int per = (g.K / 64) * (g.N / 32), cnt = per * g.nmat;
    if (r >= cnt) { r -= cnt; return false; }
    const int m = r / per, it = r % per;
    p0_transpose_item(g.src + (size_t)m * g.K * g.N, g.K, g.N, g.dst + (size_t)m * g.K * g.N, g.gu, scr, it, lane);
    return true;
}
DI void row_ld(const float* p, int lane, f32x4 (&v)[4]) {
#pragma unroll
    for (int j = 0; j < 4; ++j) v[j] = ((const GAS f32x4*)p)[lane + 64 * j];
}
DI void row_ld_bf(const bf16* p, int lane, f32x4 (&v)[4]) {
#pragma unroll
    for (int j = 0; j < 4; ++j) { const u32x2 w = ((const GAS u32x2*)p)[lane + 64 * j]; v[j] = (f32x4){bflo(w.x), bfhi(w.x), bflo(w.y), bfhi(w.y)}; }
}
DI void row_st(float* p, int lane, const f32x4 (&v)[4]) {
#pragma unroll
    for (int j = 0; j < 4; ++j) ((GAS f32x4*)p)[lane + 64 * j] = v[j];
}
DI void row_st_bf(bf16* p, int lane, const f32x4 (&v)[4]) {
#pragma unroll
    for (int j = 0; j < 4; ++j) { u32x2 w; w.x = cvtpk(v[j].x, v[j].y); w.y = cvtpk(v[j].z, v[j].w); ((GAS u32x2*)p)[lane + 64 * j] = w; }
}
DI float row_rstd(const f32x4 (&v)[4]) {
    float s = 0.f;
#pragma unroll
    for (int j = 0; j < 4; ++j) s += (v[j].x * v[j].x + v[j].y * v[j].y) + (v[j].z * v[j].z + v[j].w * v[j].w);
    return rsqrtf(wave_sum(s) * (1.f / 1024.f) + RMS_EPS);
}
DI void row_modulate(const f32x4 (&x)[4], const float* g, const float* shift, const float* scale, int lane, f32x4 (&h)[4]) {
    const float r = row_rstd(x);
#pragma unroll
    for (int j = 0; j < 4; ++j) { const f32x4 gg = ((const GAS f32x4*)g)[lane + 64 * j], sh = ((const GAS f32x4*)shift)[lane + 64 * j], sc = ((const GAS f32x4*)scale)[lane + 64 * j];
        h[j] = x[j] * r * gg * (sc + 1.f) + sh; }
}

struct EpiIn {
    static constexpr bool PERM = false, AFTER_DRAIN = false;
    bf16* P; float* LF; const float* tab; const float* lb;
    DI void operator()(const pg8::f32x4 (&acc)[2][2][4][2], const pg8::Unit& u, int wr, int wc, int fr, int fq) const {
        const int pn = u.pn; const bool lat = u.pm < 64;
#pragma unroll
        for (int bj = 0; bj < 2; ++bj) {
            int mode;
            float sc = 1.f;
            if (pn <= 1 || pn == 3 || pn == 4) { mode = 1; sc = QSCALE; }
            else if (pn == 2) mode = (bj == 0) ? 1 : 0;
            else if (pn == 5 || pn == 6) mode = 1;
            else if (pn == 9 || pn == 10 || pn == 17 || pn == 18) mode = 2;
            else if (pn >= 13 && pn <= 16) mode = 3;
            else if (pn >= 19) mode = 4;
            else mode = 0;
            if (mode == 1 && !lat) mode = 0;
            const int cb = pn * 256 + bj * 128 + wc * 32 + 4 * fq;
#pragma unroll
            for (int ai = 0; ai < 2; ++ai)
#pragma unroll
                for (int m = 0; m < 4; ++m) {
                    const int row = u.pm * 256 + ai * 128 + wr * 64 + m * 16 + fr;
                    f32x4 v0 = acc[ai][bj][m][0], v1 = acc[ai][bj][m][1];
                    if (mode == 1) {
                        const int s = row & (SEQ - 1); const int half = wc & 1; const int pos = half ? (s & 63) : (s >> 6);
                        const float* tb = tab + (half ? 4096 : 0); const int so = half ? 1024 : 2048;
                        const f32x4 cs = *(const GAS f32x4*)(tb + pos * 16 + 4 * fq), sn = *(const GAS f32x4*)(tb + so + pos * 16 + 4 * fq);
                        const f32x4 o0 = v0 * cs - v1 * sn, o1 = v1 * cs + v0 * sn; v0 = o0 * sc; v1 = o1 * sc;
                    } else if (mode == 0) { v0 = v0 * sc; v1 = v1 * sc; }
                    else if (mode == 2) {
#pragma unroll
                        for (int j = 0; j < 4; ++j) { v0[j] = silu_f(v0[j]); v1[j] = silu_f(v1[j]); }
                    } else if (mode == 4) {
#pragma unroll
                        for (int j = 0; j < 4; ++j) { v0[j] = sigm_f(v0[j]); v1[j] = sigm_f(v1[j]); }
                    } else {
                        const int dir = (pn >= 15) ? 1 : 0; const int ch = (pn - 13 - 2 * dir) * 256 + bj * 128 + wc * 32 + 4 * fq;
                        const f32x4 l0 = *(const GAS f32x4*)(lb + dir * 512 + ch), l1 = *(const GAS f32x4*)(lb + dir * 512 + ch + 16);
#pragma unroll
                        for (int j = 0; j < 4; ++j) { v0[j] = fmaxf(__logf(l0[j] + (1.f - l0[j]) * sigm_f(v0[j])), -60.f); v1[j] = fmaxf(__logf(l1[j] + (1.f - l1[j]) * sigm_f(v1[j])), -60.f); }
                        float* lp = LF + (size_t)row * 1024 + dir * 512 + ch;
                        *(GAS f32x4*)lp = v0; *(GAS f32x4*)(lp + 16) = v1;
                        continue;
                    }
                    bf16* op = P + (size_t)row * INW + cb;
                    u32x2 w0, w1; w0.x = cvtpk(v0[0], v0[1]); w0.y = cvtpk(v0[2], v0[3]); w1.x = cvtpk(v1[0], v1[1]); w1.y = cvtpk(v1[2], v1[3]);
                    *(GAS u32x2*)op = w0; *(GAS u32x2*)(op + 16) = w1;
                }
        }
    }
};
struct EpiMerge {
    static constexpr bool PERM = false, AFTER_DRAIN = false;
    const bf16* P; float* YF; bf16* Y;
    DI void operator()(const pg8::f32x4 (&acc)[2][2][4][2], const pg8::Unit& u, int wr, int wc, int fr, int fq) const {
        const int br = u.pm / 66, pm = u.pm % 66, pn = u.pn & 3;
#pragma unroll
        for (int ai = 0; ai < 2; ++ai)
#pragma unroll
            for (int m = 0; m < 4; ++m) {
                const int row = pm * 256 + ai * 128 + wr * 64 + m * 16 + fr;
#pragma unroll
                for (int bj = 0; bj < 2; ++bj)
#pragma unroll
                    for (int n = 0; n < 2; ++n) {
                        const int col = pn * 256 + bj * 128 + wc * 32 + 16 * n + 4 * fq;
                        const u32x2 gw = *(const GAS u32x2*)(P + (size_t)row * INW + C_GT + br * 1024 + col);
                        f32x4 v = acc[ai][bj][m][n] * (f32x4){bflo(gw.x), bfhi(gw.x), bflo(gw.y), bfhi(gw.y)};
                        float* yp = YF + (size_t)row * 1024 + col;
                        if (br > 0) v = v + *(const GAS f32x4*)yp;
                        if (br < 2) *(GAS f32x4*)yp = v;
                        else { u32x2 w; w.x = cvtpk(v[0], v[1]); w.y = cvtpk(v[2], v[3]); *(GAS u32x2*)(Y + (size_t)row * 1024 + col) = w; }
                    }
            }
    }
};
struct MergeOrder {
    int G, c, ntile;
    DI bool next(int i, pg8::Unit& u) const { const int t = (i / 3) * G + c, br = i % 3; if (t >= ntile) return false; u.pm = br * 66 + (t >> 2); u.pn = br * 4 + (t & 3); return true; }
    DI void a_ready(const pg8::Unit&) const {}
    DI void done(const pg8::Unit&) const {}
};
struct EpiPlain {
    static constexpr bool PERM = false, AFTER_DRAIN = false;
    bf16* O; int ldc; const float* bias; int npn;
    DI void operator()(const pg8::f32x4 (&acc)[2][2][4][2], const pg8::Unit& u, int wr, int wc, int fr, int fq) const {
        const int e = u.pn / npn, pn = u.pn % npn;
#pragma unroll
        for (int bj = 0; bj < 2; ++bj)
#pragma unroll
            for (int n = 0; n < 2; ++n) {
                const int col = pn * 256 + bj * 128 + wc * 32 + 16 * n + 4 * fq;
                const f32x4 bv = bias ? *(const GAS f32x4*)(bias + (size_t)e * npn * 256 + col) : (f32x4){0.f, 0.f, 0.f, 0.f};
#pragma unroll
                for (int ai = 0; ai < 2; ++ai)
#pragma unroll
                    for (int m = 0; m < 4; ++m) {
                        const int row = u.pm * 256 + ai * 128 + wr * 64 + m * 16 + fr;
                        const f32x4 v = acc[ai][bj][m][n] + bv;
                        u32x2 w; w.x = cvtpk(v[0], v[1]); w.y = cvtpk(v[2], v[3]); *(GAS u32x2*)(O + (size_t)row * ldc + col) = w;
                    }
            }
    }
};
struct EpiSwiglu {
    static constexpr bool PERM = false, AFTER_DRAIN = false;
    bf16* O; const float* bias;
    DI void operator()(const pg8::f32x4 (&acc)[2][2][4][2], const pg8::Unit& u, int wr, int wc, int fr, int fq) const {
        const int e = u.pn >> 3, nt = u.pn & 7;
#pragma unroll
        for (int n = 0; n < 2; ++n) {
            const int col = nt * 128 + wc * 32 + 16 * n + 4 * fq;
            const f32x4 bg = *(const GAS f32x4*)(bias + (size_t)e * 2048 + col), bu = *(const GAS f32x4*)(bias + (size_t)e * 2048 + 1024 + col);
#pragma unroll
            for (int ai = 0; ai < 2; ++ai)
#pragma unroll
                for (int m = 0; m < 4; ++m) {
                    const int row = u.pm * 256 + ai * 128 + wr * 64 + m * 16 + fr;
                    const f32x4 g = acc[ai][0][m][n] + bg, uu = acc[ai][1][m][n] + bu; f32x4 v;
#pragma unroll
                    for (int j = 0; j < 4; ++j) { const float gc = fminf(g[j], 7.f), uc = fminf(fmaxf(uu[j], -7.f), 7.f); v[j] = (uc + 1.f) * (gc * sigm_f(1.702f * gc)); }
                    u32x2 w; w.x = cvtpk(v[0], v[1]); w.y = cvtpk(v[2], v[3]); *(GAS u32x2*)(O + (size_t)row * 1024 + col) = w;
                }
        }
    }
};
struct MoeOrder {
    const volatile LAS int* tpre; int NT, G, c;
    DI bool next(int i, pg8::Unit& u) const {
        const int L = i * G + c, total = __builtin_amdgcn_readfirstlane(tpre[32]) * NT; if (L >= total) return false;
        const int mt = L / NT, nt = L % NT; int e = 0;
        for (int k = 1; k < 32; ++k) e += (tpre[k] <= mt) ? 1 : 0;
        u.pm = mt; u.pn = __builtin_amdgcn_readfirstlane(e) * NT + nt; return true;
    }
    DI void a_ready(const pg8::Unit&) const {}
    DI void done(const pg8::Unit&) const {}
};

template <int KW> DI int swzK(int row) { return KW == 128 ? (row & 15) : ((row >> 1) & 7); }
template <int VD> DI int swzV(int row) { return VD == 128 ? (row & 3) : ((row >> 1) & 1); }
struct AttnJob {
    int qrow;
    int qcol;
    int kcolT, vcolT, kc8;
    int seg0_row, n0, seg0_kpos0;
    int seg1_row, n1;
    int qpos0;
};
template <int KW, int VD, bool WINDOW>
DI void attn_run(LAS unsigned char* lds, const bf16* P, const AttnJob& J, f32x16 (&O)[VD / 32], float& m_out, float& l_out) {
    const int tid = tid_opaque(), lane = tid & 63, r32 = lane & 31, hi = lane >> 5;
    constexpr int KCH = KW / 8, VCH = VD / 8, NKR = KW / 64, NVR = VD / 64;
    bf16x8 qf[4];
#pragma unroll
    for (int d0 = 0; d0 < 4; ++d0) qf[d0] = *(const GAS bf16x8*)(P + (size_t)(J.qrow + r32) * INW + J.qcol + d0 * 16 + hi * 8);
#pragma unroll
    for (int d = 0; d < VD / 32; ++d) O[d] = (f32x16){0.f, 0.f, 0.f, 0.f, 0.f, 0.f, 0.f, 0.f, 0.f, 0.f, 0.f, 0.f, 0.f, 0.f, 0.f, 0.f};
    float m = -1e30f, l = 0.f;
    const int nt = J.n0 + J.n1;
    v4u kr[NKR], vr[NVR];
#define ATT_TROW(t) ((t) < J.n0 ? J.seg0_row + 64 * (t) : J.seg1_row + 64 * ((t) - J.n0))
#define ATT_LOAD(t) do { const int rs_ = ATT_TROW(t); \
        _Pragma("unroll") for (int i = 0; i < NKR; ++i) { const int ci = tid + NTHR * i, row = ci / KCH, cc = ci % KCH; kr[i] = *(const GAS v4u*)(P + (size_t)(rs_ + row) * INW + J.kcolT + cc * 8); } \
        _Pragma("unroll") for (int i = 0; i < NVR; ++i) { const int ci = tid + NTHR * i, row = ci / VCH, cc = ci % VCH; vr[i] = *(const GAS v4u*)(P + (size_t)(rs_ + row) * INW + J.vcolT + cc * 8); } } while (0)
#define ATT_STORE(buf) do { \
        _Pragma("unroll") for (int i = 0; i < NKR; ++i) { const int ci = tid + NTHR * i, row = ci / KCH, cc = ci % KCH; *(LAS v4u*)(lds + (buf) * 16384 + row * (KW * 2) + ((cc ^ swzK<KW>(row)) << 4)) = kr[i]; } \
        _Pragma("unroll") for (int i = 0; i < NVR; ++i) { const int ci = tid + NTHR * i, row = ci / VCH, cc = ci % VCH; *(LAS v4u*)(lds + 32768 + (buf) * 16384 + row * (VD * 2) + ((((cc >> 2) ^ swzV<VD>(row)) << 6) | ((cc & 3) << 4))) = vr[i]; } } while (0)
    if (nt > 0) { ATT_LOAD(0); ATT_STORE(0); }
    __syncthreads();
    for (int t = 0; t < nt; ++t) {
        const int cur = t & 1;
        if (t + 1 < nt) ATT_LOAD(t + 1);
        const LAS unsigned char* kb = lds + cur * 16384; const LAS unsigned char* vb = lds + 32768 + cur * 16384;
        f32x16 st[2];
#pragma unroll
        for (int sub = 0; sub < 2; ++sub) {
            f32x16 a = (f32x16){0.f, 0.f, 0.f, 0.f, 0.f, 0.f, 0.f, 0.f, 0.f, 0.f, 0.f, 0.f, 0.f, 0.f, 0.f, 0.f};
            const int row = 32 * sub + r32;
#pragma unroll
            for (int d0 = 0; d0 < 4; ++d0) { const int ch = J.kc8 + 2 * d0 + hi;
                const bf16x8 kf = *(const LAS bf16x8*)(kb + row * (KW * 2) + ((ch ^ swzK<KW>(row)) << 4));
                a = MFMA32(kf, qf[d0], a); }
            st[sub] = a;
        }
        if (WINDOW && t < J.n0) {
            const int kp0 = J.seg0_kpos0 + 64 * t - (J.qpos0 + r32);
#pragma unroll
            for (int sub = 0; sub < 2; ++sub)
#pragma unroll
                for (int r = 0; r < 16; ++r) { const int rel = kp0 + 32 * sub + crow(r, hi); if (rel > 128 || rel < -128) st[sub][r] = -INFINITY; }
        }
        float tm = st[0][0];
#pragma unroll
        for (int r = 1; r < 16; ++r) tm = fmaxf(tm, st[0][r]);
#pragma unroll
        for (int r = 0; r < 16; ++r) tm = fmaxf(tm, st[1][r]);
        tm = fmaxf(tm, __shfl_xor(tm, 32));
        const float mn = fmaxf(m, tm), alpha = __builtin_amdgcn_exp2f(m - mn); m = mn;
        float ls = 0.f;
#pragma unroll
        for (int sub = 0; sub < 2; ++sub)
#pragma unroll
            for (int r = 0; r < 16; ++r) { const float p = __builtin_amdgcn_exp2f(st[sub][r] - mn); st[sub][r] = p; ls += p; }
        l = l * alpha + ls;
#pragma unroll
        for (int d = 0; d < VD / 32; ++d) O[d] = O[d] * alpha;
        bf16x8 pb[2][2];
#pragma unroll
        for (int sub = 0; sub < 2; ++sub)
#pragma unroll
            for (int s = 0; s < 2; ++s) pb[sub][s] = pack8(st[sub][8 * s], st[sub][8 * s + 1], st[sub][8 * s + 2], st[sub][8 * s + 3], st[sub][8 * s + 4], st[sub][8 * s + 5], st[sub][8 * s + 6], st[sub][8 * s + 7]);
        const int q4 = (lane & 15) >> 2, p4 = lane & 3, blk = (lane >> 4) & 1;
#pragma unroll
        for (int d = 0; d < VD / 32; ++d)
#pragma unroll
            for (int sub = 0; sub < 2; ++sub)
#pragma unroll
                for (int s = 0; s < 2; ++s) {
                    const int r0 = 32 * sub + 16 * s + 4 * hi + q4, r1 = r0 + 8;
                    const s16x4 lo = tr_read((LAS const char*)(vb + r0 * (VD * 2) + (((d ^ swzV<VD>(r0)) << 6) | (blk << 5) | (p4 << 3))));
                    const s16x4 hh = tr_read((LAS const char*)(vb + r1 * (VD * 2) + (((d ^ swzV<VD>(r1)) << 6) | (blk << 5) | (p4 << 3))));
                    O[d] = MFMA32(cat8(lo, hh), pb[sub][s], O[d]);
                }
        if (t + 1 < nt) ATT_STORE(cur ^ 1);
        __syncthreads();
    }
#undef ATT_TROW
#undef ATT_LOAD
#undef ATT_STORE
    l += __shfl_xor(l, 32);
    m_out = m; l_out = l;
}

DI void ph_attn_a(LAS unsigned char* lds, const bf16* P, bf16* OA, const float* sink, bool with_ctx, int vcu, int G) {
    const int lane = tid_opaque() & 63, wave = __builtin_amdgcn_readfirstlane(tid_opaque() >> 6), r32 = lane & 31, hi = lane >> 5;
    const int nun = 512 + (with_ctx ? 16 : 0);
    for (int u = vcu; u < nun; u += G) {
        AttnJob J; int b, kvh, q0; const bool cq = u >= 512;
        if (!cq) { b = u >> 8; kvh = (u >> 7) & 1; q0 = (u & 127) * 64;
            int jlo = 0, jhi = 4; if (q0 == 0) jlo = 2; else if (q0 == 64) jlo = 1; if (q0 == SEQ - 64) jhi = 2; else if (q0 == SEQ - 128) jhi = 3;
            J.seg0_kpos0 = q0 - 128 + 64 * jlo; J.seg0_row = b * SEQ + J.seg0_kpos0; J.n0 = jhi - jlo + 1; J.qrow = b * SEQ + q0 + 32 * (wave & 1); J.qpos0 = q0 + 32 * (wave & 1); }
        else { const int v = u - 512; b = v >> 3; kvh = (v >> 2) & 1; q0 = (v & 3) * 64; J.seg0_kpos0 = 0; J.seg0_row = 0; J.n0 = 0; J.qrow = NLAT + b * CTXL + q0 + 32 * (wave & 1); J.qpos0 = 0; }
        const int head = kvh * 4 + (wave >> 1);
        J.qcol = C_AQ + head * 64; J.kcolT = C_AK + kvh * 64; J.vcolT = C_AV + kvh * 64; J.kc8 = 0; J.seg1_row = NLAT + b * CTXL; J.n1 = 4;
        f32x16 O[2]; float m, l;
        attn_run<64, 64, true>(lds, P, J, O, m, l);
        l += __builtin_amdgcn_exp2f(sink[head] * LOG2E - m);
        const float inv = 1.f / l;
        bf16* op = OA + (size_t)(J.qrow + r32) * 512 + head * 64;
#pragma unroll
        for (int d = 0; d < 2; ++d)
#pragma unroll
            for (int rg = 0; rg < 4; ++rg) { u32x2 w; w.x = cvtpk(O[d][4 * rg] * inv, O[d][4 * rg + 1] * inv); w.y = cvtpk(O[d][4 * rg + 2] * inv, O[d][4 * rg + 3] * inv);
                *(GAS u32x2*)(op + 32 * d + 8 * rg + 4 * hi) = w; }
    }
}
DI void ph_attn_b(LAS unsigned char* lds, const bf16* P, bf16* OB, const float* dnw, float lam, float lam_init, bool with_ctx, int vcu, int G) {
    const int lane = tid_opaque() & 63, wave = __builtin_amdgcn_readfirstlane(tid_opaque() >> 6), r32 = lane & 31, hi = lane >> 5;
    const int nun = 512 + (with_ctx ? 16 : 0);
    LAS float* XB = (LAS float*)(lds + 65536);
    for (int u = vcu; u < nun; u += G) {
        AttnJob J; int b, h, q0; const bool cq = u >= 512; const int qs = wave & 3, comp = wave >> 2;
        if (!cq) { b = u >> 8; h = (u >> 6) & 3; q0 = (u & 63) * 128; J.seg0_row = b * SEQ; J.n0 = 128; J.qrow = b * SEQ + q0 + 32 * qs; }
        else { const int v = u - 512; b = v >> 3; h = (v >> 1) & 3; q0 = (v & 1) * 128; J.seg0_row = 0; J.n0 = 0; J.qrow = NLAT + b * CTXL + q0 + 32 * qs; }
        J.seg0_kpos0 = 0; J.qpos0 = 0;
        J.qcol = C_BQ + h * 128 + comp * 64; J.kcolT = C_BK + h * 128; J.vcolT = C_BV + h * 128; J.kc8 = comp * 8; J.seg1_row = NLAT + b * CTXL; J.n1 = 4;
        f32x16 O[4]; float m, l;
        attn_run<128, 128, false>(lds, P, J, O, m, l);
        const float inv = 1.f / l;
        if (comp == 1) {
#pragma unroll
            for (int d = 0; d < 4; ++d)
#pragma unroll
                for (int r = 0; r < 16; ++r) XB[(qs * 128 + 32 * d + crow(r, hi)) * 32 + r32] = O[d][r] * inv;
        }
        __syncthreads();
        if (comp == 0) {
            float ss = 0.f;
#pragma unroll
            for (int d = 0; d < 4; ++d)
#pragma unroll
                for (int r = 0; r < 16; ++r) { const float o = O[d][r] * inv - lam * XB[(qs * 128 + 32 * d + crow(r, hi)) * 32 + r32]; O[d][r] = o; ss += o * o; }
            ss += __shfl_xor(ss, 32);
            const float rs = rsqrtf(ss * (1.f / 128.f) + RMS_EPS) * (1.f - lam_init);
            bf16* op = OB + (size_t)(J.qrow + r32) * 512 + h * 128;
#pragma unroll
            for (int d = 0; d < 4; ++d)
#pragma unroll
                for (int rg = 0; rg < 4; ++rg) { const int e0 = 32 * d + 8 * rg + 4 * hi; const f32x4 wv = *(const GAS f32x4*)(dnw + e0);
                    u32x2 w; w.x = cvtpk(O[d][4 * rg] * rs * wv[0], O[d][4 * rg + 1] * rs * wv[1]); w.y = cvtpk(O[d][4 * rg + 2] * rs * wv[2], O[d][4 * rg + 3] * rs * wv[3]);
                    *(GAS u32x2*)(op + e0) = w; }
        }
        __syncthreads();
    }
}

DI int hg_row0(int b, int dir, int c) {
    if (dir == 0) return c < 4 ? NLAT + b * CTXL + 64 * c : b * SEQ + 64 * (c - 4);
    return c < 4 ? NLAT + b * CTXL + 64 * (3 - c) : b * SEQ + 64 * (131 - c);
}
DI void ph_hg1(LAS unsigned char* lds, const bf16* P, const float* LF, float* HU, float* HD, int vcu, int G) {
    const int tid = tid_opaque(), lane = tid & 63, wave = __builtin_amdgcn_readfirstlane(tid >> 6), r32 = lane & 31, hi = lane >> 5;
    LAS unsigned char* KH = lds; LAS unsigned char* VH = lds + 65536;
    for (int u = vcu; u < NB * 2 * NCH; u += G) {
        const int b = u / (2 * NCH), dir = (u / NCH) & 1, c = u % NCH, row0 = hg_row0(b, dir, c);
        const float* lfp = LF + (size_t)row0 * 1024 + dir * 512 + tid;
        float total = 0.f;
#pragma unroll 16
        for (int t = 0; t < 64; ++t) total += lfp[(size_t)t * 1024];
        float pre = 0.f;
#pragma unroll
        for (int c8 = 0; c8 < 8; ++c8) { float kv[8];
#pragma unroll
            for (int j = 0; j < 8; ++j) { const float lf = lfp[(size_t)(8 * c8 + j) * 1024]; const float arg = dir == 0 ? (total - pre - lf) : pre; pre += lf; kv[j] = (1.f - __expf(lf)) * __expf(arg); }
            *(LAS bf16x8*)(KH + tid * 128 + ((c8 ^ ((tid >> 1) & 7)) << 4)) = pack8(kv[0], kv[1], kv[2], kv[3], kv[4], kv[5], kv[6], kv[7]); }
        { const int h = tid >> 7, d = tid & 127; HD[(size_t)(((b * 2 + dir) * 4 + h) * NCH + c) * 128 + d] = __expf(total); }
#pragma unroll
        for (int i = 0; i < 8; ++i) { const int ci = tid + NTHR * i, row = ci >> 6, cc = ci & 63;
            const v4u v = *(const GAS v4u*)(P + (size_t)(row0 + row) * INW + C_CI + cc * 8);
            *(LAS v4u*)(VH + row * 1024 + ((((cc >> 2) ^ (row & 3)) << 6) | ((cc & 3) << 4))) = v; }
        __syncthreads();
        const int head = wave >> 1, q4 = (lane & 15) >> 2, p4 = lane & 3, blk = (lane >> 4) & 1;
        float* hu = HU + (size_t)(((b * 2 + dir) * 4 + head) * NCH + c) * 16384;
#pragma unroll
        for (int ebi = 0; ebi < 2; ++ebi) {
            const int eb = 2 * (wave & 1) + ebi;
            f32x16 acc[4];
#pragma unroll
            for (int k = 0; k < 4; ++k) acc[k] = (f32x16){0.f, 0.f, 0.f, 0.f, 0.f, 0.f, 0.f, 0.f, 0.f, 0.f, 0.f, 0.f, 0.f, 0.f, 0.f, 0.f};
#pragma unroll
            for (int ks = 0; ks < 4; ++ks) {
                const int r0 = 16 * ks + 8 * hi + q4, r1 = r0 + 4; const int c64 = head * 4 + eb;
                const s16x4 lo = tr_read((LAS const char*)(VH + r0 * 1024 + (((c64 ^ (r0 & 3)) << 6) | (blk << 5) | (p4 << 3))));
                const s16x4 hh = tr_read((LAS const char*)(VH + r1 * 1024 + (((c64 ^ (r1 & 3)) << 6) | (blk << 5) | (p4 << 3))));
                const bf16x8 vf = cat8(lo, hh);
#pragma unroll
                for (int dkb = 0; dkb < 4; ++dkb) { const int R = head * 128 + 32 * dkb + r32, ch = 2 * ks + hi;
                    const bf16x8 kf = *(const LAS bf16x8*)(KH + R * 128 + ((ch ^ ((R >> 1) & 7)) << 4));
                    acc[dkb] = MFMA32(vf, kf, acc[dkb]); }
            }
#pragma unroll
            for (int dkb = 0; dkb < 4; ++dkb)
#pragma unroll
                for (int r = 0; r < 16; ++r) hu[(32 * eb + crow(r, hi)) * 128 + 32 * dkb + r32] = acc[dkb][r];
        }
        __syncthreads();
    }
}
DI void ph_hg2(const float* HU, const float* HD, bf16* HS, int vcu, int G) {
    const int gt = vcu * NTHR + tid_opaque(), NT = G * NTHR;
    for (int idx = gt; idx < 16 * 8192; idx += NT) {
        const int chain = idx >> 13, pr = idx & 8191, e = pr >> 6, dk = (pr & 63) * 2;
        const float* up = HU + (size_t)chain * NCH * 16384 + e * 128 + dk; const float* dp = HD + (size_t)chain * NCH * 128 + dk; bf16* sp = HS + (size_t)chain * NCH * 16384 + e * 128 + dk;
        float s0 = 0.f, s1 = 0.f;
#pragma unroll 4
        for (int c = 0; c < NCH; ++c) {
            const f32x2 uu = *(const GAS f32x2*)(up + (size_t)c * 16384), dd = *(const GAS f32x2*)(dp + (size_t)c * 128);
            *(GAS unsigned*)(sp + (size_t)c * 16384) = cvtpk(s0, s1);
            s0 = dd.x * s0 + uu.x; s1 = dd.y * s1 + uu.y;
        }
    }
}
DI void ph_hg3(LAS unsigned char* lds, const bf16* P, const float* LF, const bf16* HS, bf16* OC, const float* hw, bool with_ctx, int vcu, int G) {
    const int tid = tid_opaque(), lane = tid & 63, wave = __builtin_amdgcn_readfirstlane(tid >> 6), tl = lane & 15, kg = lane >> 4;
    LAS float* BC = (LAS float*)lds; LAS unsigned char* VT = lds + 65536; LAS float* CB = (LAS float*)(lds + 81920);
    const int tc_lo = with_ctx ? 0 : 4, ntc = NCH - tc_lo, nun = NB * ntc * 4;
    for (int u = vcu; u < nun; u += G) {
        const int b = u / (ntc * 4), tc = tc_lo + (u / 4) % ntc, h = u & 3;
        const int row0 = tc < 4 ? NLAT + b * CTXL + 64 * tc : b * SEQ + 64 * (tc - 4);
        if (tid < 256) { const int dir = tid >> 7, d = tid & 127; const float* lfp = LF + (size_t)row0 * 1024 + dir * 512 + h * 128 + d; float a = 0.f;
            if (dir == 0) {
#pragma unroll 16
                for (int t = 0; t < 64; ++t) { a += lfp[(size_t)t * 1024]; BC[t * 128 + d] = a; }
            } else {
#pragma unroll 16
                for (int t = 63; t >= 0; --t) { a += lfp[(size_t)t * 1024]; BC[8192 + t * 128 + d] = a; }
            }
        } else {
#pragma unroll
            for (int i = 0; i < 4; ++i) { const int ci = (tid - 256) + 256 * i, row = ci >> 4, cc = ci & 15;
                const v4u v = *(const GAS v4u*)(P + (size_t)(row0 + row) * INW + C_CI + h * 128 + cc * 8);
                *(LAS v4u*)(VT + row * 256 + ((((cc >> 2) ^ (row & 3)) << 6) | ((cc & 3) << 4))) = v; }
        }
        __syncthreads();
        const int dir = wave >> 2, I = wave & 3, t = 16 * I + tl;
        const int cs = dir == 0 ? tc : (tc < 4 ? 3 - tc : 135 - tc);
        const bf16* hs = HS + (size_t)(((b * 2 + dir) * 4 + h) * NCH + cs) * 16384;
        const LAS float* bc = BC + dir * 8192;
        const bool hasb = dir == 0 ? (I > 0) : (I < 3); const int brow = dir == 0 ? 16 * I - 1 : 16 * I + 16;
        bf16x8 qh[4], qt[4];
#pragma unroll
        for (int ks = 0; ks < 4; ++ks) { const int dk0 = 32 * ks + 8 * kg;
            const v4u qw = *(const GAS v4u*)(P + (size_t)(row0 + t) * INW + C_CQ + h * 128 + dk0);
            const f32x4 b0 = *(const LAS f32x4*)(bc + t * 128 + dk0), b1 = *(const LAS f32x4*)(bc + t * 128 + dk0 + 4);
            f32x4 e0 = (f32x4){0.f, 0.f, 0.f, 0.f}, e1 = e0; if (hasb) { e0 = *(const LAS f32x4*)(bc + brow * 128 + dk0); e1 = *(const LAS f32x4*)(bc + brow * 128 + dk0 + 4); }
            const float q0 = bflo(qw.x), q1 = bfhi(qw.x), q2 = bflo(qw.y), q3 = bfhi(qw.y), q4 = bflo(qw.z), q5 = bfhi(qw.z), q6 = bflo(qw.w), q7 = bfhi(qw.w);
            qh[ks] = pack8(q0 * __expf(b0[0]), q1 * __expf(b0[1]), q2 * __expf(b0[2]), q3 * __expf(b0[3]), q4 * __expf(b1[0]), q5 * __expf(b1[1]), q6 * __expf(b1[2]), q7 * __expf(b1[3]));
            qt[ks] = pack8(q0 * __expf(b0[0] - e0[0]), q1 * __expf(b0[1] - e0[1]), q2 * __expf(b0[2] - e0[2]), q3 * __expf(b0[3] - e0[3]),
                           q4 * __expf(b1[0] - e1[0]), q5 * __expf(b1[1] - e1[1]), q6 * __expf(b1[2] - e1[2]), q7 * __expf(b1[3] - e1[3])); }
        f32x4 acc[8];
#pragma unroll
        for (int eb = 0; eb < 8; ++eb) acc[eb] = (f32x4){0.f, 0.f, 0.f, 0.f};
#pragma unroll
        for (int ks = 0; ks < 4; ++ks)
#pragma unroll
            for (int eb = 0; eb < 8; ++eb) { const bf16x8 sf = *(const GAS bf16x8*)(hs + (size_t)(16 * eb + tl) * 128 + 32 * ks + 8 * kg); acc[eb] = MFMA16(sf, qh[ks], acc[eb]); }
        f32x4 att[4];
#pragma unroll
        for (int Jb = 0; Jb < 4; ++Jb) {
            att[Jb] = (f32x4){0.f, 0.f, 0.f, 0.f};
            const bool active = dir == 0 ? (Jb <= I) : (Jb >= I);
            if (active) {
                const int s = 16 * Jb + tl; f32x4 a = (f32x4){0.f, 0.f, 0.f, 0.f};
#pragma unroll
                for (int ks = 0; ks < 4; ++ks) { const int dk0 = 32 * ks + 8 * kg;
                    const float* lfp = LF + (size_t)(row0 + s) * 1024 + dir * 512 + h * 128 + dk0;
                    const f32x4 l0 = *(const GAS f32x4*)lfp, l1 = *(const GAS f32x4*)(lfp + 4);
                    const f32x4 b0 = *(const LAS f32x4*)(bc + s * 128 + dk0), b1 = *(const LAS f32x4*)(bc + s * 128 + dk0 + 4);
                    f32x4 e0 = (f32x4){0.f, 0.f, 0.f, 0.f}, e1 = e0; if (hasb) { e0 = *(const LAS f32x4*)(bc + brow * 128 + dk0); e1 = *(const LAS f32x4*)(bc + brow * 128 + dk0 + 4); }
                    float kv[8];
#pragma unroll
                    for (int j = 0; j < 4; ++j) { kv[j] = (1.f - __expf(l0[j])) * __expf(fminf(e0[j] - b0[j], 80.f)); kv[4 + j] = (1.f - __expf(l1[j])) * __expf(fminf(e1[j] - b1[j], 80.f)); }
                    a = MFMA16(pack8(kv[0], kv[1], kv[2], kv[3], kv[4], kv[5], kv[6], kv[7]), qt[ks], a); }
                if (Jb == I) {
#pragma unroll
                    for (int r = 0; r < 4; ++r) { const int sl = 4 * kg + r; const bool keep = dir == 0 ? (sl <= tl) : (sl >= tl); if (!keep) a[r] = 0.f; }
                }
                att[Jb] = a;
            }
        }
        { const int q4 = tl >> 2, p4 = tl & 3;
#pragma unroll
            for (int pr = 0; pr < 2; ++pr) {
                const bool any = dir == 0 ? (2 * pr <= I) : (2 * pr + 1 >= I);
                if (any) {
                    const f32x4 a0 = att[2 * pr], a1 = att[2 * pr + 1];
                    const bf16x8 ab = pack8(a0[0], a0[1], a0[2], a0[3], a1[0], a1[1], a1[2], a1[3]);
                    const int r0 = 32 * pr + 4 * kg + q4, r1 = r0 + 16;
#pragma unroll
                    for (int eb = 0; eb < 8; ++eb) {
                        const s16x4 lo = tr_read((LAS const char*)(VT + r0 * 256 + ((((eb >> 1) ^ (r0 & 3)) << 6) | ((eb & 1) << 5) | (p4 << 3))));
                        const s16x4 hh = tr_read((LAS const char*)(VT + r1 * 256 + ((((eb >> 1) ^ (r1 & 3)) << 6) | ((eb & 1) << 5) | (p4 << 3))));
                        acc[eb] = MFMA16(cat8(lo, hh), ab, acc[eb]); }
                }
            }
        }
        if (dir == 1) {
#pragma unroll
            for (int eb = 0; eb < 8; ++eb) *(LAS f32x4*)(CB + ((I * 16 + tl) * 128 + 16 * eb + 4 * kg)) = acc[eb];
        }
        __syncthreads();
        if (dir == 0) {
            float ss = 0.f;
#pragma unroll
            for (int eb = 0; eb < 8; ++eb) { acc[eb] = acc[eb] + *(const LAS f32x4*)(CB + ((I * 16 + tl) * 128 + 16 * eb + 4 * kg)); ss += (acc[eb][0] * acc[eb][0] + acc[eb][1] * acc[eb][1]) + (acc[eb][2] * acc[eb][2] + acc[eb][3] * acc[eb][3]); }
            ss += __shfl_xor(ss, 16); ss += __shfl_xor(ss, 32);
            const float rs = rsqrtf(ss * (1.f / 128.f) + RMS_EPS);
#pragma unroll
            for (int eb = 0; eb < 8; ++eb) { const int e0 = 16 * eb + 4 * kg; const f32x4 wv = *(const GAS f32x4*)(hw + e0);
                const u32x2 gw = *(const GAS u32x2*)(P + (size_t)(row0 + t) * INW + C_CG + h * 128 + e0);
                u32x2 w; w.x = cvtpk(acc[eb][0] * rs * wv[0] * bflo(gw.x), acc[eb][1] * rs * wv[1] * bfhi(gw.x)); w.y = cvtpk(acc[eb][2] * rs * wv[2] * bflo(gw.y), acc[eb][3] * rs * wv[3] * bfhi(gw.y));
                *(GAS u32x2*)(OC + (size_t)(row0 + t) * 512 + h * 128 + e0) = w; }
        }
        __syncthreads();
    }
}

DI void ph_r2(LAS unsigned char* lds, const float* xin, const float* cin, float* XA, const bf16* YO, bf16* H, const float* MODl, const float* ng, const float* wr, const float* br,
              unsigned* cnt, int* TOPE, float* GATE, int* RANK, int l, int nrows, int vcu, int G) {
    const int tid = tid_opaque(), lane = tid & 63, wave = __builtin_amdgcn_readfirstlane(tid >> 6);
    for (int i = tid; i < 1024 * 8; i += NTHR) { const int k = i >> 3, ch = i & 7, slot = ((k >> 8) * 4 + (k & 3)) * 64 + ((k >> 2) & 63);
        *(LAS f32x4*)(lds + slot * 128 + ((ch ^ (slot & 7)) << 4)) = *(const GAS f32x4*)(wr + k * 32 + ch * 4); }
    __syncthreads();
    for (int row = vcu * NWAVES + wave; row < nrows; row += G * NWAVES) {
        const int mj = row < NLAT ? row / SEQ : 2; const float* md = MODl + mj * 6144;
        const float* xp = (l == 0) ? (row < NLAT ? xin + (size_t)row * 1024 : cin + (size_t)(row - NLAT) * 1024) : XA + (size_t)row * 1024;
        f32x4 x[4], y[4]; row_ld(xp, lane, x); row_ld_bf(YO + (size_t)row * 1024, lane, y);
        const float ry = row_rstd(y);
#pragma unroll
        for (int j = 0; j < 4; ++j) { const f32x4 g1 = ((const GAS f32x4*)(ng + 1024))[lane + 64 * j], m2 = ((const GAS f32x4*)(md + 2048))[lane + 64 * j]; x[j] = x[j] + m2 * (y[j] * ry * g1); }
        row_st(XA + (size_t)row * 1024, lane, x);
        f32x4 h[4]; row_modulate(x, ng + 2048, md + 3 * 1024, md + 4 * 1024, lane, h);
        row_st_bf(H + (size_t)row * 1024, lane, h);
        float acc[32];
#pragma unroll
        for (int e = 0; e < 32; ++e) acc[e] = 0.f;
#pragma unroll
        for (int j = 0; j < 4; ++j)
#pragma unroll
            for (int i = 0; i < 4; ++i) { const int slot = (j * 4 + i) * 64 + lane; const float hv = h[j][i];
#pragma unroll
                for (int ch = 0; ch < 8; ++ch) { const f32x4 w = *(const LAS f32x4*)(lds + slot * 128 + ((ch ^ (slot & 7)) << 4));
                    acc[4 * ch] += hv * w[0]; acc[4 * ch + 1] += hv * w[1]; acc[4 * ch + 2] += hv * w[2]; acc[4 * ch + 3] += hv * w[3]; }
                __builtin_amdgcn_sched_barrier(0); }
#define R2_STEP(N, BIT) _Pragma("unroll") for (int i = 0; i < N; ++i) { const float lo = acc[i], hi = acc[i + N]; const bool up = (lane & BIT) != 0; const float keep = up ? hi : lo, send = up ? lo : hi; acc[i] = keep + __shfl_xor(send, BIT); }
        R2_STEP(16, 32) R2_STEP(8, 16) R2_STEP(4, 8) R2_STEP(2, 4) R2_STEP(1, 2)
#undef R2_STEP
        const int me = (lane >> 1) & 31;
        float lg = acc[0] + __shfl_xor(acc[0], 1) + br[me];
        float tv[4]; int te[4];
#pragma unroll
        for (int k = 0; k < 4; ++k) { float bv = lg; int bi = me;
#pragma unroll
            for (int o = 1; o < 64; o <<= 1) { const float ov = __shfl_xor(bv, o); const int oi = __shfl_xor(bi, o); if (ov > bv || (ov == bv && oi < bi)) { bv = ov; bi = oi; } }
            tv[k] = bv; te[k] = bi; if (me == bi) lg = -INFINITY; }
        const float e1 = __expf(tv[1] - tv[0]), e2 = __expf(tv[2] - tv[0]), e3 = __expf(tv[3] - tv[0]), inv = 1.f / (1.f + e1 + e2 + e3);
        if (lane < 4) { const int ek = lane == 0 ? te[0] : lane == 1 ? te[1] : lane == 2 ? te[2] : te[3]; const float gk = (lane == 0 ? 1.f : lane == 1 ? e1 : lane == 2 ? e2 : e3) * inv;
            const unsigned rk = atomicAdd(cnt + ek, 1u);
            TOPE[row * 4 + lane] = ek; GATE[row * 4 + lane] = gk; RANK[row * 4 + lane] = (int)rk; }
    }
}
DI void moe_tables(volatile LAS int* tb, const unsigned* cnt) {
    if (tid_opaque() == 0) { int t = 0;
        for (int e = 0; e < 32; ++e) { const int c = (int)__hip_atomic_load(cnt + e, __ATOMIC_RELAXED, __HIP_MEMORY_SCOPE_AGENT); tb[e] = t; tb[40 + e] = t * 256; t += (c + 255) >> 8; }
        tb[32] = t; }
    __syncthreads();
}
DI void ph_r3(volatile LAS int* tb, const bf16* H, bf16* XG, const int* TOPE, const int* RANK, int* DEST, int nrows, int vcu, int G) {
    const int lane = tid_opaque() & 63, wave = __builtin_amdgcn_readfirstlane(tid_opaque() >> 6);
    for (int row = vcu * NWAVES + wave; row < nrows; row += G * NWAVES) {
        const v4u h0 = ((const GAS v4u*)(H + (size_t)row * 1024))[lane], h1 = ((const GAS v4u*)(H + (size_t)row * 1024))[lane + 64];
#pragma unroll
        for (int k = 0; k < 4; ++k) { const int e = TOPE[row * 4 + k], d = tb[40 + e] + RANK[row * 4 + k];
            if (lane == 0) DEST[row * 4 + k] = d;
            ((GAS v4u*)(XG + (size_t)d * 1024))[lane] = h0; ((GAS v4u*)(XG + (size_t)d * 1024))[lane + 64] = h1; }
    }
}
DI void ph_r4(float* XA, const bf16* YS, const int* DEST, const float* GATE, const float* MODl, const float* ng, float* out, bf16* H, const float* MODn, const float* ngn, bool last, int nrows, int vcu, int G) {
    const int lane = tid_opaque() & 63, wave = __builtin_amdgcn_readfirstlane(tid_opaque() >> 6);
    for (int row = vcu * NWAVES + wave; row < nrows; row += G * NWAVES) {
        const int mj = row < NLAT ? row / SEQ : 2; const float* md = MODl + mj * 6144;
        f32x4 f[4];
#pragma unroll
        for (int j = 0; j < 4; ++j) f[j] = (f32x4){0.f, 0.f, 0.f, 0.f};
#pragma unroll
        for (int k = 0; k < 4; ++k) { const int d = DEST[row * 4 + k]; const float g = GATE[row * 4 + k]; f32x4 y[4]; row_ld_bf(YS + (size_t)d * 1024, lane, y);
#pragma unroll
            for (int j = 0; j < 4; ++j) f[j] = f[j] + y[j] * g; }
        const float rf = row_rstd(f);
        f32x4 x[4]; row_ld(XA + (size_t)row * 1024, lane, x);
#pragma unroll
        for (int j = 0; j < 4; ++j) { const f32x4 g3 = ((const GAS f32x4*)(ng + 3 * 1024))[lane + 64 * j], m5 = ((const GAS f32x4*)(md + 5 * 1024))[lane + 64 * j]; x[j] = x[j] + m5 * (f[j] * rf * g3); }
        if (last) row_st(out + (size_t)row * 1024, lane, x);
        else { row_st(XA + (size_t)row * 1024, lane, x);
            f32x4 h[4]; row_modulate(x, ngn, MODn + mj * 6144, MODn + mj * 6144 + 1024, lane, h); row_st_bf(H + (size_t)row * 1024, lane, h); }
    }
}

#ifndef PHM
#define PHM 0x7fff
#endif
struct Args { const float* in[21]; float* out; unsigned char* ws; };
__global__ void __launch_bounds__(NTHR, 2) fwd_mega(Args a) {
    extern __shared__ __attribute__((aligned(16))) unsigned char lds_raw[];
    LAS unsigned char* lds = (LAS unsigned char*)lds_raw;
    volatile LAS unsigned* MISC = (volatile LAS unsigned*)(lds + MISC_OFF);
    volatile LAS int* MTB = (volatile LAS int*)(lds + MISC_OFF + 256);
    const int tid = tid_opaque(), lane = tid & 63, wave = __builtin_amdgcn_readfirstlane(tid >> 6);
    const int G = gridDim.x, bx = blockIdx.x, vcu = (G % 8 == 0) ? (bx % 8) * (G / 8) + bx / 8 : bx;
    unsigned char* ws = a.ws;
    gu32* ctl = (gu32*)(ws + WS_CTL);
    float* SM = (float*)(ws + WS_SMALL);
    bf16* WIN = (bf16*)(ws + WS_WIN); bf16* WBR = (bf16*)(ws + WS_WBR); bf16* WO = (bf16*)(ws + WS_WO); bf16* WGU = (bf16*)(ws + WS_WGU); bf16* WDN = (bf16*)(ws + WS_WDN);
    float* XA = (float*)(ws + WS_XA); bf16* H = (bf16*)(ws + WS_H); bf16* P = (bf16*)(ws + WS_P); float* LF = (float*)(ws + WS_LF); bf16* O3 = (bf16*)(ws + WS_O3);
    float* HU = (float*)(ws + WS_HU); float* HD = (float*)(ws + WS_HD); bf16* HS = (bf16*)(ws + WS_HS); float* YF = (float*)(ws + WS_YF); bf16* Y = (bf16*)(ws + WS_Y); bf16* YO = (bf16*)(ws + WS_YO);
    int* TOPE = (int*)(ws + WS_ROUTE); float* GATE = (float*)(ws + WS_ROUTE + 524288 * 1); int* RANK = (int*)(ws + WS_ROUTE + 524288 * 2); int* DEST = (int*)(ws + WS_ROUTE + 524288 * 3);
    bf16* XG = (bf16*)(ws + WS_XG); bf16* ACT = (bf16*)(ws + WS_ACT); bf16* YS = (bf16*)(ws + WS_YS);
    const float* x_in = a.in[0]; const float* c_in = a.in[1]; const float* ctx_in = a.in[2]; const float* cctx_in = a.in[3];

    for (int u = tid; u < (LDS_BYTES - LDSCTL_OFF) / 4; u += NTHR) ((LAS unsigned*)(lds + LDSCTL_OFF))[u] = 0u;
    __syncthreads();
    XcdBarrier bar = xcd_barrier_post((unsigned*)(ctl + CW_BAR), MISC + 8);
#define GRID_BAR() xcd_barrier(bar)

    if (PHM & 1) ph_mod(lds, c_in, cctx_in, a.in[4], a.in[5], SM + SM_MOD, vcu, G);
    if (PHM & 1) ph_tables(SM, a.in[11], a.in[9], vcu, G);
    GRID_BAR();
    if (PHM & 2) {
        LAS float* scr = (LAS float*)(lds + wave * 16384);
        const int gw = vcu * NWAVES + wave, NGW = G * NWAVES;
        const TGroup g0{a.in[7], WIN, 1024, INW, 2, 0}, g1{a.in[13], WBR, 512, 1024, 6, 0}, g2{a.in[14], WO, 1024, 1024, 2, 0}, g3{a.in[17], WGU, 1024, 2048, 64, 1}, g4{a.in[19], WDN, 1024, 1024, 64, 0};
        const int total = 2 * 16 * 248 + 6 * 8 * 32 + 2 * 16 * 32 + 64 * 16 * 64 + 64 * 16 * 32;
        for (int it = gw; it < total; it += NGW) { int r = it;
            if (p0_group(g0, r, scr, lane)) continue; if (p0_group(g1, r, scr, lane)) continue; if (p0_group(g2, r, scr, lane)) continue; if (p0_group(g3, r, scr, lane)) continue; p0_group(g4, r, scr, lane); }
        const float* ng = a.in[6];
        for (int row = gw; row < NTOK; row += NGW) { const int mj = row < NLAT ? row / SEQ : 2; const float* md = SM + SM_MOD + mj * 6144;
            const float* xp = row < NLAT ? x_in + (size_t)row * 1024 : ctx_in + (size_t)(row - NLAT) * 1024;
            f32x4 x[4], h[4]; row_ld(xp, lane, x); row_modulate(x, ng, md, md + 1024, lane, h); row_st_bf(H + (size_t)row * 1024, lane, h); }
    }
    GRID_BAR();

    for (int l = 0; l < DEPTH; ++l) {
        const bool last = (l == DEPTH - 1);
        const float* MODl = SM + SM_MOD + l * 3 * 6144;
        const float* ng = a.in[6] + l * 4096;
        const int nrows = last ? NLAT : NTOK;
        if (PHM & 4) { pg8::Gemm g{H, WIN + (size_t)l * INW * 1024, NTOK, INW, 1024}; pg8::StaticOrder S; S.init(NTOK, INW, G, bx);
          EpiIn E{P, LF, SM + SM_TAB, SM + SM_LB + l * 1024};
          pg8::gemm_phase<EpiIn, pg8::StaticOrder, true, true>(lds, g, S, E); }
        GRID_BAR();
        if (PHM & 8) ph_hg1(lds, P, LF, HU, HD, vcu, G);
        if (PHM & 16) ph_attn_a(lds, P, O3, a.in[8] + l * 8, !last, vcu, G);
        if (PHM & 32) ph_attn_b(lds, P, O3 + (size_t)NTOK * 512, a.in[10] + l * 128, SM[SM_LAM + l], SM[SM_LAM + 2 + l], !last, vcu, G);
        GRID_BAR();
        if (PHM & 64) ph_hg2(HU, HD, HS, vcu, G);
        GRID_BAR();
        if (PHM & 128) ph_hg3(lds, P, LF, HS, O3 + (size_t)2 * NTOK * 512, a.in[12] + l * 128, !last, vcu, G);
        GRID_BAR();
        if (PHM & 256) { pg8::Gemm g{O3, WBR + (size_t)l * 3 * 1024 * 512, 3 * NTOK, 3 * 1024, 512}; MergeOrder S{G, vcu, (nrows / 256) * 4};
          EpiMerge E{P, YF, Y};
          pg8::gemm_phase<EpiMerge, MergeOrder, true, true>(lds, g, S, E); }
        GRID_BAR();
        if (PHM & 512) { pg8::Gemm g{Y, WO + (size_t)l * 1024 * 1024, nrows, 1024, 1024}; pg8::StaticOrder S; S.init(nrows, 1024, G, bx);
          EpiPlain E{YO, 1024, nullptr, 4};
          pg8::gemm_phase<EpiPlain, pg8::StaticOrder, true, true>(lds, g, S, E); }
        GRID_BAR();
        unsigned* cnt = (unsigned*)(ctl + CW_CNT) + l * 32;
        if (PHM & 1024) ph_r2(lds, x_in, ctx_in, XA, YO, H, MODl, ng, a.in[15] + l * 32768, a.in[16] + l * 32, cnt, TOPE, GATE, RANK, l, nrows, vcu, G);
        GRID_BAR();
        moe_tables(MTB, cnt);
        if (PHM & 2048) ph_r3(MTB, H, XG, TOPE, RANK, DEST, nrows, vcu, G);
        GRID_BAR();
        if (PHM & 4096) { pg8::Gemm g{XG, WGU + (size_t)l * 32 * 2048 * 1024, XG_ROWS, 32 * 2048, 1024}; MoeOrder S{MTB, 8, G, vcu};
          EpiSwiglu E{ACT, a.in[18] + (size_t)l * 32 * 2048};
          pg8::gemm_phase<EpiSwiglu, MoeOrder, true, true>(lds, g, S, E); }
        GRID_BAR();
        if (PHM & 8192) { pg8::Gemm g{ACT, WDN + (size_t)l * 32 * 1024 * 1024, XG_ROWS, 32 * 1024, 1024}; MoeOrder S{MTB, 4, G, vcu};
          EpiPlain E{YS, 1024, a.in[20] + (size_t)l * 32 * 1024, 4};
          pg8::gemm_phase<EpiPlain, MoeOrder, true, true>(lds, g, S, E); }
        GRID_BAR();
        if (PHM & 16384) ph_r4(XA, YS, DEST, GATE, MODl, ng, a.out, H, SM + SM_MOD + (l + 1 < DEPTH ? (l + 1) * 3 * 6144 : 0), a.in[6] + (l + 1 < DEPTH ? (l + 1) * 4096 : 0), last, nrows, vcu, G);
        if (!last) GRID_BAR();
    }
    if (__hip_atomic_load((gu32*)((unsigned*)(ctl + CW_BAR) + XB_TMO), RLX_AGENT) != 0u) { if (bx == 0) for (int i = tid; i < 4096; i += NTHR) a.out[i] = __builtin_nanf(""); }
}

extern "C" void kernel_launch(void* const* d_in, const int* in_sizes, int n_in, void* d_out, int out_size, void* d_ws, size_t ws_size, hipStream_t stream) {
    static int grid = 0;
    if (grid == 0) {
        if (n_in != 21 || out_size != NLAT * DM || ws_size < WS_END) { fprintf(stderr, "kernel_launch: unexpected shapes (n_in %d, out %d, ws %zu)\n", n_in, out_size, ws_size); grid = -1; return; }
        int dev = 0, cus = 0, per_cu = 0;
        if (hipGetDevice(&dev) != hipSuccess || hipDeviceGetAttribute(&cus, hipDeviceAttributeMultiprocessorCount, dev) != hipSuccess) { grid = -1; return; }
        if (hipFuncSetAttribute((const void*)fwd_mega, hipFuncAttributeMaxDynamicSharedMemorySize, LDS_BYTES) != hipSuccess) { fprintf(stderr, "kernel_launch: hipFuncSetAttribute failed\n"); grid = -1; return; }
        if (hipOccupancyMaxActiveBlocksPerMultiprocessor(&per_cu, (const void*)fwd_mega, NTHR, LDS_BYTES) != hipSuccess || per_cu < 1) { fprintf(stderr, "kernel_launch: occupancy query reports %d\n", per_cu); per_cu = 1; }
        (void)hipGetLastError();
        grid = cus;
    }
    if (grid < 0) return;
    (void)hipMemsetAsync((char*)d_ws + WS_CTL, 0, CTL_ZERO_BYTES, stream);
    Args a{};
    for (int i = 0; i < 21; ++i) a.in[i] = (const float*)d_in[i];
    a.out = (float*)d_out; a.ws = (unsigned char*)d_ws;
    hipLaunchKernelGGL(fwd_mega, dim3(grid), dim3(NTHR), LDS_BYTES, stream, a);
}
```

```cpp
#include <hip/hip_runtime.h>
#include <cstdio>
#include <cstdint>
namespace pg8 {
#define PG8_LAS __attribute__((address_space(3)))
typedef unsigned short bf16_t;
typedef short bf16x8 __attribute__((ext_vector_type(8)));
typedef float f32x4 __attribute__((ext_vector_type(4)));
typedef unsigned u32x4 __attribute__((ext_vector_type(4)));
constexpr int BM = 256, BK = 64, HALF = 128, HTB = HALF * BK * 2  , STAGE_BYTES = 8 * HTB, NXCD = 8, WGM = 8;

__host__ __device__ __forceinline__ int lds_byte(int r, int c) { const int st = (r >> 4) * 2 + (c >> 5), rr = r & 15, cc = c & 31, ob = rr * 64 + cc * 2; return st * 1024 + (ob ^ (((ob >> 9) & 1) << 5)); }
__host__ __device__ __forceinline__ void stage_rc(int b, int& R, int& C) { const int st = b / 1024, sb = b % 1024, swz = sb ^ (((sb >> 9) & 1) << 5); R = (st >> 1) * 16 + swz / 64; C = (st & 1) * 32 + (swz % 64) / 2; }
__host__ __device__ __forceinline__ int perm32(int rho) { const int n = rho >> 4, i = rho & 15; return 8 * (i >> 2) + 4 * n + (i & 3); }

struct Unit { int pm, pn; };
struct Gemm { const bf16_t* A; const bf16_t* Bt; int M, N, K; };

struct StaticOrder {
    int nM, nN, nwg, G, c;
    __host__ __device__ void init(int M, int N, int G_, int c_) { nM = M / BM; nN = N / BM; nwg = nM * nN; G = G_; c = c_; }
    __host__ __device__ bool next(int i, Unit& u) const {
        const long L = (long)i * G + c; if (L >= nwg) return false;
        int wgid = (int)L; { const int q = nwg / NXCD, r = nwg % NXCD, xcd = wgid % NXCD, off = wgid / NXCD; wgid = (xcd < r ? xcd * (q + 1) : r * (q + 1) + (xcd - r) * q) + off; }
        const int nig = WGM * nN, gid = wgid / nig, fm = gid * WGM, gsz = (nM - fm) < WGM ? (nM - fm) : WGM;
        u.pm = fm + ((wgid % nig) % gsz); u.pn = (wgid % nig) / gsz; return true;
    }
    __device__ __forceinline__ void a_ready(const Unit&) const {}
    __device__ __forceinline__ void done(const Unit&) const {}
};

template <class Epi, class Sched, bool ALIGN_EPI = false, bool SP2 = false, int ES = 2>
__device__ __forceinline__ void gemm_phase(PG8_LAS unsigned char* lds, const Gemm g, const Sched& S, const Epi& E) {
    int tid_ = threadIdx.x; asm volatile("" : "+v"(tid_));
    const int tid = tid_, wid = __builtin_amdgcn_readfirstlane(tid >> 6), lane = tid & 63, wr = wid >> 2, wc = wid & 3, fr = lane & 15, fq = lane >> 4;
    const int K = g.K, nt = K * ES / 128;
    unsigned voffA[2], voffB[2];
#pragma unroll
    for (int i = 0; i < 2; ++i) { int R, C; stage_rc(tid * 16 + i * 8192, R, C); const int Rb = Epi::PERM ? ((R & ~31) + perm32(R & 31)) : R;
        voffA[i] = (unsigned)(R * K * ES + C * 2); voffB[i] = (unsigned)(Rb * K * ES + C * 2); }
    const size_t kstep = (size_t)(BK * 2);
    const size_t hstep = (size_t)HALF * K * ES;
    const size_t tstep = 2 * hstep;
    const unsigned ldsw = (unsigned)wid * 1024u;
    const int aoff = lds_byte(wr * 64 + fr, fq * 8), boff = lds_byte(wc * 32 + fr, fq * 8);
#define PG8_SA(b, h) (((b) * 2 + (h)) * HTB)
#define PG8_SB(b, h) ((4 + (b) * 2 + (h)) * HTB)
#define PG8_STAGE(bufoff, gbase, voff) do { _Pragma("unroll") for (int _i = 0; _i < 2; ++_i) \
        __builtin_amdgcn_global_load_lds((const unsigned*)((const char*)(gbase) + (voff)[_i]), (PG8_LAS unsigned*)(lds + (bufoff) + ldsw + _i * 8192), 16, 0, 0); } while (0)
#define PG8_LDA(dst, b, h) do { _Pragma("unroll") for (int m = 0; m < 4; ++m) _Pragma("unroll") for (int k = 0; k < 2; ++k) dst[m][k] = *(const PG8_LAS bf16x8*)(lds + PG8_SA(b, h) + aoff + m * 2048 + k * 1024); } while (0)
#define PG8_LDB(dst, b, h) do { _Pragma("unroll") for (int n = 0; n < 2; ++n) _Pragma("unroll") for (int k = 0; k < 2; ++k) dst[n][k] = *(const PG8_LAS bf16x8*)(lds + PG8_SB(b, h) + boff + n * 2048 + k * 1024); } while (0)
#define PG8_MMA(ai, bj, At, Bt) do { __builtin_amdgcn_s_setprio(1); _Pragma("unroll") for (int m = 0; m < 4; ++m) _Pragma("unroll") for (int n = 0; n < 2; ++n) _Pragma("unroll") for (int k = 0; k < 2; ++k) \
        acc[ai][bj][m][n] = __builtin_amdgcn_mfma_f32_16x16x32_bf16(Bt[n][k], At[m][k], acc[ai][bj][m][n], 0, 0, 0); __builtin_amdgcn_s_setprio(0); } while (0)
    typedef int v8i_t __attribute__((ext_vector_type(8)));
#define PG8_CAT8(x0, x1) __builtin_shufflevector(__builtin_bit_cast(u32x4, (x0)), __builtin_bit_cast(u32x4, (x1)), 0, 1, 2, 3, 4, 5, 6, 7)
#define PG8_MMA8(ai, bj, At, Bt) do { __builtin_amdgcn_s_setprio(1); _Pragma("unroll") for (int m = 0; m < 4; ++m) _Pragma("unroll") for (int n = 0; n < 2; ++n) { \
        const v8i_t a8_ = __builtin_bit_cast(v8i_t, PG8_CAT8(Bt[n][0], Bt[n][1])), b8_ = __builtin_bit_cast(v8i_t, PG8_CAT8(At[m][0], At[m][1])); \
        asm volatile("v_mfma_scale_f32_16x16x128_f8f6f4 %0, %1, %2, %0, %3, %3 op_sel_hi:[0,0,0]" : "+v"(acc[ai][bj][m][n]) : "v"(a8_), "v"(b8_), "v"(0x7f7f7f7f)); } \
        __builtin_amdgcn_s_setprio(0); } while (0)
#define PG8_MMAX(ai, bj, At, Bt) do { if constexpr (ES == 1) PG8_MMA8(ai, bj, At, Bt); else PG8_MMA(ai, bj, At, Bt); } while (0)
#define PG8_WAIT_V(n) asm volatile("s_waitcnt vmcnt(" #n ")" ::: "memory")
#define PG8_WAIT_L(n) asm volatile("s_waitcnt lgkmcnt(" #n ")" ::: "memory")
#define PG8_BAR __builtin_amdgcn_s_barrier()
#define PG8_SCHED __builtin_amdgcn_sched_barrier(0)
    Unit cur, nxt; int ui = 0;
    if (!S.next(0, cur)) return;
    f32x4 acc[2][2][4][2];
#pragma unroll
    for (int a = 0; a < 2; ++a)
#pragma unroll
        for (int b = 0; b < 2; ++b)
#pragma unroll
            for (int m = 0; m < 4; ++m)
#pragma unroll
                for (int n = 0; n < 2; ++n) acc[a][b][m][n] = (f32x4){0.f, 0.f, 0.f, 0.f};
    bf16x8 At[4][2], B0[2][2], B1[2][2];
    const char* cA = (const char*)g.A + (size_t)cur.pm * tstep; const char* cB = (const char*)g.Bt + (size_t)cur.pn * tstep;
    S.a_ready(cur);
    if constexpr (SP2) {
        PG8_STAGE(PG8_SB(0, 0), cB, voffB); PG8_STAGE(PG8_SB(0, 1), cB + hstep, voffB); PG8_STAGE(PG8_SA(0, 0), cA, voffA); PG8_STAGE(PG8_SA(0, 1), cA + hstep, voffA);
        if (wr == 1) PG8_BAR;
        PG8_WAIT_V(2); PG8_BAR;
        PG8_STAGE(PG8_SB(1, 0), cB + kstep, voffB); PG8_STAGE(PG8_SA(1, 0), cA + kstep, voffA); PG8_STAGE(PG8_SB(1, 1), cB + hstep + kstep, voffB);
        PG8_WAIT_V(6); PG8_BAR;
    } else {
        PG8_STAGE(PG8_SB(0, 0), cB, voffB); PG8_STAGE(PG8_SA(0, 0), cA, voffA); PG8_STAGE(PG8_SB(0, 1), cB + hstep, voffB); PG8_STAGE(PG8_SA(0, 1), cA + hstep, voffA);
        if (wr == 1) PG8_BAR;
        PG8_WAIT_V(4); PG8_BAR;
        PG8_STAGE(PG8_SB(1, 0), cB + kstep, voffB); PG8_STAGE(PG8_SA(1, 0), cA + kstep, voffA); PG8_STAGE(PG8_SB(1, 1), cB + hstep + kstep, voffB);
        PG8_WAIT_V(6); PG8_BAR;
    }
    for (;;) {
        const bool has_next = S.next(ui + 1, nxt);
        const char* nA = has_next ? (const char*)g.A + (size_t)nxt.pm * tstep : cA; const char* nB = has_next ? (const char*)g.Bt + (size_t)nxt.pn * tstep : cB;
        for (int t = 0; t < nt; t += 2) {
            if constexpr (Epi::KHOOK) { if (t == 8 || t == 16) E.khook(acc, cur, t >> 3, wr, wc, fr, fq); }
            const bool last = (t == nt - 2);
            const char* a1 = cA + (size_t)(t + 1) * kstep;
            const char* a2 = last ? nA : cA + (size_t)(t + 2) * kstep; const char* b2 = last ? nB : cB + (size_t)(t + 2) * kstep;
            const char* a3 = a2 + kstep; const char* b3 = b2 + kstep;
            if (last && has_next) S.a_ready(nxt);
            if constexpr (SP2) {
            PG8_LDB(B0, 0, 0); PG8_LDB(B1, 0, 1); PG8_SCHED; PG8_LDA(At, 0, 0); PG8_STAGE(PG8_SA(1, 1), a1 + hstep, voffA);
            PG8_WAIT_V(8); PG8_WAIT_L(0); PG8_BAR; PG8_MMAX(0, 0, At, B0); PG8_MMAX(0, 1, At, B1); PG8_BAR; PG8_SCHED;
            PG8_LDA(At, 0, 1); PG8_STAGE(PG8_SB(0, 0), b2, voffB); PG8_STAGE(PG8_SB(0, 1), b2 + hstep, voffB); PG8_STAGE(PG8_SA(0, 0), a2, voffA);
            PG8_WAIT_V(8); PG8_WAIT_L(0); PG8_BAR; PG8_MMAX(1, 0, At, B0); PG8_MMAX(1, 1, At, B1); PG8_BAR; PG8_SCHED;
            PG8_LDB(B0, 1, 0); PG8_LDB(B1, 1, 1); PG8_SCHED; PG8_LDA(At, 1, 0); PG8_STAGE(PG8_SA(0, 1), a2 + hstep, voffA);
            PG8_WAIT_V(8); PG8_WAIT_L(0); PG8_BAR; PG8_MMAX(0, 0, At, B0); PG8_MMAX(0, 1, At, B1); PG8_BAR; PG8_SCHED;
            PG8_LDA(At, 1, 1); PG8_STAGE(PG8_SB(1, 0), b3, voffB); PG8_STAGE(PG8_SB(1, 1), b3 + hstep, voffB); PG8_STAGE(PG8_SA(1, 0), a3, voffA);
            PG8_WAIT_V(8); PG8_WAIT_L(0); PG8_BAR; PG8_MMAX(1, 0, At, B0); PG8_MMAX(1, 1, At, B1); PG8_BAR; PG8_SCHED;
            } else {
            PG8_LDB(B0, 0, 0); PG8_SCHED; PG8_LDA(At, 0, 0); PG8_STAGE(PG8_SA(1, 1), a1 + hstep, voffA);
            PG8_WAIT_L(8); PG8_BAR; PG8_WAIT_L(0); PG8_MMAX(0, 0, At, B0); PG8_BAR; PG8_SCHED;
            PG8_LDB(B1, 0, 1); PG8_STAGE(PG8_SB(0, 0), b2, voffB);
            PG8_BAR; PG8_WAIT_L(0); PG8_MMAX(0, 1, At, B1); PG8_BAR;
            PG8_LDA(At, 0, 1); PG8_STAGE(PG8_SA(0, 0), a2, voffA);
            PG8_BAR; PG8_WAIT_L(0); PG8_MMAX(1, 0, At, B0); PG8_BAR; PG8_SCHED;
            PG8_STAGE(PG8_SB(0, 1), b2 + hstep, voffB);
            PG8_WAIT_V(6); PG8_BAR; PG8_MMAX(1, 1, At, B1); PG8_BAR;
            PG8_LDB(B0, 1, 0); PG8_SCHED; PG8_LDA(At, 1, 0); PG8_STAGE(PG8_SA(0, 1), a2 + hstep, voffA);
            PG8_WAIT_L(8); PG8_BAR; PG8_WAIT_L(0); PG8_MMAX(0, 0, At, B0); PG8_BAR; PG8_SCHED;
            PG8_LDB(B1, 1, 1); PG8_STAGE(PG8_SB(1, 0), b3, voffB);
            PG8_BAR; PG8_WAIT_L(0); PG8_MMAX(0, 1, At, B1); PG8_BAR;
            PG8_LDA(At, 1, 1); PG8_STAGE(PG8_SA(1, 0), a3, voffA);
            PG8_BAR; PG8_WAIT_L(0); PG8_MMAX(1, 0, At, B0); PG8_BAR; PG8_SCHED;
            PG8_STAGE(PG8_SB(1, 1), b3 + hstep, voffB);
            PG8_WAIT_V(6); PG8_BAR; PG8_MMAX(1, 1, At, B1); PG8_BAR;
            }
        }
        if constexpr (ES == 1) asm volatile("s_nop 15\n\ts_nop 7" ::: "memory");
        if constexpr (ALIGN_EPI) { if (wr == 0) PG8_BAR; }
        if constexpr (!Epi::AFTER_DRAIN) { E(acc, cur, wr, wc, fr, fq); S.done(cur); }
        if (!has_next) break;
#pragma unroll
        for (int a = 0; a < 2; ++a)
#pragma unroll
            for (int b = 0; b < 2; ++b)
#pragma unroll
                for (int m = 0; m < 4; ++m)
#pragma unroll
                    for (int n = 0; n < 2; ++n) acc[a][b][m][n] = (f32x4){0.f, 0.f, 0.f, 0.f};
        cur = nxt; cA = nA; cB = nB; ++ui;
        if constexpr (ALIGN_EPI) { if (wr == 1) PG8_BAR; }
    }
    PG8_WAIT_V(0);
    if constexpr (!ALIGN_EPI) { if (wr == 0) PG8_BAR; }
    PG8_BAR;
    if constexpr (Epi::AFTER_DRAIN) { E.fused(acc, cur, wr, wc, fr, fq, lds, wid, lane); S.done(cur); }
#undef PG8_SA
#undef PG8_SB
#undef PG8_STAGE
#undef PG8_LDA
#undef PG8_LDB
#undef PG8_MMA
#undef PG8_MMA8
#undef PG8_MMAX
#undef PG8_CAT8
#undef PG8_WAIT_V
#undef PG8_WAIT_L
#undef PG8_BAR
#undef PG8_SCHED
}
}
#define GAS __attribute__((address_space(1)))
#define LAS __attribute__((address_space(3)))
typedef unsigned short bf16;
typedef unsigned v4u __attribute__((ext_vector_type(4)));
typedef float f32x4 __attribute__((ext_vector_type(4)));
typedef short bf16x8 __attribute__((ext_vector_type(8)));
typedef GAS unsigned gu32;
typedef GAS unsigned long long gu64;
#define RLX_AGENT __ATOMIC_RELAXED, __HIP_MEMORY_SCOPE_AGENT
#define LDS_WAIT() asm volatile("s_waitcnt lgkmcnt(0)" ::: "memory")
#define VM_WAIT() asm volatile("s_waitcnt vmcnt(0)" ::: "memory")
__device__ __forceinline__ unsigned long long rt() { return __builtin_amdgcn_s_memrealtime(); }
__device__ __forceinline__ unsigned f2bf(float f) { unsigned u = __builtin_bit_cast(unsigned, f); return (u + 0x7fffu + ((u >> 16) & 1u)) >> 16; }
__device__ __forceinline__ unsigned pk2(float lo, float hi) { return f2bf(lo) | (f2bf(hi) << 16); }

#define XB_TMO      128
#define XB_XCNT(j)  (256  + 64 * (j))
#define XB_XSUB(j)  (1280 + 64 * (j))
#define XB_XGEN(j)  (2304 + 64 * (j))
#define XB_TOP      3328
#define XB_TOPGEN   3392
#define XCD_BAR_WORDS 3456
#define XB_SPIN_CAP (1u << 18)

__device__ __forceinline__ unsigned xb_ld(unsigned* p)              { return __hip_atomic_load(p, __ATOMIC_RELAXED, __HIP_MEMORY_SCOPE_AGENT); }
__device__ __forceinline__ unsigned xb_add(unsigned* p, unsigned v) { return __hip_atomic_fetch_add(p, v, __ATOMIC_RELAXED, __HIP_MEMORY_SCOPE_AGENT); }
__device__ __forceinline__ unsigned xb_xcc_id() { return (unsigned)__builtin_amdgcn_s_getreg((3 << 11) | 20) & 0xFu; }
#define XB_SPIN(cond, bar) do { unsigned _sp = 0; while (cond) { __builtin_amdgcn_s_sleep(1); \
    if ((++_sp & 255u) == 0u) { if (xb_ld(&(bar)[XB_TMO])) break; if (_sp > XB_SPIN_CAP) { atomicAdd(&(bar)[XB_TMO], 1u); break; } } } } while (0)

struct XcdBarrier {
    unsigned* bar; unsigned x;
    volatile LAS unsigned* st;
};

__device__ __forceinline__ XcdBarrier xcd_barrier_post(unsigned* bar, volatile LAS unsigned* st) {
    XcdBarrier b; b.bar = bar; b.x = xb_xcc_id(); b.st = st;
    if (threadIdx.x == 0) (void)xb_add(&bar[XB_XCNT(b.x)], 1u);
    return b;
}
__device__ __forceinline__ void xcd_barrier_complete(unsigned* bar, unsigned x, unsigned& nloc, unsigned& nx) {
    const unsigned G = gridDim.x * gridDim.y * gridDim.z;
    unsigned sum, cnt, mine, sp = 0u;
    for (;;) {
        sum = 0u; cnt = 0u; mine = 0u;
#pragma unroll
        for (unsigned j = 0; j < 16; ++j) { const unsigned c = xb_ld(&bar[XB_XCNT(j)]); sum += c; cnt += (c > 0u) ? 1u : 0u; mine = (j == x) ? c : mine; }
        if (sum == G) break;
        __builtin_amdgcn_s_sleep(1);
        if ((++sp & 255u) == 0u) { if (xb_ld(&bar[XB_TMO])) break; if (sp > XB_SPIN_CAP) { atomicAdd(&bar[XB_TMO], 1u); break; } }
    }
    nloc = mine > 0u ? mine : 1u; nx = cnt > 0u ? cnt : 1u;
}

__device__ __forceinline__ void xcd_barrier(const XcdBarrier& b) {
    asm volatile("s_waitcnt vmcnt(0)" ::: "memory");
    __syncthreads();
    if (threadIdx.x == 0) {
        unsigned* bar = b.bar;
        __builtin_amdgcn_s_waitcnt(0);
        unsigned nloc = b.st[0], nx = b.st[1];
        if (nloc == 0u) { xcd_barrier_complete(bar, b.x, nloc, nx); b.st[0] = nloc; b.st[1] = nx; }
        const unsigned old = xb_add(&bar[XB_XSUB(b.x)], 1u);
        const unsigned gen = old / nloc;
        if (old + 1u == (gen + 1u) * nloc) {
            __builtin_amdgcn_fence(__ATOMIC_RELEASE, "agent");
            asm volatile("s_waitcnt vmcnt(0)" ::: "memory");
            const unsigned og = xb_add(&bar[XB_TOP], 1u);
            const unsigned tg = og / nx;
            if (og + 1u == (tg + 1u) * nx) xb_add(&bar[XB_TOPGEN], 1u);
            else XB_SPIN(xb_ld(&bar[XB_TOPGEN]) == tg, bar);
            __builtin_amdgcn_fence(__ATOMIC_ACQUIRE, "agent");
            xb_add(&bar[XB_XGEN(b.x)], 1u);
            asm volatile("s_waitcnt vmcnt(0)" ::: "memory");
        } else {
            XB_SPIN(xb_ld(&bar[XB_XGEN(b.x)]) == gen, bar);
            __builtin_amdgcn_fence(__ATOMIC_ACQUIRE, "agent");
            asm volatile("s_waitcnt vmcnt(0)" ::: "memory");
        }
    }
    __syncthreads();
}

#define DI __device__ __forceinline__
constexpr int DM = 1024, NB = 2, SEQ = 8192, CTXL = 256, DEPTH = 2;
constexpr int NLAT = NB * SEQ, NCTX = NB * CTXL, NTOK = NLAT + NCTX;
constexpr int INW = 7936;
constexpr int C_AQ = 0, C_AK = 512, C_AV = 640, C_BQ = 768, C_BK = 1280, C_BV = 1792, C_CQ = 2304, C_CI = 2816, C_CFF = 3328, C_CFB = 3840, C_CG = 4352, C_GT = 4864;
constexpr int NEXP = 32, EFF = 1024, NCH = 132;
constexpr float RMS_EPS = 1e-6f, LOG2E = 1.4426950408889634f, QSCALE = 0.125f * 1.4426950408889634f;
constexpr int XG_ROWS = 75776;
constexpr int NWAVES = 8, NTHR = 512;

constexpr size_t MiB = 1u << 20;
constexpr size_t WS_CTL = 0, CTL_ZERO_BYTES = 1 * MiB;
constexpr size_t WS_SMALL = 1 * MiB;
constexpr size_t WS_WIN = 2 * MiB, WS_WBR = 33 * MiB, WS_WO = 39 * MiB, WS_WGU = 43 * MiB, WS_WDN = 299 * MiB;
constexpr size_t WS_XA = 427 * MiB, WS_H = 493 * MiB, WS_P = 526 * MiB, WS_LF = 782 * MiB, WS_O3 = 848 * MiB, WS_HU = 898 * MiB, WS_HD = 1030 * MiB, WS_HS = 1032 * MiB;
constexpr size_t WS_YF = 1098 * MiB, WS_Y = 1164 * MiB, WS_YO = 1197 * MiB, WS_ROUTE = 1230 * MiB, WS_XA2 = 1232 * MiB, WS_WIN8 = 1298 * MiB  , WS_END = 1314 * MiB;
constexpr size_t WS_XG = 526 * MiB, WS_ACT = 674 * MiB, WS_YS = 822 * MiB;
static_assert(WS_YS + (size_t)XG_ROWS * 1024 * 2 <= WS_HD, "moe overlay");
static_assert(WS_P + (size_t)NTOK * INW * 2 <= WS_LF && WS_HU + (size_t)2112 * 16384 * 4 <= WS_HD && WS_HS + (size_t)2112 * 16384 * 2 <= WS_YF, "ws map");
constexpr int SM_MOD = 0;
constexpr int SM_LB = 36864;
constexpr int SM_TAB = 38912;
constexpr int SM_LAM = 45056;
constexpr int CW_BAR = 4096;
constexpr int CW_CNT = 16384;

constexpr int RING_BYTES = 147456, LDSCTL_OFF = RING_BYTES, MISC_OFF = LDSCTL_OFF + 320, LDS_BYTES = 163840;

typedef float f32x16 __attribute__((ext_vector_type(16)));
typedef float f32x2 __attribute__((ext_vector_type(2)));
typedef short s16x4 __attribute__((ext_vector_type(4)));
typedef unsigned u32x2 __attribute__((ext_vector_type(2)));
typedef __bf16 bf16x2_t __attribute__((ext_vector_type(2)));
DI unsigned cvtpk(float lo, float hi) { f32x2 v = {lo, hi}; bf16x2_t b = __builtin_convertvector(v, bf16x2_t); return __builtin_bit_cast(unsigned, b); }
DI float bf2f(unsigned short u) { return __uint_as_float(((unsigned)u) << 16); }
DI float bflo(unsigned u) { return __uint_as_float(u << 16); }
DI float bfhi(unsigned u) { return __uint_as_float(u & 0xffff0000u); }
DI float wave_sum(float v) {
#pragma unroll
    for (int o = 1; o < 64; o <<= 1) v += __shfl_xor(v, o);
    return v;
}
constexpr float LOG2E_ = 1.4426950408889634f;
DI float silu_f(float v) { return v * __builtin_amdgcn_rcpf(1.f + __builtin_amdgcn_exp2f(-LOG2E_ * v)); }
DI float sigm_f(float v) { return __builtin_amdgcn_rcpf(1.f + __builtin_amdgcn_exp2f(-LOG2E_ * v)); }
DI bf16x8 pack8(float a0, float a1, float a2, float a3, float a4, float a5, float a6, float a7) {
    v4u p; p.x = cvtpk(a0, a1); p.y = cvtpk(a2, a3); p.z = cvtpk(a4, a5); p.w = cvtpk(a6, a7); return __builtin_bit_cast(bf16x8, p);
}
typedef short v4i16_t __attribute__((ext_vector_type(4)));
DI s16x4 tr_read(LAS const char* p) { return __builtin_bit_cast(s16x4, __builtin_amdgcn_ds_read_tr16_b64_v4i16((LAS v4i16_t*)p)); }
DI bf16x8 cat8(s16x4 lo, s16x4 hi) { return __builtin_shufflevector(lo, hi, 0, 1, 2, 3, 4, 5, 6, 7); }
#define MFMA32(a, b, c) __builtin_amdgcn_mfma_f32_32x32x16_bf16((a), (b), (c), 0, 0, 0)
#define MFMA16(a, b, c) __builtin_amdgcn_mfma_f32_16x16x32_bf16((a), (b), (c), 0, 0, 0)
#ifndef INP_FP8
#define INP_FP8 0
#endif
#define INP_L1_FP8 0
constexpr float F8_ACT = 8.f, F8_W = 256.f, F8_MID = 4.f;
constexpr float INP_OSC = INP_FP8 ? 1.f / (8.f * 256.f) : 1.f;
DI float clamp8(float x) { return fminf(fmaxf(x, -448.f), 448.f); }
DI unsigned f8x4(float a, float b, float c, float d) { int w = __builtin_amdgcn_cvt_pk_fp8_f32(clamp8(a), clamp8(b), 0, false); w = __builtin_amdgcn_cvt_pk_fp8_f32(clamp8(c), clamp8(d), w, true); return (unsigned)w; }
DI int tid_opaque() { int t = threadIdx.x; asm volatile("" : "+v"(t)); return t; }
DI int crow(int r, int hi) { return (r & 3) + 8 * (r >> 2) + 4 * hi; }

DI void ph_mod(LAS unsigned char* lds, const float* c, const float* cctx, const float* wmod, const float* bmod, float* MOD, int vcu, int G) {
    LAS float* red = (LAS float*)lds;
    const int tid = tid_opaque(), col = tid & 31, ks = tid >> 5;
    for (int tile = vcu; tile < 2 * 192; tile += G) {
        const int l = tile / 192, n0 = (tile % 192) * 32;
        const float* W = wmod + (size_t)l * 1024 * 6144 + n0 + col;
        float a0 = 0.f, a1 = 0.f, a2 = 0.f;
#pragma unroll 8
        for (int k = ks * 64; k < ks * 64 + 64; ++k) {
            const float w = W[(size_t)k * 6144];
            a0 += silu_f(c[k]) * w; a1 += silu_f(c[1024 + k]) * w; a2 += silu_f(cctx[k]) * w;
        }
        red[(ks * 3 + 0) * 32 + col] = a0; red[(ks * 3 + 1) * 32 + col] = a1; red[(ks * 3 + 2) * 32 + col] = a2;
        __syncthreads();
        if (tid < 96) { const int j = tid >> 5, cc = tid & 31; float s = 0.f;
#pragma unroll
            for (int k2 = 0; k2 < 16; ++k2) s += red[(k2 * 3 + j) * 32 + cc];
            MOD[(l * 3 + j) * 6144 + n0 + cc] = s + bmod[l * 6144 + n0 + cc]; }
        __syncthreads();
    }
}
DI void sincos_tab(double a, float& s, float& c) {
    const double TWO_PI = 6.283185307179586476925;
    const double k = rint(a / TWO_PI), r = a - k * TWO_PI, r2 = r * r;
    double ts = r, ss = r, tc = 1.0, cs = 1.0;
    for (int n = 1; n <= 15; ++n) { ts *= -r2 / (double)((2 * n) * (2 * n + 1)); ss += ts; tc *= -r2 / (double)((2 * n - 1) * (2 * n)); cs += tc; }
    s = (float)ss; c = (float)cs;
}
DI void ph_tables(float* SM, const float* lb_logits, const float* dlam, int vcu, int G) {
    const int gt = vcu * NTHR + tid_opaque(), NT = G * NTHR;
    for (int i = gt; i < 192 * 16; i += NT) {
        const int pos = i >> 4, f = i & 15;
        const float invf = f == 0 ? 1.0f : f == 1 ? 0.5623413324356079f : f == 2 ? 0.3162277638912201f : f == 3 ? 0.17782793939113617f : f == 4 ? 0.10000000149011612f : f == 5 ? 0.05623413249850273f
                         : f == 6 ? 0.03162277489900589f : f == 7 ? 0.017782794311642647f : f == 8 ? 0.009999999776482582f : f == 9 ? 0.005623413249850273f : f == 10 ? 0.003162277629598975f
                         : f == 11 ? 0.0017782794311642647f : f == 12 ? 0.0010000000474974513f : f == 13 ? 0.000562341301701963f : f == 14 ? 0.0003162277571391314f : 0.00017782794020604342f;
        const int p = pos < 128 ? pos : pos - 128;
        const float ang = (float)p * invf;
        float s, c; sincos_tab((double)ang, s, c);
        if (pos < 128) { SM[SM_TAB + p * 16 + f] = c; SM[SM_TAB + 2048 + p * 16 + f] = s; }
        else { SM[SM_TAB + 4096 + p * 16 + f] = c; SM[SM_TAB + 4096 + 1024 + p * 16 + f] = s; }
    }
    for (int i = gt; i < 1024; i += NT) {
        const float l0 = lb_logits[i], l1 = lb_logits[1024 + i];
        SM[SM_LB + i] = 0.f; SM[SM_LB + 1024 + i] = 1.f / (1.f + expf(l0 - l1));
    }
    if (gt < 2) { const float* lp = dlam + gt * 256; float s0 = 0.f, s1 = 0.f;
        for (int d = 0; d < 64; ++d) { s0 += lp[d] * lp[64 + d]; s1 += lp[128 + d] * lp[192 + d]; }
        const float li = 0.8f - 0.6f * expf(-0.3f * (float)gt);
        SM[SM_LAM + gt] = expf(s0) - expf(s1) + li; SM[SM_LAM + 2 + gt] = li; }
}
DI void p0_transpose_item(const float* W, int K, int N, int spitch, bf16* WT, int dpitch, int gu, int f8, LAS float* scr, int item, int lane) {
    const int nblk = N / 32, kb = item / nblk, nb = item % nblk, k0 = 64 * kb, n0 = 32 * nb;
    float wv[32];
#pragma unroll
    for (int i = 0; i < 32; ++i) wv[i] = __builtin_nontemporal_load(W + (size_t)(k0 + 2 * i + (lane >> 5)) * spitch + n0 + (lane & 31));
#pragma unroll
    for (int i = 0; i < 32; ++i) scr[(2 * i + (lane >> 5)) * 33 + (lane & 31)] = wv[i];
    LDS_WAIT(); asm volatile("" ::: "memory");
    const int c = lane & 7;
    const int r0 = gu ? (256 * ((n0 & 1023) >> 7) + 128 * (n0 >> 10) + (n0 & 127)) : n0;
#pragma unroll
    for (int j = 0; j < 4; ++j) { const int n = (lane >> 3) + 8 * j; const LAS float* s = scr + (8 * c) * 33 + n;
        if (f8) { u32x2 o8; o8.x = f8x4(s[0 * 33] * F8_W, s[1 * 33] * F8_W, s[2 * 33] * F8_W, s[3 * 33] * F8_W); o8.y = f8x4(s[4 * 33] * F8_W, s[5 * 33] * F8_W, s[6 * 33] * F8_W, s[7 * 33] * F8_W);
            *(GAS u32x2*)((unsigned char*)WT + (size_t)(r0 + n) * dpitch + k0 + 8 * c) = o8; }
        else { v4u o; o.x = pk2(s[0 * 33], s[1 * 33]); o.y = pk2(s[2 * 33], s[3 * 33]); o.z = pk2(s[4 * 33], s[5 * 33]); o.w = pk2(s[6 * 33], s[7 * 33]);
            *(GAS v4u*)(WT + (size_t)(r0 + n) * dpitch + k0 + 8 * c) = o; } }
    LDS_WAIT(); asm volatile("" ::: "memory");
}
struct TGroup { const float* src; bf16* dst; int K, N, nmat, gu, sub, f8, spitch; };
DI bool p0_group(const TGroup& g, int& r, LAS float* scr, int lane) {
    const int per = (g.K / 64) * (g.N / 32), cnt = per * g.nmat;
    if (r >= cnt) { r -= cnt; return false; }
    const int m = r / per, it = r % per;
    p0_transpose_item(g.src + (size_t)m * g.K * g.N, g.K, g.N, g.spitch ? g.spitch : g.N, g.f8 ? (bf16*)((unsigned char*)g.dst + (size_t)m * g.K * g.N) : g.dst + (size_t)(m / g.sub) * g.sub * g.K * g.N + (size_t)(m % g.sub) * g.K, g.sub * g.K, g.gu, g.f8, scr, it, lane);
    return true;
}
DI void row_ld(const float* p, int lane, f32x4 (&v)[4]) {
#pragma unroll
    for (int j = 0; j < 4; ++j) v[j] = ((const GAS f32x4*)p)[lane + 64 * j];
}
DI void row_ld_bf(const bf16* p, int lane, f32x4 (&v)[4]) {
#pragma unroll
    for (int j = 0; j < 4; ++j) { const u32x2 w = ((const GAS u32x2*)p)[lane + 64 * j]; v[j] = (f32x4){bflo(w.x), bfhi(w.x), bflo(w.y), bfhi(w.y)}; }
}
DI void row_st(float* p, int lane, const f32x4 (&v)[4]) {
#pragma unroll
    for (int j = 0; j < 4; ++j) ((GAS f32x4*)p)[lane + 64 * j] = v[j];
}
DI void row_st_bf(bf16* p, int lane, const f32x4 (&v)[4]) {
#pragma unroll
    for (int j = 0; j < 4; ++j) { u32x2 w; w.x = cvtpk(v[j].x, v[j].y); w.y = cvtpk(v[j].z, v[j].w); ((GAS u32x2*)p)[lane + 64 * j] = w; }
}
DI void row_st_f8(unsigned char* p, int lane, const f32x4 (&v)[4], float s) {
#pragma unroll
    for (int j = 0; j < 4; ++j) ((GAS unsigned*)p)[lane + 64 * j] = f8x4(v[j].x * s, v[j].y * s, v[j].z * s, v[j].w * s);
}
DI float row_rstd(const f32x4 (&v)[4]) {
    float s = 0.f;
#pragma unroll
    for (int j = 0; j < 4; ++j) s += (v[j].x * v[j].x + v[j].y * v[j].y) + (v[j].z * v[j].z + v[j].w * v[j].w);
    return rsqrtf(wave_sum(s) * (1.f / 1024.f) + RMS_EPS);
}
DI void row_modulate(const f32x4 (&x)[4], const float* g, const float* shift, const float* scale, int lane, f32x4 (&h)[4]) {
    const float r = row_rstd(x);
#pragma unroll
    for (int j = 0; j < 4; ++j) { const f32x4 gg = ((const GAS f32x4*)g)[lane + 64 * j], sh = ((const GAS f32x4*)shift)[lane + 64 * j], sc = ((const GAS f32x4*)scale)[lane + 64 * j];
        h[j] = x[j] * r * gg * (sc + 1.f) + sh; }
}

DI v4u pack8u(const f32x4& a, const f32x4& b) { v4u w; w.x = cvtpk(a[0], a[1]); w.y = cvtpk(a[2], a[3]); w.z = cvtpk(b[0], b[1]); w.w = cvtpk(b[2], b[3]); return w; }
template <int MODE> struct EpiInT {
    static constexpr bool PERM = true, AFTER_DRAIN = false, KHOOK = false;
    bf16* P; float* LF; const float* tab; const float* lb; int pn_off; float osc;
    DI void operator()(const pg8::f32x4 (&acc)[2][2][4][2], const pg8::Unit& u, int wr, int wc, int fr_, int fq_) const {
        const int lane_ = tid_opaque() & 63, fr = lane_ & 15, fq = lane_ >> 4;
        const int pn = u.pn + pn_off; const bool lat = u.pm < 64;
#pragma unroll
        for (int bj = 0; bj < 2; ++bj) {
            int mode;
            float sc = 1.f;
            if (pn <= 1 || pn == 3 || pn == 4) { mode = 1; sc = QSCALE; }
            else if (pn == 2) mode = (bj == 0) ? 1 : 0;
            else if (pn == 5 || pn == 6) mode = 1;
            else if (pn == 9 || pn == 10 || pn == 17 || pn == 18) mode = 2;
            else if (pn >= 13 && pn <= 16) mode = 3;
            else if (pn >= 19) mode = 4;
            else mode = 0;
            if (mode == 1 && !lat) mode = 0;
            if (MODE == 2) mode = (mode == 3) ? 5 : 0;
            unsigned keep_ = 0u;
            const int cu = pn * 256 + bj * 128 + wc * 32;
#pragma unroll
            for (int ai = 0; ai < 2; ++ai)
#pragma unroll
                for (int m = 0; m < 4; ++m) {
                    const int rowu = u.pm * 256 + ai * 128 + wr * 64 + m * 16, row = rowu + fr;
                    f32x4 v0 = acc[ai][bj][m][0] * osc, v1 = acc[ai][bj][m][1] * osc;
                    if (mode == 1) {
                        const int s = row & (SEQ - 1); const int half = wc & 1; const int pos = half ? (s & 63) : (s >> 6);
                        const float* tb = tab + (half ? 4096 : 0) + pos * 16 + 8 * (fq & 1); const int so = half ? 1024 : 2048;
                        const f32x4 c0 = *(const GAS f32x4*)tb, c1 = *(const GAS f32x4*)(tb + 4), s0 = *(const GAS f32x4*)(tb + so), s1 = *(const GAS f32x4*)(tb + so + 4);
                        const float sg = (fq < 2) ? -sc : sc;
                        f32x4 p0, p1;
#pragma unroll
                        for (int j = 0; j < 4; ++j) { p0[j] = __shfl_xor(v0[j], 32); p1[j] = __shfl_xor(v1[j], 32); }
                        v0 = v0 * c0 * sc + p0 * s0 * sg; v1 = v1 * c1 * sc + p1 * s1 * sg;
                    } else if (mode == 0) { v0 = v0 * sc; v1 = v1 * sc; }
                    else if (mode == 2) {
#pragma unroll
                        for (int j = 0; j < 4; ++j) { v0[j] = silu_f(v0[j]); v1[j] = silu_f(v1[j]); }
                    } else if (mode == 4) {
#pragma unroll
                        for (int j = 0; j < 4; ++j) { v0[j] = sigm_f(v0[j]); v1[j] = sigm_f(v1[j]); }
                    } else if (mode == 5) { float* lp5 = LF + (size_t)rowu * 1024 + ((pn >= 15) ? 512 : 0) + (pn - 13 - 2 * ((pn >= 15) ? 1 : 0)) * 256 + bj * 128 + wc * 32; *(GAS f32x4*)(lp5 + fr * 1024 + 8 * fq) = v0; *(GAS f32x4*)(lp5 + fr * 1024 + 8 * fq + 4) = v1; continue;
                    } else {
                        const int dir = (pn >= 15) ? 1 : 0; const int ch = (pn - 13 - 2 * dir) * 256 + bj * 128 + wc * 32 + 8 * fq;
                        const f32x4 l0 = *(const GAS f32x4*)(lb + dir * 512 + ch), l1 = *(const GAS f32x4*)(lb + dir * 512 + ch + 4);
#pragma unroll
                        for (int j = 0; j < 4; ++j) { v0[j] = fmaxf(__logf(l0[j] + (1.f - l0[j]) * sigm_f(v0[j])), -60.f); v1[j] = fmaxf(__logf(l1[j] + (1.f - l1[j]) * sigm_f(v1[j])), -60.f); }
                        float* lp = LF + (size_t)rowu * 1024 + dir * 512 + (pn - 13 - 2 * dir) * 256 + bj * 128 + wc * 32;
                        if (MODE != 1) { *(GAS f32x4*)(lp + fr * 1024 + 8 * fq) = v0; *(GAS f32x4*)(lp + fr * 1024 + 8 * fq + 4) = v1; } else keep_ ^= __float_as_uint(v0[0] + v0[1] + v0[2] + v0[3] + v1[0] + v1[1] + v1[2] + v1[3]);
                        if (MODE == 1 && ai == 1 && m == 3) *(GAS unsigned*)(lp + fr * 1024 + 8 * fq) = keep_;
                        continue;
                    }
                    bf16* op = P + (size_t)rowu * INW + cu;
                    if (MODE != 1) *(GAS v4u*)(op + fr * INW + 8 * fq) = pack8u(v0, v1); else { const v4u pw = pack8u(v0, v1); keep_ ^= pw.x ^ pw.y ^ pw.z ^ pw.w; if (ai == 1 && m == 3) *(GAS unsigned*)(op + fr * INW + 8 * fq) = keep_; }
                }
        }
    }
};
typedef EpiInT<0> EpiIn;
struct EpiMerge {
    static constexpr bool PERM = true, AFTER_DRAIN = false, KHOOK = true;
    const bf16* P; bf16* Y;
    DI void khook(pg8::f32x4 (&acc)[2][2][4][2], const pg8::Unit& u, int seam, int wr, int wc, int fr_, int fq_) const {
        const int lane_ = tid_opaque() & 63, fr = lane_ & 15, fq = lane_ >> 4;
        const int loff = fr * INW + 8 * fq;
#pragma unroll
        for (int ai = 0; ai < 2; ++ai)
#pragma unroll
            for (int m = 0; m < 4; ++m) {
                const bf16* gb = P + (size_t)(u.pm * 256 + ai * 128 + wr * 64 + m * 16) * INW + C_GT + (seam - 1) * 1024 + u.pn * 256 + wc * 32;
#pragma unroll
                for (int bj = 0; bj < 2; ++bj) {
                    const bf16* gp = gb + bj * 128 + loff;
                    const v4u ga = *(const GAS v4u*)gp, gn = *(const GAS v4u*)(gp + 1024);
                    const f32x4 r0 = (f32x4){bflo(ga.x) * __builtin_amdgcn_rcpf(bflo(gn.x)), bfhi(ga.x) * __builtin_amdgcn_rcpf(bfhi(gn.x)), bflo(ga.y) * __builtin_amdgcn_rcpf(bflo(gn.y)), bfhi(ga.y) * __builtin_amdgcn_rcpf(bfhi(gn.y))};
                    const f32x4 r1 = (f32x4){bflo(ga.z) * __builtin_amdgcn_rcpf(bflo(gn.z)), bfhi(ga.z) * __builtin_amdgcn_rcpf(bfhi(gn.z)), bflo(ga.w) * __builtin_amdgcn_rcpf(bflo(gn.w)), bfhi(ga.w) * __builtin_amdgcn_rcpf(bfhi(gn.w))};
                    acc[ai][bj][m][0] = acc[ai][bj][m][0] * r0; acc[ai][bj][m][1] = acc[ai][bj][m][1] * r1;
                }
                { asm volatile("" ::: "memory");
                    __builtin_amdgcn_sched_barrier(0); }
            }
    }
    DI void operator()(const pg8::f32x4 (&acc)[2][2][4][2], const pg8::Unit& u, int wr, int wc, int fr_, int fq_) const {
        const int lane_ = tid_opaque() & 63, fr = lane_ & 15, fq = lane_ >> 4;
        const int loff = fr * INW + 8 * fq, yoff = fr * 1024 + 8 * fq;
#pragma unroll
        for (int ai = 0; ai < 2; ++ai)
#pragma unroll
            for (int m = 0; m < 4; ++m) {
                const int rowu = u.pm * 256 + ai * 128 + wr * 64 + m * 16, colu = u.pn * 256 + wc * 32;
                const bf16* gb = P + (size_t)rowu * INW + C_GT + 2 * 1024 + colu; bf16* yb = Y + (size_t)rowu * 1024 + colu;
#pragma unroll
                for (int bj = 0; bj < 2; ++bj) {
                    const v4u gw = *(const GAS v4u*)(gb + bj * 128 + loff);
                    const f32x4 v0 = acc[ai][bj][m][0] * (f32x4){bflo(gw.x), bfhi(gw.x), bflo(gw.y), bfhi(gw.y)}, v1 = acc[ai][bj][m][1] * (f32x4){bflo(gw.z), bfhi(gw.z), bflo(gw.w), bfhi(gw.w)};
                    *(GAS v4u*)(yb + bj * 128 + yoff) = pack8u(v0, v1);
                }
                asm volatile("" ::: "memory");
            }
    }
};
struct EpiNull {
    static constexpr bool PERM = true, AFTER_DRAIN = false, KHOOK = false;
    float* O;
    DI void operator()(const pg8::f32x4 (&acc)[2][2][4][2], const pg8::Unit& u, int wr, int wc, int fr_, int fq_) const {
        float s = 0.f;
#pragma unroll
        for (int ai = 0; ai < 2; ++ai)
#pragma unroll
            for (int bj = 0; bj < 2; ++bj)
#pragma unroll
                for (int m = 0; m < 4; ++m)
#pragma unroll
                    for (int n = 0; n < 2; ++n) s += (acc[ai][bj][m][n][0] + acc[ai][bj][m][n][1]) + (acc[ai][bj][m][n][2] + acc[ai][bj][m][n][3]);
        O[(size_t)(u.pm * 31 + (u.pn % 31)) * 512 + tid_opaque()] = s;
    }
};
struct EpiPlain {
    static constexpr bool PERM = true, AFTER_DRAIN = false, KHOOK = false;
    bf16* O; int ldc; const float* bias; int npn; float osc;
    DI void operator()(const pg8::f32x4 (&acc)[2][2][4][2], const pg8::Unit& u, int wr, int wc, int fr_, int fq_) const {
        const int lane_ = tid_opaque() & 63, fr = lane_ & 15, fq = lane_ >> 4;
        const int e = u.pn / npn, pn = u.pn % npn;
#pragma unroll
        for (int bj = 0; bj < 2; ++bj) {
            const int colu = pn * 256 + bj * 128 + wc * 32;
            f32x4 b0 = (f32x4){0.f, 0.f, 0.f, 0.f}, b1 = b0;
            if (bias) { const float* bp = bias + (size_t)e * npn * 256 + colu + 8 * fq; b0 = *(const GAS f32x4*)bp; b1 = *(const GAS f32x4*)(bp + 4); }
#pragma unroll
            for (int ai = 0; ai < 2; ++ai)
#pragma unroll
                for (int m = 0; m < 4; ++m) {
                    bf16* ob = O + (size_t)(u.pm * 256 + ai * 128 + wr * 64 + m * 16) * ldc + colu;
                    *(GAS v4u*)(ob + fr * ldc + 8 * fq) = pack8u(acc[ai][bj][m][0] * osc + b0, acc[ai][bj][m][1] * osc + b1);
                }
        }
    }
};
template <int MODE> struct EpiSwigluT {
    static constexpr bool PERM = true, AFTER_DRAIN = false, KHOOK = false;
    unsigned char* O; const float* bias;
    DI void operator()(const pg8::f32x4 (&acc)[2][2][4][2], const pg8::Unit& u, int wr, int wc, int fr_, int fq_) const {
        const int lane_ = tid_opaque() & 63, fr = lane_ & 15, fq = lane_ >> 4;
        const int e = u.pn >> 3, nt = u.pn & 7;
        const int colu = nt * 128 + wc * 32;
        const float* bp = bias + (size_t)e * 2048 + colu + 8 * fq;
        const f32x4 bg0 = *(const GAS f32x4*)bp, bg1 = *(const GAS f32x4*)(bp + 4), bu0 = *(const GAS f32x4*)(bp + 1024), bu1 = *(const GAS f32x4*)(bp + 1028);
        unsigned keep_ = 0u;
#pragma unroll
        for (int ai = 0; ai < 2; ++ai)
#pragma unroll
            for (int m = 0; m < 4; ++m) {
                f32x4 v[2];
#pragma unroll
                for (int n = 0; n < 2; ++n) { const f32x4 g = acc[ai][0][m][n] * (1.f / (F8_ACT * F8_W)) + (n ? bg1 : bg0), uu = acc[ai][1][m][n] * (1.f / (F8_ACT * F8_W)) + (n ? bu1 : bu0);
#pragma unroll
                    for (int j = 0; j < 4; ++j) { if (MODE == 2) v[n][j] = g[j] + uu[j]; else { const float gc = fminf(g[j], 7.f), uc = fminf(fmaxf(uu[j], -7.f), 7.f); v[n][j] = (uc + 1.f) * (gc * sigm_f(1.702f * gc)); } } }
                unsigned char* ob = O + (size_t)(u.pm * 256 + ai * 128 + wr * 64 + m * 16) * 1024 + colu;
                u32x2 w8; w8.x = f8x4(v[0][0] * F8_MID, v[0][1] * F8_MID, v[0][2] * F8_MID, v[0][3] * F8_MID); w8.y = f8x4(v[1][0] * F8_MID, v[1][1] * F8_MID, v[1][2] * F8_MID, v[1][3] * F8_MID);
                if (MODE != 1) *(GAS u32x2*)(ob + fr * 1024 + 8 * fq) = w8; else if (ai == 1 && m == 3) *(GAS unsigned*)(ob + fr * 1024 + 8 * fq) = w8.x ^ w8.y ^ keep_; else keep_ ^= w8.x + w8.y;
            }
    }
};
typedef EpiSwigluT<0> EpiSwiglu;
struct SubOrder {
    pg8::StaticOrder base; int skip_from, skip_n;
    DI bool next(int i, pg8::Unit& u) const { if (!base.next(i, u)) return false; if (u.pn >= skip_from) u.pn += skip_n; return true; }
    DI void a_ready(const pg8::Unit&) const {}
    DI void done(const pg8::Unit&) const {}
};
struct MoeOrder {
    const volatile LAS int* tpre; int NT, G, c;
    DI bool next(int i, pg8::Unit& u) const {
        const int L = i * G + c, total = __builtin_amdgcn_readfirstlane(tpre[32]) * NT; if (L >= total) return false;
        const int mt = L / NT, nt = L % NT; int e = 0;
        for (int k = 1; k < 32; ++k) e += (tpre[k] <= mt) ? 1 : 0;
        u.pm = mt; u.pn = __builtin_amdgcn_readfirstlane(e) * NT + nt; return true;
    }
    DI void a_ready(const pg8::Unit&) const {}
    DI void done(const pg8::Unit&) const {}
};

template <int KW> DI int swzK(int row) { return KW == 128 ? (row & 15) : ((row >> 1) & 7); }
template <int VD> DI int swzV(int row) { return VD == 128 ? (row & 3) : ((row >> 1) & 1); }
struct AttnJob {
    int qrow;
    int qcol;
    int kcolT, vcolT, kc8;
    int seg0_row, n0, seg0_kpos0;
    int seg1_row, n1;
    int qpos0;
};
template <int KW, int VD, bool WINDOW>
DI void attn_run(LAS unsigned char* lds, const bf16* P, const AttnJob& J, f32x16 (&O)[VD / 32], float& m_out, float& l_out) {
    const int tid = tid_opaque(), lane = tid & 63, r32 = lane & 31, hi = lane >> 5;
    constexpr int KCH = KW / 8, VCH = VD / 8, NKR = KW / 64, NVR = VD / 64;
    bf16x8 qf[4];
#pragma unroll
    for (int d0 = 0; d0 < 4; ++d0) qf[d0] = *(const GAS bf16x8*)(P + (size_t)(J.qrow + r32) * INW + J.qcol + d0 * 16 + hi * 8);
#pragma unroll
    for (int d = 0; d < VD / 32; ++d) O[d] = (f32x16){0.f, 0.f, 0.f, 0.f, 0.f, 0.f, 0.f, 0.f, 0.f, 0.f, 0.f, 0.f, 0.f, 0.f, 0.f, 0.f};
    float m = -1e30f, l = 0.f;
    const int nt = J.n0 + J.n1;
    v4u kr[NKR], vr[NVR];
#define ATT_TROW(t) ((t) < J.n0 ? J.seg0_row + 64 * (t) : J.seg1_row + 64 * ((t) - J.n0))
#define ATT_LOAD(t) do { const int rs_ = ATT_TROW(t); \
        _Pragma("unroll") for (int i = 0; i < NKR; ++i) { const int ci = tid + NTHR * i, row = ci / KCH, cc = ci % KCH; kr[i] = *(const GAS v4u*)(P + (size_t)(rs_ + row) * INW + J.kcolT + cc * 8); } \
        _Pragma("unroll") for (int i = 0; i < NVR; ++i) { const int ci = tid + NTHR * i, row = ci / VCH, cc = ci % VCH; vr[i] = *(const GAS v4u*)(P + (size_t)(rs_ + row) * INW + J.vcolT + cc * 8); } } while (0)
#define ATT_STORE(buf) do { \
        _Pragma("unroll") for (int i = 0; i < NKR; ++i) { const int ci = tid + NTHR * i, row = ci / KCH, cc = ci % KCH; *(LAS v4u*)(lds + (buf) * 16384 + row * (KW * 2) + ((cc ^ swzK<KW>(row)) << 4)) = kr[i]; } \
        _Pragma("unroll") for (int i = 0; i < NVR; ++i) { const int ci = tid + NTHR * i, row = ci / VCH, cc = ci % VCH; *(LAS v4u*)(lds + 32768 + (buf) * 16384 + row * (VD * 2) + ((((cc >> 2) ^ swzV<VD>(row)) << 6) | ((cc & 3) << 4))) = vr[i]; } } while (0)
    if (nt > 0) { ATT_LOAD(0); ATT_STORE(0); }
    __syncthreads();
    for (int t = 0; t < nt; ++t) {
        const int cur = t & 1;
        if (t + 1 < nt) ATT_LOAD(t + 1);
        const LAS unsigned char* kb = lds + cur * 16384; const LAS unsigned char* vb = lds + 32768 + cur * 16384;
        f32x16 st[2];
#pragma unroll
        for (int sub = 0; sub < 2; ++sub) {
            f32x16 a = (f32x16){0.f, 0.f, 0.f, 0.f, 0.f, 0.f, 0.f, 0.f, 0.f, 0.f, 0.f, 0.f, 0.f, 0.f, 0.f, 0.f};
            const int row = 32 * sub + r32;
#pragma unroll
            for (int d0 = 0; d0 < 4; ++d0) { const int ch = J.kc8 + 2 * d0 + hi;
                const bf16x8 kf = *(const LAS bf16x8*)(kb + row * (KW * 2) + ((ch ^ swzK<KW>(row)) << 4));
                a = MFMA32(kf, qf[d0], a); }
            st[sub] = a;
        }
        if (WINDOW && t < J.n0) {
            const int kp0 = J.seg0_kpos0 + 64 * t - (J.qpos0 + r32);
#pragma unroll
            for (int sub = 0; sub < 2; ++sub)
#pragma unroll
                for (int r = 0; r < 16; ++r) { const int rel = kp0 + 32 * sub + crow(r, hi); if (rel > 128 || rel < -128) st[sub][r] = -INFINITY; }
        }
        float tm = st[0][0];
#pragma unroll
        for (int r = 1; r < 16; ++r) tm = fmaxf(tm, st[0][r]);
#pragma unroll
        for (int r = 0; r < 16; ++r) tm = fmaxf(tm, st[1][r]);
        tm = fmaxf(tm, __shfl_xor(tm, 32));
        const float mn = fmaxf(m, tm), alpha = __builtin_amdgcn_exp2f(m - mn); m = mn;
        float ls = 0.f;
#pragma unroll
        for (int sub = 0; sub < 2; ++sub)
#pragma unroll
            for (int r = 0; r < 16; ++r) { const float p = __builtin_amdgcn_exp2f(st[sub][r] - mn); st[sub][r] = p; ls += p; }
        l = l * alpha + ls;
#pragma unroll
        for (int d = 0; d < VD / 32; ++d) O[d] = O[d] * alpha;
        bf16x8 pb[2][2];
#pragma unroll
        for (int sub = 0; sub < 2; ++sub)
#pragma unroll
            for (int s = 0; s < 2; ++s) pb[sub][s] = pack8(st[sub][8 * s], st[sub][8 * s + 1], st[sub][8 * s + 2], st[sub][8 * s + 3], st[sub][8 * s + 4], st[sub][8 * s + 5], st[sub][8 * s + 6], st[sub][8 * s + 7]);
        const int q4 = (lane & 15) >> 2, p4 = lane & 3, blk = (lane >> 4) & 1;
#pragma unroll
        for (int d = 0; d < VD / 32; ++d)
#pragma unroll
            for (int sub = 0; sub < 2; ++sub)
#pragma unroll
                for (int s = 0; s < 2; ++s) {
                    const int r0 = 32 * sub + 16 * s + 4 * hi + q4, r1 = r0 + 8;
                    const s16x4 lo = tr_read((LAS const char*)(vb + r0 * (VD * 2) + (((d ^ swzV<VD>(r0)) << 6) | (blk << 5) | (p4 << 3))));
                    const s16x4 hh = tr_read((LAS const char*)(vb + r1 * (VD * 2) + (((d ^ swzV<VD>(r1)) << 6) | (blk << 5) | (p4 << 3))));
                    O[d] = MFMA32(cat8(lo, hh), pb[sub][s], O[d]);
                }
        if (t + 1 < nt) ATT_STORE(cur ^ 1);
        __syncthreads();
    }
#undef ATT_TROW
#undef ATT_LOAD
#undef ATT_STORE
    l += __shfl_xor(l, 32);
    m_out = m; l_out = l;
}

DI void ph_attn_a(LAS unsigned char* lds, const bf16* P, bf16* OA, const float* sink, bool with_ctx, int vcu, int G) {
    const int lane = tid_opaque() & 63, wave = __builtin_amdgcn_readfirstlane(tid_opaque() >> 6), r32 = lane & 31, hi = lane >> 5;
    const int nun = 512 + (with_ctx ? 16 : 0);
    for (int u = vcu; u < nun; u += G) {
        AttnJob J; int b, kvh, q0; const bool cq = u >= 512;
        if (!cq) { b = u >> 8; kvh = (u >> 7) & 1; q0 = (u & 127) * 64;
            int jlo = 0, jhi = 4; if (q0 == 0) jlo = 2; else if (q0 == 64) jlo = 1; if (q0 == SEQ - 64) jhi = 2; else if (q0 == SEQ - 128) jhi = 3;
            J.seg0_kpos0 = q0 - 128 + 64 * jlo; J.seg0_row = b * SEQ + J.seg0_kpos0; J.n0 = jhi - jlo + 1; J.qrow = b * SEQ + q0 + 32 * (wave & 1); J.qpos0 = q0 + 32 * (wave & 1); }
        else { const int v = u - 512; b = v >> 3; kvh = (v >> 2) & 1; q0 = (v & 3) * 64; J.seg0_kpos0 = 0; J.seg0_row = 0; J.n0 = 0; J.qrow = NLAT + b * CTXL + q0 + 32 * (wave & 1); J.qpos0 = 0; }
        const int head = kvh * 4 + (wave >> 1);
        J.qcol = C_AQ + head * 64; J.kcolT = C_AK + kvh * 64; J.vcolT = C_AV + kvh * 64; J.kc8 = 0; J.seg1_row = NLAT + b * CTXL; J.n1 = 4;
        f32x16 O[2]; float m, l;
        attn_run<64, 64, true>(lds, P, J, O, m, l);
        l += __builtin_amdgcn_exp2f(sink[head] * LOG2E - m);
        const float inv = 1.f / l;
        bf16* op = OA + (size_t)(J.qrow + r32) * 1536 + head * 64;
#pragma unroll
        for (int d = 0; d < 2; ++d)
#pragma unroll
            for (int rg = 0; rg < 4; ++rg) { u32x2 w; w.x = cvtpk(O[d][4 * rg] * inv, O[d][4 * rg + 1] * inv); w.y = cvtpk(O[d][4 * rg + 2] * inv, O[d][4 * rg + 3] * inv);
                *(GAS u32x2*)(op + 32 * d + 8 * rg + 4 * hi) = w; }
    }
}
#ifndef AB_WIDE
#define AB_WIDE 1
#endif
#define SPLAT16(x) ((f32x16){(x), (x), (x), (x), (x), (x), (x), (x), (x), (x), (x), (x), (x), (x), (x), (x)})
DI float max3_asm(float a, float b, float c) { float r; asm("v_max3_f32 %0, %1, %2, %3" : "=v"(r) : "v"(a), "v"(b), "v"(c)); return r; }
DI float rowmax32(const f32x16& a, const f32x16& b) {
    float x = max3_asm(a[0], a[1], b[0]), y = max3_asm(a[2], a[3], b[1]);
    x = max3_asm(x, b[2], b[3]);
#pragma unroll
    for (int r = 4; r < 16; r += 4) { x = max3_asm(x, a[r], a[r + 1]); y = max3_asm(y, a[r + 2], a[r + 3]); x = max3_asm(x, b[r], b[r + 1]); y = max3_asm(y, b[r + 2], b[r + 3]); }
    x = fmaxf(x, y);
    const auto sw = __builtin_amdgcn_permlane32_swap(__float_as_uint(x), __float_as_uint(x), false, false);
    return max3_asm(__uint_as_float(sw[0]), __uint_as_float(sw[1]), x);
}
#define LDSRD128(dst, addr, off) asm volatile("ds_read_b128 %0, %1 offset:%c2" : "=&v"(dst) : "v"(addr), "i"(off) : "memory")
#define LDSTR64(dst, addr, off) asm volatile("ds_read_b64_tr_b16 %0, %1 offset:%c2" : "=&v"(dst) : "v"(addr), "i"(off) : "memory")
#define LGKM_WAIT(n) do { asm volatile("s_waitcnt lgkmcnt(" #n ")" ::: "memory"); __builtin_amdgcn_sched_barrier(0); } while (0)
template <int VAR> DI void attn_b_run(LAS unsigned char* lds, const bf16* P, const AttnJob& J, f32x16 (&O)[4], float& l_out) {
    const int tid = tid_opaque(), lane = tid & 63, r32 = lane & 31, hi = lane >> 5, wave = __builtin_amdgcn_readfirstlane(tid >> 6);
    bf16x8 qf[4];
#pragma unroll
    for (int d0 = 0; d0 < 4; ++d0) qf[d0] = *(const GAS bf16x8*)(P + (size_t)(J.qrow + r32) * INW + J.qcol + d0 * 16 + hi * 8);
#pragma unroll
    for (int d = 0; d < 4; ++d) O[d] = SPLAT16(0.f);
    const int nt = J.n0 + J.n1;
    const unsigned lds0 = (unsigned)(uintptr_t)lds;
    unsigned ka0, va0;
    { const int q4 = (lane & 15) >> 2, p4 = lane & 3, blk = (lane >> 4) & 1;
      ka0 = lds0 + r32 * 256 + (((J.kc8 + hi) ^ (r32 & 15)) << 4);
      va0 = lds0 + 49152 + (4 * hi + q4) * 256 + ((q4 << 6) | (blk << 5) | (p4 << 3)); }
#define ka(i) (ka0 ^ ((i) << 5))
#define va(i) (va0 ^ ((i) << 6))
#define AB_TROW(t) ((t) < J.n0 ? J.seg0_row + 64 * (t) : J.seg1_row + 64 * ((t) - J.n0))
    unsigned dko[2], dvo[2];
#pragma unroll
    for (int i = 0; i < 2; ++i) { const int row_ = 4 * (2 * wave + i) + (lane >> 4), cp_ = lane & 15;
        dko[i] = (unsigned)(row_ * INW + J.kcolT + ((cp_ ^ (row_ & 15)) << 3)) * 2u; dvo[i] = (unsigned)(row_ * INW + J.vcolT + (((((cp_ >> 2) ^ (row_ & 3)) << 2) | (cp_ & 3)) << 3)) * 2u; }
#define AB_DMA(t, st) do { const char* src_ = (const char*)(P + (size_t)AB_TROW(t) * INW); \
        _Pragma("unroll") for (int i = 0; i < 2; ++i) __builtin_amdgcn_global_load_lds((const unsigned*)(src_ + dko[i]), (LAS unsigned*)(lds + (st) * 16384 + (2 * wave + i) * 1024), 16, 0, 0); \
        _Pragma("unroll") for (int i = 0; i < 2; ++i) __builtin_amdgcn_global_load_lds((const unsigned*)(src_ + dvo[i]), (LAS unsigned*)(lds + 49152 + (st) * 16384 + (2 * wave + i) * 1024), 16, 0, 0); } while (0)
#define AB_KREAD(ST) do { \
        LDSRD128(kf[0], ka(0), (ST) * 16384); LDSRD128(kf[1], ka(0), (ST) * 16384 + 8192); LDSRD128(kf[2], ka(1), (ST) * 16384); LDSRD128(kf[3], ka(1), (ST) * 16384 + 8192); \
        LDSRD128(kf[4], ka(2), (ST) * 16384); LDSRD128(kf[5], ka(2), (ST) * 16384 + 8192); LDSRD128(kf[6], ka(3), (ST) * 16384); LDSRD128(kf[7], ka(3), (ST) * 16384 + 8192); } while (0)
#define AB_QKM(S0, S1) do { S0 = MFMA32(kf[0], qf[0], negm); S1 = MFMA32(kf[1], qf[0], negm); S0 = MFMA32(kf[2], qf[1], S0); S1 = MFMA32(kf[3], qf[1], S1); \
        S0 = MFMA32(kf[4], qf[2], S0); S1 = MFMA32(kf[5], qf[2], S1); S0 = MFMA32(kf[6], qf[3], S0); S1 = MFMA32(kf[7], qf[3], S1); } while (0)
#define AB_VREAD(VB, D, ST) do { \
        LDSTR64(VB[0], va(D), (ST) * 16384 + 0 * 4096); LDSTR64(VB[1], va(D), (ST) * 16384 + 0 * 4096 + 2048); LDSTR64(VB[2], va(D), (ST) * 16384 + 1 * 4096); LDSTR64(VB[3], va(D), (ST) * 16384 + 1 * 4096 + 2048); \
        LDSTR64(VB[4], va(D), (ST) * 16384 + 2 * 4096); LDSTR64(VB[5], va(D), (ST) * 16384 + 2 * 4096 + 2048); LDSTR64(VB[6], va(D), (ST) * 16384 + 3 * 4096); LDSTR64(VB[7], va(D), (ST) * 16384 + 3 * 4096 + 2048); } while (0)
#define AB_PVM(VB, D) do { O[D] = MFMA32(cat8(VB[0], VB[1]), pb00, O[D]); O[D] = MFMA32(cat8(VB[2], VB[3]), pb01, O[D]); O[D] = MFMA32(cat8(VB[4], VB[5]), pb10, O[D]); O[D] = MFMA32(cat8(VB[6], VB[7]), pb11, O[D]); } while (0)
    float m = 0.f, l = 0.f;
    f32x16 c0, c1, negm = SPLAT16(0.f);
    bf16x8 kf[8]; s16x4 vA[8], vB[8];
    AB_DMA(0, 0); if (nt > 1) AB_DMA(1, 1);
    if (nt > 1) asm volatile("s_waitcnt vmcnt(4)" ::: "memory"); else asm volatile("s_waitcnt vmcnt(0)" ::: "memory");
    __syncthreads();
#define AB_VREADK(VB, SS, ST) do { \
        LDSTR64(VB[0], va(0), (ST) * 16384 + (SS) * 4096); LDSTR64(VB[1], va(0), (ST) * 16384 + (SS) * 4096 + 2048); LDSTR64(VB[2], va(1), (ST) * 16384 + (SS) * 4096); LDSTR64(VB[3], va(1), (ST) * 16384 + (SS) * 4096 + 2048); \
        LDSTR64(VB[4], va(2), (ST) * 16384 + (SS) * 4096); LDSTR64(VB[5], va(2), (ST) * 16384 + (SS) * 4096 + 2048); LDSTR64(VB[6], va(3), (ST) * 16384 + (SS) * 4096); LDSTR64(VB[7], va(3), (ST) * 16384 + (SS) * 4096 + 2048); } while (0)
#define AB_EX2(C, B) do { C[B] = __builtin_amdgcn_exp2f(C[B]); C[(B) + 1] = __builtin_amdgcn_exp2f(C[(B) + 1]); } while (0)
#define AB_GAP(VB, D, PB, C, B) do { O[D] = MFMA32(cat8(VB[2 * (D)], VB[2 * (D) + 1]), PB, O[D]); AB_EX2(C, B); __builtin_amdgcn_sched_barrier(0); } while (0)
#define AB_GAPN(VB, D, PB) do { O[D] = MFMA32(cat8(VB[2 * (D)], VB[2 * (D) + 1]), PB, O[D]); __builtin_amdgcn_sched_barrier(0); } while (0)
#define AB_PK(C, B) pack8(C[B], C[(B) + 1], C[(B) + 2], C[(B) + 3], C[(B) + 4], C[(B) + 5], C[(B) + 6], C[(B) + 7])
#define AB_STEP(t, ST) do { \
        if ((t) + 2 < nt && (!(VAR & 4) || (t) < 1)) AB_DMA((t) + 2, ((ST) + 2) % 3); \
        if (!(VAR & 16) || wave < 4) { \
        if (!(VAR & 8)) { AB_KREAD(ST); LGKM_WAIT(0); AB_QKM(c0, c1); } else { c0 = negm; c1 = negm; } \
        AB_VREAD(vA, 0, ST); \
        asm volatile("s_nop 15\n\ts_nop 7" : "+v"(c0), "+v"(c1));     \
        { const float tm_ = rowmax32(c0, c1); const float sh_ = ((t) == 0) ? tm_ : (tm_ > 8.f ? tm_ : 0.f); \
          if (__any(sh_ != 0.f)) { _Pragma("unroll") for (int r = 0; r < 16; ++r) { c0[r] -= sh_; c1[r] -= sh_; } m += sh_; negm = SPLAT16(-m); \
              if ((t) > 0) { const float al_ = __builtin_amdgcn_exp2f(-sh_); l *= al_; _Pragma("unroll") for (int d = 0; d < 4; ++d) O[d] = O[d] * al_; } } } \
        float ls_ = 0.f; \
        { \
        if (!(VAR & 1)) { _Pragma("unroll") for (int r = 0; r < 16; ++r) { c0[r] = __builtin_amdgcn_exp2f(c0[r]); c1[r] = __builtin_amdgcn_exp2f(c1[r]); } } \
        { const f32x16 s_ = c0 + c1; const float s0_ = (s_[0] + s_[1]) + (s_[2] + s_[3]), s1_ = (s_[4] + s_[5]) + (s_[6] + s_[7]), s2_ = (s_[8] + s_[9]) + (s_[10] + s_[11]), s3_ = (s_[12] + s_[13]) + (s_[14] + s_[15]); ls_ = (s0_ + s1_) + (s2_ + s3_); } \
        l += ls_; \
        const bf16x8 pb00 = pack8(c0[0], c0[1], c0[2], c0[3], c0[4], c0[5], c0[6], c0[7]), pb01 = pack8(c0[8], c0[9], c0[10], c0[11], c0[12], c0[13], c0[14], c0[15]); \
        const bf16x8 pb10 = pack8(c1[0], c1[1], c1[2], c1[3], c1[4], c1[5], c1[6], c1[7]), pb11 = pack8(c1[8], c1[9], c1[10], c1[11], c1[12], c1[13], c1[14], c1[15]); \
        if (!(VAR & 2)) { AB_VREAD(vB, 1, ST); LGKM_WAIT(8); AB_PVM(vA, 0); \
        AB_VREAD(vA, 2, ST); LGKM_WAIT(8); AB_PVM(vB, 1); \
        AB_VREAD(vB, 3, ST); LGKM_WAIT(8); AB_PVM(vA, 2); \
        LGKM_WAIT(0); AB_PVM(vB, 3); } else { LGKM_WAIT(0); O[0][0] += c0[0] + (float)vA[0][0]; } } } \
        if ((t) + 2 < nt) asm volatile("s_waitcnt vmcnt(4)" ::: "memory"); else asm volatile("s_waitcnt vmcnt(0)" ::: "memory"); \
        if (!(VAR & 32) || (t) < 2 || (t) + 3 >= nt) __syncthreads(); } while (0)
    for (int t = 0; t < nt; t += 3) {
        AB_STEP(t, 0);
        if (t + 1 < nt) AB_STEP(t + 1, 1);
        if (t + 2 < nt) AB_STEP(t + 2, 2);
    }
#undef ka
#undef va
#undef AB_TROW
#undef AB_DMA
#undef AB_KREAD
#undef AB_QKM
#undef AB_VREAD
#undef AB_PVM
#undef AB_STEP
#undef AB_VREADK
#undef AB_EX2
#undef AB_GAP
#undef AB_GAPN
#undef AB_PK
    l += __shfl_xor(l, 32);
    l_out = l;
}
DI void attn_b_run_w(LAS unsigned char* lds, const bf16* P, const AttnJob& J, f32x16 (&O)[4], float& l_out) {
    const int tid = tid_opaque(), lane = tid & 63, r32 = lane & 31, hi = lane >> 5, wave = __builtin_amdgcn_readfirstlane(tid >> 6);
    bf16x8 qf[4];
#pragma unroll
    for (int d0 = 0; d0 < 4; ++d0) qf[d0] = *(const GAS bf16x8*)(P + (size_t)(J.qrow + r32) * INW + J.qcol + d0 * 16 + hi * 8);
#pragma unroll
    for (int d = 0; d < 4; ++d) O[d] = SPLAT16(0.f);
    const int ns = (J.n0 + J.n1) >> 1;
    const unsigned lds0 = (unsigned)(uintptr_t)lds;
    unsigned ka0, va0;
    { const int q4 = (lane & 15) >> 2, p4 = lane & 3, blk = (lane >> 4) & 1;
      ka0 = lds0 + r32 * 256 + (((J.kc8 + hi) ^ (r32 & 15)) << 4);
      va0 = lds0 + 65536 + (4 * hi + q4) * 256 + ((q4 << 6) | (blk << 5) | (p4 << 3)); }
#define ka(i) (ka0 ^ ((i) << 5))
#define va(i) (va0 ^ ((i) << 6))
#define AW_TROW(t) ((t) < J.n0 ? J.seg0_row + 64 * (t) : J.seg1_row + 64 * ((t) - J.n0))
    unsigned dko[2], dvo[2];
#pragma unroll
    for (int i = 0; i < 2; ++i) { const int row_ = 4 * (2 * wave + i) + (lane >> 4), cp_ = lane & 15;
        dko[i] = (unsigned)(row_ * INW + J.kcolT + ((cp_ ^ (row_ & 15)) << 3)) * 2u; dvo[i] = (unsigned)(row_ * INW + J.vcolT + (((((cp_ >> 2) ^ (row_ & 3)) << 2) | (cp_ & 3)) << 3)) * 2u; }
#define AW_DMA1(t, off) do { const char* src_ = (const char*)(P + (size_t)AW_TROW(t) * INW); \
        _Pragma("unroll") for (int i = 0; i < 2; ++i) __builtin_amdgcn_global_load_lds((const unsigned*)(src_ + dko[i]), (LAS unsigned*)(lds + (off) + (2 * wave + i) * 1024), 16, 0, 0); \
        _Pragma("unroll") for (int i = 0; i < 2; ++i) __builtin_amdgcn_global_load_lds((const unsigned*)(src_ + dvo[i]), (LAS unsigned*)(lds + 65536 + (off) + (2 * wave + i) * 1024), 16, 0, 0); } while (0)
#define AW_DMA(j, st) do { AW_DMA1(2 * (j), (st) * 32768); AW_DMA1(2 * (j) + 1, (st) * 32768 + 16384); } while (0)
#define AW_KREAD(OFF, H) do { \
        LDSRD128(kf[0], ka(2 * (H)), (OFF)); LDSRD128(kf[1], ka(2 * (H)), (OFF) + 8192); LDSRD128(kf[2], ka(2 * (H) + 1), (OFF)); LDSRD128(kf[3], ka(2 * (H) + 1), (OFF) + 8192); } while (0)
#define AW_QKM0(S0, S1) do { S0 = MFMA32(kf[0], qf[0], negm); S1 = MFMA32(kf[1], qf[0], negm); S0 = MFMA32(kf[2], qf[1], S0); S1 = MFMA32(kf[3], qf[1], S1); } while (0)
#define AW_QKM1(S0, S1) do { S0 = MFMA32(kf[0], qf[2], S0); S1 = MFMA32(kf[1], qf[2], S1); S0 = MFMA32(kf[2], qf[3], S0); S1 = MFMA32(kf[3], qf[3], S1); } while (0)
#define AW_VREAD(VB, D, OFF) do { \
        LDSTR64(VB[0], va(D), (OFF) + 0 * 4096); LDSTR64(VB[1], va(D), (OFF) + 0 * 4096 + 2048); LDSTR64(VB[2], va(D), (OFF) + 1 * 4096); LDSTR64(VB[3], va(D), (OFF) + 1 * 4096 + 2048); \
        LDSTR64(VB[4], va(D), (OFF) + 2 * 4096); LDSTR64(VB[5], va(D), (OFF) + 2 * 4096 + 2048); LDSTR64(VB[6], va(D), (OFF) + 3 * 4096); LDSTR64(VB[7], va(D), (OFF) + 3 * 4096 + 2048); } while (0)
#define AW_PVM(VB, D, PA, PB_, PC, PD) do { O[D] = MFMA32(cat8(VB[0], VB[1]), PA, O[D]); O[D] = MFMA32(cat8(VB[2], VB[3]), PB_, O[D]); O[D] = MFMA32(cat8(VB[4], VB[5]), PC, O[D]); O[D] = MFMA32(cat8(VB[6], VB[7]), PD, O[D]); } while (0)
#define AW_PK(C, B) pack8(C[B], C[(B) + 1], C[(B) + 2], C[(B) + 3], C[(B) + 4], C[(B) + 5], C[(B) + 6], C[(B) + 7])
    float m = 0.f, l = 0.f;
    f32x16 c00, c01, c10, c11;
    bf16x8 kf[4]; s16x4 vA[8], vB[8];
    AW_DMA(0, 0);
    asm volatile("s_waitcnt vmcnt(0)" ::: "memory"); __syncthreads();
#define AW_STEP(j, ST) do { \
        if ((j) + 1 < ns) AW_DMA((j) + 1, 1 - (ST)); \
        const f32x16 negm = SPLAT16(-m); \
        AW_KREAD((ST) * 32768, 0); LGKM_WAIT(0); AW_QKM0(c00, c01); AW_KREAD((ST) * 32768, 1); LGKM_WAIT(0); AW_QKM1(c00, c01); \
        AW_KREAD((ST) * 32768 + 16384, 0); LGKM_WAIT(0); AW_QKM0(c10, c11); AW_KREAD((ST) * 32768 + 16384, 1); LGKM_WAIT(0); AW_QKM1(c10, c11); \
        AW_VREAD(vA, 0, (ST) * 32768); \
        asm volatile("s_nop 15\n\ts_nop 7" : "+v"(c00), "+v"(c01), "+v"(c10), "+v"(c11)); \
        { const float tm_ = fmaxf(rowmax32(c00, c01), rowmax32(c10, c11)); const float sh_ = ((j) == 0) ? tm_ : (tm_ > 8.f ? tm_ : 0.f); \
          if (__any(sh_ != 0.f)) { _Pragma("unroll") for (int r = 0; r < 16; ++r) { c00[r] -= sh_; c01[r] -= sh_; c10[r] -= sh_; c11[r] -= sh_; } m += sh_; \
              if ((j) > 0) { const float al_ = __builtin_amdgcn_exp2f(-sh_); l *= al_; _Pragma("unroll") for (int d = 0; d < 4; ++d) O[d] = O[d] * al_; } } } \
        _Pragma("unroll") for (int r = 0; r < 16; ++r) { c00[r] = __builtin_amdgcn_exp2f(c00[r]); c01[r] = __builtin_amdgcn_exp2f(c01[r]); c10[r] = __builtin_amdgcn_exp2f(c10[r]); c11[r] = __builtin_amdgcn_exp2f(c11[r]); } \
        { const f32x16 s_ = (c00 + c01) + (c10 + c11); const float s0_ = (s_[0] + s_[1]) + (s_[2] + s_[3]), s1_ = (s_[4] + s_[5]) + (s_[6] + s_[7]), s2_ = (s_[8] + s_[9]) + (s_[10] + s_[11]), s3_ = (s_[12] + s_[13]) + (s_[14] + s_[15]); l += (s0_ + s1_) + (s2_ + s3_); } \
        const bf16x8 pa0 = AW_PK(c00, 0), pa1 = AW_PK(c00, 8), pa2 = AW_PK(c01, 0), pa3 = AW_PK(c01, 8); \
        AW_VREAD(vB, 1, (ST) * 32768); LGKM_WAIT(8); AW_PVM(vA, 0, pa0, pa1, pa2, pa3); \
        AW_VREAD(vA, 2, (ST) * 32768); LGKM_WAIT(8); AW_PVM(vB, 1, pa0, pa1, pa2, pa3); \
        AW_VREAD(vB, 3, (ST) * 32768); LGKM_WAIT(8); AW_PVM(vA, 2, pa0, pa1, pa2, pa3); \
        AW_VREAD(vA, 0, (ST) * 32768 + 16384); LGKM_WAIT(8); AW_PVM(vB, 3, pa0, pa1, pa2, pa3); \
        const bf16x8 pb0 = AW_PK(c10, 0), pb1 = AW_PK(c10, 8), pb2 = AW_PK(c11, 0), pb3 = AW_PK(c11, 8); \
        AW_VREAD(vB, 1, (ST) * 32768 + 16384); LGKM_WAIT(8); AW_PVM(vA, 0, pb0, pb1, pb2, pb3); \
        AW_VREAD(vA, 2, (ST) * 32768 + 16384); LGKM_WAIT(8); AW_PVM(vB, 1, pb0, pb1, pb2, pb3); \
        AW_VREAD(vB, 3, (ST) * 32768 + 16384); LGKM_WAIT(8); AW_PVM(vA, 2, pb0, pb1, pb2, pb3); \
        LGKM_WAIT(0); AW_PVM(vB, 3, pb0, pb1, pb2, pb3); \
        asm volatile("s_waitcnt vmcnt(0)" ::: "memory"); __syncthreads(); } while (0)
    for (int j = 0; j < ns; j += 2) {
        AW_STEP(j, 0);
        if (j + 1 < ns) AW_STEP(j + 1, 1);
    }
#undef ka
#undef va
#undef AW_TROW
#undef AW_DMA1
#undef AW_DMA
#undef AW_KREAD
#undef AW_QKM0
#undef AW_QKM1
#undef AW_VREAD
#undef AW_PVM
#undef AW_PK
#undef AW_STEP
    l += __shfl_xor(l, 32);
    l_out = l;
}
template <int VAR> DI void ph_attn_b(LAS unsigned char* lds, const bf16* P, bf16* OB, const float* dnw, float lam, float lam_init, bool with_ctx, int vcu, int G) {
    const int lane = tid_opaque() & 63, wave = __builtin_amdgcn_readfirstlane(tid_opaque() >> 6), r32 = lane & 31, hi = lane >> 5;
    const int nun = 512 + (with_ctx ? 16 : 0);
    LAS float* XB = (LAS float*)lds;
    for (int u = vcu; u < nun; u += G) {
        AttnJob J; int b, h, q0; const bool cq = u >= 512; const int qs = wave & 3, comp = wave >> 2;
        if (!cq) { b = u >> 8; h = (u >> 6) & 3; q0 = (u & 63) * 128; J.seg0_row = b * SEQ; J.n0 = 128; J.qrow = b * SEQ + q0 + 32 * qs; }
        else { const int v = u - 512; b = v >> 3; h = (v >> 1) & 3; q0 = (v & 1) * 128; J.seg0_row = 0; J.n0 = 0; J.qrow = NLAT + b * CTXL + q0 + 32 * qs; }
        J.seg0_kpos0 = 0; J.qpos0 = 0;
        J.qcol = C_BQ + h * 128 + comp * 64; J.kcolT = C_BK + h * 128; J.vcolT = C_BV + h * 128; J.kc8 = comp * 8; J.seg1_row = NLAT + b * CTXL; J.n1 = 4;
        f32x16 O[4]; float l;
        if (VAR == 64 || AB_WIDE) attn_b_run_w(lds, P, J, O, l); else attn_b_run<VAR>(lds, P, J, O, l);
        const float inv = 1.f / l;
        if (comp == 1) {
#pragma unroll
            for (int d = 0; d < 4; ++d)
#pragma unroll
                for (int r = 0; r < 16; ++r) XB[(qs * 128 + 32 * d + crow(r, hi)) * 32 + r32] = O[d][r] * inv;
        }
        __syncthreads();
        if (comp == 0) {
            float ss = 0.f;
#pragma unroll
            for (int d = 0; d < 4; ++d)
#pragma unroll
                for (int r = 0; r < 16; ++r) { const float o = O[d][r] * inv - lam * XB[(qs * 128 + 32 * d + crow(r, hi)) * 32 + r32]; O[d][r] = o; ss += o * o; }
            ss += __shfl_xor(ss, 32);
            const float rs = rsqrtf(ss * (1.f / 128.f) + RMS_EPS) * (1.f - lam_init);
            bf16* op = OB + (size_t)(J.qrow + r32) * 1536 + h * 128;
#pragma unroll
            for (int d = 0; d < 4; ++d)
#pragma unroll
                for (int rg = 0; rg < 4; ++rg) { const int e0 = 32 * d + 8 * rg + 4 * hi; const f32x4 wv = *(const GAS f32x4*)(dnw + e0);
                    u32x2 w; w.x = cvtpk(O[d][4 * rg] * rs * wv[0], O[d][4 * rg + 1] * rs * wv[1]); w.y = cvtpk(O[d][4 * rg + 2] * rs * wv[2], O[d][4 * rg + 3] * rs * wv[3]);
                    *(GAS u32x2*)(op + e0) = w; }
        }
        __syncthreads();
    }
}

DI int hg_row0(int b, int dir, int c) {
    if (dir == 0) return c < 4 ? NLAT + b * CTXL + 64 * c : b * SEQ + 64 * (c - 4);
    return c < 4 ? NLAT + b * CTXL + 64 * (3 - c) : b * SEQ + 64 * (131 - c);
}
DI void glds16(const void* src, LAS unsigned char* dst) { __builtin_amdgcn_global_load_lds((const unsigned*)src, (LAS unsigned*)dst, 16, 0, 0); }
DI void ph_hg1(LAS unsigned char* lds, const bf16* P, const float* LF, bf16* HU, float* HD, int vcu, int G) {
    const int tid = tid_opaque(), lane = tid & 63, wave = __builtin_amdgcn_readfirstlane(tid >> 6), r32 = lane & 31, hi = lane >> 5;
    LAS float* LFs = (LAS float*)lds; LAS unsigned char* Vs = lds + 32768; LAS unsigned char* KH = lds + 49152; LAS float* TOT = (LAS float*)(lds + 65536);
    for (int u = vcu; u < NB * 2 * NCH * 4; u += G) {
        const int h = u & 3, c = (u >> 2) % NCH, dir = ((u >> 2) / NCH) & 1, b = (u >> 2) / (2 * NCH), row0 = hg_row0(b, dir, c);
        const int uidx = ((b * 2 + dir) * 4 + h) * NCH + c;
#pragma unroll
        for (int i = 0; i < 4; ++i) { const int slot = 4 * wave + i, row = 2 * slot + (lane >> 5), ch = lane & 31;
            glds16(LF + (size_t)(row0 + row) * 1024 + dir * 512 + h * 128 + ch * 4, lds + slot * 1024); }
#pragma unroll
        for (int i = 0; i < 2; ++i) { const int slot = 2 * wave + i, row = 4 * slot + (lane >> 4), cp = lane & 15, sc = ((((cp >> 2) ^ (row & 3)) << 2) | (cp & 3));
            glds16(P + (size_t)(row0 + row) * INW + C_CI + h * 128 + sc * 8, Vs + slot * 1024); }
        asm volatile("s_waitcnt vmcnt(0)" ::: "memory"); __syncthreads();
        const int d = tid & 127, q = tid >> 7;
        float lf[16]; float sum = 0.f;
#pragma unroll
        for (int j = 0; j < 16; ++j) { lf[j] = LFs[(16 * q + j) * 128 + d]; sum += lf[j]; }
        TOT[q * 128 + d] = sum;
        __syncthreads();
        const float t0 = TOT[d], t1 = TOT[128 + d], t2 = TOT[256 + d], t3 = TOT[384 + d], total = (t0 + t1) + (t2 + t3);
        float pre = (q > 0 ? t0 : 0.f) + (q > 1 ? t1 : 0.f) + (q > 2 ? t2 : 0.f);
        float kv[16];
#pragma unroll
        for (int j = 0; j < 16; ++j) { const float arg = dir == 0 ? (total - pre - lf[j]) : pre; pre += lf[j]; kv[j] = (1.f - __expf(lf[j])) * __expf(arg); }
        *(LAS bf16x8*)(KH + d * 128 + (((2 * q) ^ ((d >> 1) & 7)) << 4)) = pack8(kv[0], kv[1], kv[2], kv[3], kv[4], kv[5], kv[6], kv[7]);
        *(LAS bf16x8*)(KH + d * 128 + (((2 * q + 1) ^ ((d >> 1) & 7)) << 4)) = pack8(kv[8], kv[9], kv[10], kv[11], kv[12], kv[13], kv[14], kv[15]);
        if (q == 0) HD[(size_t)uidx * 128 + d] = __expf(total);
        __syncthreads();
        const int eb = wave & 3, dkb0 = 2 * (wave >> 2), q4 = (lane & 15) >> 2, p4 = lane & 3, blk = (lane >> 4) & 1;
        f32x16 acc[2]; acc[0] = SPLAT16(0.f); acc[1] = SPLAT16(0.f);
#pragma unroll
        for (int ks = 0; ks < 4; ++ks) {
            const int r0 = 16 * ks + 8 * hi + q4, r1 = r0 + 4;
            const s16x4 lo = tr_read((LAS const char*)(Vs + r0 * 256 + (((eb ^ (r0 & 3)) << 6) | (blk << 5) | (p4 << 3))));
            const s16x4 hh = tr_read((LAS const char*)(Vs + r1 * 256 + (((eb ^ (r1 & 3)) << 6) | (blk << 5) | (p4 << 3))));
            const bf16x8 vf = cat8(lo, hh);
#pragma unroll
            for (int j = 0; j < 2; ++j) { const int R = 32 * (dkb0 + j) + r32, ch = 2 * ks + hi;
                const bf16x8 kf = *(const LAS bf16x8*)(KH + R * 128 + ((ch ^ ((R >> 1) & 7)) << 4));
                acc[j] = MFMA32(vf, kf, acc[j]); }
        }
        bf16* hu = HU + (size_t)uidx * 16384;
#pragma unroll
        for (int j = 0; j < 2; ++j)
#pragma unroll
            for (int r = 0; r < 16; ++r) hu[(32 * eb + crow(r, hi)) * 128 + 32 * (dkb0 + j) + r32] = (bf16)(cvtpk(acc[j][r], 0.f) & 0xffffu);
        __syncthreads();
    }
}
DI void ph_hg2(const bf16* HU, const float* HD, bf16* HS, int vcu, int G) {
    const int gt = vcu * NTHR + tid_opaque(), NT = G * NTHR;
    for (int idx = gt; idx < 16 * 8192; idx += NT) {
        const int chain = idx >> 13, pr = idx & 8191, e = pr >> 6, dk = (pr & 63) * 2;
        const bf16* up = HU + (size_t)chain * NCH * 16384 + e * 128 + dk; const float* dp = HD + (size_t)chain * NCH * 128 + dk; bf16* sp = HS + (size_t)chain * NCH * 16384 + e * 128 + dk;
        float s0 = 0.f, s1 = 0.f;
        for (int c0 = 0; c0 < NCH; c0 += 22) {
            unsigned uu[22]; f32x2 dd[22];
#pragma unroll
            for (int j = 0; j < 22; ++j) { uu[j] = *(const GAS unsigned*)(up + (size_t)(c0 + j) * 16384); dd[j] = *(const GAS f32x2*)(dp + (size_t)(c0 + j) * 128); }
#pragma unroll
            for (int j = 0; j < 22; ++j) { *(GAS unsigned*)(sp + (size_t)(c0 + j) * 16384) = cvtpk(s0, s1); s0 = dd[j].x * s0 + bflo(uu[j]); s1 = dd[j].y * s1 + bfhi(uu[j]); }
        }
    }
}
DI void ph_hg3(LAS unsigned char* lds, const bf16* P, const float* LF, const bf16* HS, bf16* OC, const float* hw, bool with_ctx, int vcu, int G, int probe_mode = 0) {
    const int tid = tid_opaque(), lane = tid & 63, wave = __builtin_amdgcn_readfirstlane(tid >> 6), tl = lane & 15, kg = lane >> 4;
    LAS float* BC = (LAS float*)lds; LAS unsigned char* VT = lds + 65536; LAS unsigned char* HSs = lds + 81920; LAS float* CB = (LAS float*)(lds + 81920);
    const int tc_lo = with_ctx ? 0 : 4, ntc = NCH - tc_lo, nun = NB * ntc * 4;
    for (int u = vcu; u < nun; u += G) {
        const int b = u / (ntc * 4), tc = tc_lo + (u / 4) % ntc, h = u & 3;
        const int row0 = tc < 4 ? NLAT + b * CTXL + 64 * tc : b * SEQ + 64 * (tc - 4);
        const int dir = wave >> 2, I = wave & 3, t = 16 * I + tl;
        v4u qw[4];
#pragma unroll
        for (int ks = 0; ks < 4; ++ks) qw[ks] = *(const GAS v4u*)(P + (size_t)(row0 + t) * INW + C_CQ + h * 128 + 32 * ks + 8 * kg);
        u32x2 gwv[8];
#pragma unroll
        for (int eb = 0; eb < 8; ++eb) gwv[eb] = *(const GAS u32x2*)(P + (size_t)(row0 + t) * INW + C_CG + h * 128 + 16 * eb + 4 * kg);
#pragma unroll
        for (int i = 0; i < 8; ++i) { const int slot = 8 * wave + i, dd = slot >> 5, row = 2 * (slot & 31) + (lane >> 5), ch = lane & 31;
            glds16(LF + (size_t)(row0 + row) * 1024 + dd * 512 + h * 128 + ch * 4, lds + slot * 1024); }
#pragma unroll
        for (int i = 0; i < 2; ++i) { const int slot = 2 * wave + i, row = 4 * slot + (lane >> 4), cp = lane & 15, sc = ((((cp >> 2) ^ (row & 3)) << 2) | (cp & 3));
            glds16(P + (size_t)(row0 + row) * INW + C_CI + h * 128 + sc * 8, VT + slot * 1024); }
#pragma unroll
        for (int i = 0; i < 8; ++i) { const int slot = 8 * wave + i, dd = slot >> 5, row = 4 * (slot & 31) + (lane >> 4), cp = lane & 15;
            const int cs = dd == 0 ? tc : (tc < 4 ? 3 - tc : 135 - tc);
            glds16(HS + ((size_t)(((b * 2 + dd) * 4 + h) * NCH + cs) * 128 + row) * 128 + ((cp ^ (row & 15)) << 3), HSs + slot * 1024); }
        asm volatile("s_waitcnt vmcnt(0)" ::: "memory"); __syncthreads();
        if (probe_mode == 1) { asm volatile("" :: "v"(qw[0]), "v"(qw[3])); __syncthreads(); continue; }
        if (tid < 256) { const int dd = tid >> 7, d = tid & 127; LAS float* col = BC + dd * 8192 + d; float v[64];
#pragma unroll
            for (int j = 0; j < 64; ++j) v[j] = col[j * 128];
            float a = 0.f;
            if (dd == 0) {
#pragma unroll
                for (int j = 0; j < 64; ++j) { a += v[j]; col[j * 128] = a; }
            } else {
#pragma unroll
                for (int j = 63; j >= 0; --j) { a += v[j]; col[j * 128] = a; }
            }
        }
        __syncthreads();
        if (probe_mode == 2) { asm volatile("" :: "v"(qw[0]), "v"(qw[3])); continue; }
        const LAS float* bc = BC + dir * 8192;
        const bool hasb = dir == 0 ? (I > 0) : (I < 3); const int brow = dir == 0 ? 16 * I - 1 : 16 * I + 16;
        bf16x8 qh[4], qt[4];
#pragma unroll
        for (int ks = 0; ks < 4; ++ks) { const int dk0 = 32 * ks + 8 * kg;
            const f32x4 b0 = *(const LAS f32x4*)(bc + t * 128 + dk0), b1 = *(const LAS f32x4*)(bc + t * 128 + dk0 + 4);
            f32x4 e0 = (f32x4){0.f, 0.f, 0.f, 0.f}, e1 = e0; if (hasb) { e0 = *(const LAS f32x4*)(bc + brow * 128 + dk0); e1 = *(const LAS f32x4*)(bc + brow * 128 + dk0 + 4); }
            const float q0 = bflo(qw[ks].x), q1 = bfhi(qw[ks].x), q2 = bflo(qw[ks].y), q3 = bfhi(qw[ks].y), q4 = bflo(qw[ks].z), q5 = bfhi(qw[ks].z), q6 = bflo(qw[ks].w), q7 = bfhi(qw[ks].w);
            qh[ks] = pack8(q0 * __expf(b0[0]), q1 * __expf(b0[1]), q2 * __expf(b0[2]), q3 * __expf(b0[3]), q4 * __expf(b1[0]), q5 * __expf(b1[1]), q6 * __expf(b1[2]), q7 * __expf(b1[3]));
            qt[ks] = pack8(q0 * __expf(b0[0] - e0[0]), q1 * __expf(b0[1] - e0[1]), q2 * __expf(b0[2] - e0[2]), q3 * __expf(b0[3] - e0[3]),
                           q4 * __expf(b1[0] - e1[0]), q5 * __expf(b1[1] - e1[1]), q6 * __expf(b1[2] - e1[2]), q7 * __expf(b1[3] - e1[3])); }
        f32x4 acc[8];
#pragma unroll
        for (int eb = 0; eb < 8; ++eb) acc[eb] = (f32x4){0.f, 0.f, 0.f, 0.f};
#pragma unroll
        for (int ks = 0; ks < 4; ++ks)
#pragma unroll
            for (int eb = 0; eb < 8; ++eb) { const int er = 16 * eb + tl;
                const bf16x8 sf = *(const LAS bf16x8*)(HSs + dir * 32768 + er * 256 + (((4 * ks + kg) ^ (er & 15)) << 4)); acc[eb] = MFMA16(sf, qh[ks], acc[eb]); }
        if (probe_mode == 3) { asm volatile("" :: "v"(acc[0]), "v"(acc[7]), "v"(qt[0]), "v"(qt[3])); __syncthreads(); continue; }
        f32x4 att[4];
#pragma unroll
        for (int Jb = 0; Jb < 4; ++Jb) {
            att[Jb] = (f32x4){0.f, 0.f, 0.f, 0.f};
            const bool active = dir == 0 ? (Jb <= I) : (Jb >= I);
            if (active) {
                const int s = 16 * Jb + tl; f32x4 a = (f32x4){0.f, 0.f, 0.f, 0.f};
                const int sp = dir == 0 ? s - 1 : s + 1; const bool hasp = dir == 0 ? (s > 0) : (s < 63);
#pragma unroll
                for (int ks = 0; ks < 4; ++ks) { const int dk0 = 32 * ks + 8 * kg;
                    const f32x4 b0 = *(const LAS f32x4*)(bc + s * 128 + dk0), b1 = *(const LAS f32x4*)(bc + s * 128 + dk0 + 4);
                    f32x4 p0 = (f32x4){0.f, 0.f, 0.f, 0.f}, p1 = p0; if (hasp) { p0 = *(const LAS f32x4*)(bc + sp * 128 + dk0); p1 = *(const LAS f32x4*)(bc + sp * 128 + dk0 + 4); }
                    f32x4 e0 = (f32x4){0.f, 0.f, 0.f, 0.f}, e1 = e0; if (hasb) { e0 = *(const LAS f32x4*)(bc + brow * 128 + dk0); e1 = *(const LAS f32x4*)(bc + brow * 128 + dk0 + 4); }
                    float kv[8];
#pragma unroll
                    for (int j = 0; j < 4; ++j) { kv[j] = (1.f - __expf(b0[j] - p0[j])) * __expf(fminf(e0[j] - b0[j], 80.f)); kv[4 + j] = (1.f - __expf(b1[j] - p1[j])) * __expf(fminf(e1[j] - b1[j], 80.f)); }
                    a = MFMA16(pack8(kv[0], kv[1], kv[2], kv[3], kv[4], kv[5], kv[6], kv[7]), qt[ks], a); }
                if (Jb == I) {
#pragma unroll
                    for (int r = 0; r < 4; ++r) { const int sl = 4 * kg + r; const bool keep = dir == 0 ? (sl <= tl) : (sl >= tl); if (!keep) a[r] = 0.f; }
                }
                att[Jb] = a;
            }
        }
        if (probe_mode == 4) { asm volatile("" :: "v"(acc[0]), "v"(acc[7]), "v"(att[0]), "v"(att[1]), "v"(att[2]), "v"(att[3])); __syncthreads(); continue; }
        { const int q4 = tl >> 2, p4 = tl & 3;
#pragma unroll
            for (int pr = 0; pr < 2; ++pr) {
                const bool any = dir == 0 ? (2 * pr <= I) : (2 * pr + 1 >= I);
                if (any) {
                    const f32x4 a0 = att[2 * pr], a1 = att[2 * pr + 1];
                    const bf16x8 ab = pack8(a0[0], a0[1], a0[2], a0[3], a1[0], a1[1], a1[2], a1[3]);
                    const int r0 = 32 * pr + 4 * kg + q4, r1 = r0 + 16;
#pragma unroll
                    for (int eb = 0; eb < 8; ++eb) {
                        const s16x4 lo = tr_read((LAS const char*)(VT + r0 * 256 + ((((eb >> 1) ^ (r0 & 3)) << 6) | ((eb & 1) << 5) | (p4 << 3))));
                        const s16x4 hh = tr_read((LAS const char*)(VT + r1 * 256 + ((((eb >> 1) ^ (r1 & 3)) << 6) | ((eb & 1) << 5) | (p4 << 3))));
                        acc[eb] = MFMA16(cat8(lo, hh), ab, acc[eb]); }
                }
            }
        }
        __syncthreads();
        if (dir == 1) {
#pragma unroll
            for (int eb = 0; eb < 8; ++eb) *(LAS f32x4*)(CB + ((I * 16 + tl) * 128 + 16 * eb + 4 * kg)) = acc[eb];
        }
        __syncthreads();
        if (dir == 0) {
            float ss = 0.f;
#pragma unroll
            for (int eb = 0; eb < 8; ++eb) { acc[eb] = acc[eb] + *(const LAS f32x4*)(CB + ((I * 16 + tl) * 128 + 16 * eb + 4 * kg)); ss += (acc[eb][0] * acc[eb][0] + acc[eb][1] * acc[eb][1]) + (acc[eb][2] * acc[eb][2] + acc[eb][3] * acc[eb][3]); }
            ss += __shfl_xor(ss, 16); ss += __shfl_xor(ss, 32);
            const float rs = rsqrtf(ss * (1.f / 128.f) + RMS_EPS);
#pragma unroll
            for (int eb = 0; eb < 8; ++eb) { const int e0 = 16 * eb + 4 * kg; const f32x4 wv = *(const GAS f32x4*)(hw + e0);
                const u32x2 gw = gwv[eb];
                u32x2 w; w.x = cvtpk(acc[eb][0] * rs * wv[0] * bflo(gw.x), acc[eb][1] * rs * wv[1] * bfhi(gw.x)); w.y = cvtpk(acc[eb][2] * rs * wv[2] * bflo(gw.y), acc[eb][3] * rs * wv[3] * bfhi(gw.y));
                *(GAS u32x2*)(OC + (size_t)(row0 + t) * 1536 + h * 128 + e0) = w; }
        }
        __syncthreads();
    }
}

#define R2_PROBE_NOROUTER 0
DI void ph_r2(LAS unsigned char* lds, const float* xin, const float* cin, float* XA, const float* XA2, bool do_route, const bf16* YO, unsigned char* H, const float* MODl, const float* ng, const float* wr, const float* br,
              unsigned* cnt, int* TOPE, float* GATE, int* RANK, int l, int nrows, int vcu, int G) {
    const int tid = tid_opaque(), lane = tid & 63, wave = __builtin_amdgcn_readfirstlane(tid >> 6);
    for (int i = tid; i < 1024 * 8; i += NTHR) { const int k = i >> 3, ch = i & 7, slot = ((k >> 8) * 4 + (k & 3)) * 64 + ((k >> 2) & 63);
        *(LAS f32x4*)(lds + slot * 128 + ((ch ^ (slot & 7)) << 4)) = *(const GAS f32x4*)(wr + k * 32 + ch * 4); }
    __syncthreads();
    for (int row = vcu * NWAVES + wave; row < nrows; row += G * NWAVES) {
        const int mj = row < NLAT ? row / SEQ : 2; const float* md = MODl + mj * 6144;
        const float* xp = (l == 0) ? (row < NLAT ? xin + (size_t)row * 1024 : cin + (size_t)(row - NLAT) * 1024) : XA2 + (size_t)row * 1024;
        f32x4 x[4], y[4]; row_ld(xp, lane, x); row_ld_bf(YO + (size_t)row * 1024, lane, y);
        const float ry = row_rstd(y);
#pragma unroll
        for (int j = 0; j < 4; ++j) { const f32x4 g1 = ((const GAS f32x4*)(ng + 1024))[lane + 64 * j], m2 = ((const GAS f32x4*)(md + 2048))[lane + 64 * j]; x[j] = x[j] + m2 * (y[j] * ry * g1); }
        row_st(XA + (size_t)row * 1024, lane, x);
        f32x4 h[4]; row_modulate(x, ng + 2048, md + 3 * 1024, md + 4 * 1024, lane, h);
        row_st_f8(H + (size_t)row * 1024, lane, h, F8_ACT);
        if (R2_PROBE_NOROUTER && !do_route) continue;
        float acc[32];
#pragma unroll
        for (int e = 0; e < 32; ++e) acc[e] = 0.f;
        f32x4 wA[8], wB[8];
#define R2_WLD(W, S) do { const int slot_ = (S) * 64 + lane; _Pragma("unroll") for (int ch = 0; ch < 8; ++ch) W[ch] = *(const LAS f32x4*)(lds + slot_ * 128 + ((ch ^ (slot_ & 7)) << 4)); } while (0)
#define R2_FMA(W, HV) do { const float hv_ = (HV); _Pragma("unroll") for (int ch = 0; ch < 8; ++ch) { acc[4 * ch] += hv_ * W[ch][0]; acc[4 * ch + 1] += hv_ * W[ch][1]; acc[4 * ch + 2] += hv_ * W[ch][2]; acc[4 * ch + 3] += hv_ * W[ch][3]; } } while (0)
        R2_WLD(wA, 0);
#pragma unroll
        for (int s2 = 0; s2 < 8; ++s2) {
            R2_WLD(wB, 2 * s2 + 1); R2_FMA(wA, h[(2 * s2) >> 2][(2 * s2) & 3]); __builtin_amdgcn_sched_barrier(0);
            if (s2 < 7) R2_WLD(wA, 2 * s2 + 2); R2_FMA(wB, h[(2 * s2 + 1) >> 2][(2 * s2 + 1) & 3]); __builtin_amdgcn_sched_barrier(0);
        }
#undef R2_WLD
#undef R2_FMA
#define R2_STEP(N, BIT) _Pragma("unroll") for (int i = 0; i < N; ++i) { const float lo = acc[i], hi = acc[i + N]; const bool up = (lane & BIT) != 0; const float keep = up ? hi : lo, send = up ? lo : hi; acc[i] = keep + __shfl_xor(send, BIT); }
        R2_STEP(16, 32) R2_STEP(8, 16) R2_STEP(4, 8) R2_STEP(2, 4) R2_STEP(1, 2)
#undef R2_STEP
        const int me = (lane >> 1) & 31;
        const float lg = acc[0] + __shfl_xor(acc[0], 1) + br[me];
        const unsigned lb_ = __float_as_uint(lg);
        unsigned key = ((lb_ ^ (unsigned)(((int)lb_ >> 31) | 0x80000000)) & ~31u) | (unsigned)(31 - me);
        float tv[4]; int te[4];
#pragma unroll
        for (int k = 0; k < 4; ++k) {
            unsigned r = key;
            r = max(r, (unsigned)__builtin_amdgcn_update_dpp(0, (int)r, 0xB1, 0xF, 0xF, true));
            r = max(r, (unsigned)__builtin_amdgcn_update_dpp(0, (int)r, 0x4E, 0xF, 0xF, true));
            r = max(r, (unsigned)__builtin_amdgcn_update_dpp(0, (int)r, 0x141, 0xF, 0xF, true));
            r = max(r, (unsigned)__builtin_amdgcn_update_dpp(0, (int)r, 0x140, 0xF, 0xF, true));
            const unsigned r0 = (unsigned)__builtin_amdgcn_readlane((int)r, 0), r1 = (unsigned)__builtin_amdgcn_readlane((int)r, 16), r2 = (unsigned)__builtin_amdgcn_readlane((int)r, 32), r3 = (unsigned)__builtin_amdgcn_readlane((int)r, 48);
            const unsigned km = max(max(r0, r1), max(r2, r3));
            const int idx = 31 - (int)(km & 31u);
            te[k] = idx; tv[k] = __uint_as_float((unsigned)__builtin_amdgcn_readlane((int)lb_, 2 * idx));
            if (me == idx) key = 0u;
        }
        const float e1 = __expf(tv[1] - tv[0]), e2 = __expf(tv[2] - tv[0]), e3 = __expf(tv[3] - tv[0]), inv = 1.f / (1.f + e1 + e2 + e3);
        if (do_route && lane < 4) { const int ek = lane == 0 ? te[0] : lane == 1 ? te[1] : lane == 2 ? te[2] : te[3]; const float gk = (lane == 0 ? 1.f : lane == 1 ? e1 : lane == 2 ? e2 : e3) * inv;
            const unsigned rk = atomicAdd(cnt + ek, 1u);
            TOPE[row * 4 + lane] = ek; GATE[row * 4 + lane] = gk; RANK[row * 4 + lane] = (int)rk; }
    }
}
DI void moe_tables(volatile LAS int* tb, const unsigned* cnt) {
    if (tid_opaque() == 0) { int t = 0;
        for (int e = 0; e < 32; ++e) { const int c = (int)__hip_atomic_load(cnt + e, __ATOMIC_RELAXED, __HIP_MEMORY_SCOPE_AGENT); tb[e] = t; tb[40 + e] = t * 256; t += (c + 255) >> 8; }
        tb[32] = t; }
    __syncthreads();
}
DI void ph_r3(volatile LAS int* tb, const unsigned char* H, unsigned char* XG, const int* TOPE, const int* RANK, int* DEST, int nrows, int vcu, int G) {
    const int lane = tid_opaque() & 63, wave = __builtin_amdgcn_readfirstlane(tid_opaque() >> 6);
    for (int row0 = (vcu * NWAVES + wave) * 4; row0 < nrows; row0 += G * NWAVES * 4) {
        v4u h0[4]; int ek[4], rk[4];
#pragma unroll
        for (int q = 0; q < 4; ++q) { h0[q] = ((const GAS v4u*)(H + (size_t)(row0 + q) * 1024))[lane]; ek[q] = TOPE[(row0 + q) * 4 + (lane & 3)]; rk[q] = RANK[(row0 + q) * 4 + (lane & 3)]; }
#pragma unroll
        for (int q = 0; q < 4; ++q) { const int dl = tb[40 + ek[q]] + rk[q];
            if (lane < 4) DEST[(row0 + q) * 4 + lane] = dl;
#pragma unroll
            for (int k = 0; k < 4; ++k) { const int d = __builtin_amdgcn_readlane(dl, k); ((GAS v4u*)(XG + (size_t)d * 1024))[lane] = h0[q]; } }
    }
}
DI void ph_r4(const float* XA, float* XA2, const bf16* YS, const int* DEST, const float* GATE, const float* MODl, const float* ng, float* out, unsigned char* H, bf16* HBn, const float* MODn, const float* ngn, bool last, int nrows, int vcu, int G) {
    const int lane = tid_opaque() & 63, wave = __builtin_amdgcn_readfirstlane(tid_opaque() >> 6);
    for (int row0 = (vcu * NWAVES + wave) * 2; row0 < nrows; row0 += G * NWAVES * 2) {
        f32x4 f[2][4], x[2][4]; float gk[2][4]; int dk[2][4];
#pragma unroll
        for (int q = 0; q < 2; ++q) { const int row = row0 + q;
#pragma unroll
            for (int k = 0; k < 4; ++k) { dk[q][k] = DEST[row * 4 + k]; gk[q][k] = GATE[row * 4 + k]; }
            row_ld(XA + (size_t)row * 1024, lane, x[q]); }
#pragma unroll
        for (int q = 0; q < 2; ++q) {
#pragma unroll
            for (int j = 0; j < 4; ++j) f[q][j] = (f32x4){0.f, 0.f, 0.f, 0.f};
#pragma unroll
            for (int k = 0; k < 4; ++k) { f32x4 y[4]; row_ld_bf(YS + (size_t)dk[q][k] * 1024, lane, y);
#pragma unroll
                for (int j = 0; j < 4; ++j) f[q][j] = f[q][j] + y[j] * gk[q][k]; } }
#pragma unroll
        for (int q = 0; q < 2; ++q) { const int row = row0 + q;
            const int mj = row < NLAT ? row / SEQ : 2; const float* md = MODl + mj * 6144;
            const float rf = row_rstd(f[q]);
#pragma unroll
            for (int j = 0; j < 4; ++j) { const f32x4 g3 = ((const GAS f32x4*)(ng + 3 * 1024))[lane + 64 * j], m5 = ((const GAS f32x4*)(md + 5 * 1024))[lane + 64 * j]; x[q][j] = x[q][j] + m5 * (f[q][j] * rf * g3); }
            if (last) row_st(out + (size_t)row * 1024, lane, x[q]);
            else { row_st(XA2 + (size_t)row * 1024, lane, x[q]);
                f32x4 h[4]; row_modulate(x[q], ngn, MODn + mj * 6144, MODn + mj * 6144 + 1024, lane, h); if (INP_FP8 || INP_L1_FP8) row_st_f8(H + (size_t)row * 1024, lane, h, F8_ACT); if (!INP_FP8) row_st_bf(HBn + (size_t)row * 1024, lane, h); } }
    }
}

#define PROF_MASK 0
#define AB_PROBE -1
#define GEMM_PROBE 0
#define HG3_PROBE 0
#define TS_SEL -1
#define TSB(id) do { if (TS_SEL == (id) && bx == 0 && tid_opaque() == 0) tsum -= (long long)rt(); } while (0)
#define TSE(id) do { if (TS_SEL == (id) && bx == 0 && tid_opaque() == 0) tsum += (long long)rt(); } while (0)
#define REP(bit) for (int rep_ = 0; rep_ < (((PROF_MASK) >> (bit)) & 1 ? 2 : 1); ++rep_)
#ifndef PHM
#define PHM 0x7fff
#endif
struct Args { const float* in[21]; float* out; unsigned char* ws; };
__global__ void __launch_bounds__(NTHR, 2) fwd_mega(Args a) {
    extern __shared__ __attribute__((aligned(16))) unsigned char lds_raw[];
    LAS unsigned char* lds = (LAS unsigned char*)lds_raw;
    volatile LAS unsigned* MISC = (volatile LAS unsigned*)(lds + MISC_OFF);
    volatile LAS int* MTB = (volatile LAS int*)(lds + MISC_OFF + 256);
    const int G = gridDim.x, bx = blockIdx.x, vcu = (G % 8 == 0) ? (bx % 8) * (G / 8) + bx / 8 : bx;
#define AS4 __attribute__((address_space(4)))
#define KARGS() ({ const AS4 char* kp_ = (const AS4 char*)__builtin_amdgcn_kernarg_segment_ptr(); asm volatile("" : "+s"(kp_)); kp_; })
#define IN(i) (*(const float* const AS4*)(KARGS() + 8 * (i)))
#define WSB() (*(unsigned char* const AS4*)(KARGS() + 176))
#define OUTP() (*(float* const AS4*)(KARGS() + 168))
#define ctl ((gu32*)(WSB() + WS_CTL))
#define SM ((float*)(WSB() + WS_SMALL))
#define WIN ((bf16*)(WSB() + WS_WIN))
#define WIN8 ((bf16*)(WSB() + WS_WIN8))
#define WINB ((bf16*)(WSB() + WS_WIN + 16 * MiB))
#define WBR ((bf16*)(WSB() + WS_WBR))
#define WO ((bf16*)(WSB() + WS_WO))
#define WGU ((bf16*)(WSB() + WS_WGU))
#define WDN ((bf16*)(WSB() + WS_WDN))
#define XA ((float*)(WSB() + WS_XA))
#define XA2 ((float*)(WSB() + WS_XA2))
#define H ((unsigned char*)(WSB() + WS_YF))
#define HB ((bf16*)(WSB() + WS_H))
#define P ((bf16*)(WSB() + WS_P))
#define LF ((float*)(WSB() + WS_LF))
#define O3 ((bf16*)(WSB() + WS_O3))
#define HU ((bf16*)(WSB() + WS_HU))
#define HD ((float*)(WSB() + WS_HD))
#define HS ((bf16*)(WSB() + WS_HS))
#define Y ((bf16*)(WSB() + WS_Y))
#define YO ((bf16*)(WSB() + WS_YO))
#define TOPE ((int*)(WSB() + WS_ROUTE))
#define GATE ((float*)(WSB() + WS_ROUTE + 524288 * 1))
#define RANK ((int*)(WSB() + WS_ROUTE + 524288 * 2))
#define DEST ((int*)(WSB() + WS_ROUTE + 524288 * 3))
#define XG ((unsigned char*)(WSB() + WS_XG))
#define ACT ((unsigned char*)(WSB() + WS_ACT))
#define YS ((bf16*)(WSB() + WS_YS))
#define x_in IN(0)
#define c_in IN(1)
#define ctx_in IN(2)
#define cctx_in IN(3)

    for (int u = tid_opaque(); u < (LDS_BYTES - LDSCTL_OFF) / 4; u += NTHR) ((LAS unsigned*)(lds + LDSCTL_OFF))[u] = 0u;
    __syncthreads();
    XcdBarrier bar = xcd_barrier_post((unsigned*)(ctl + CW_BAR), MISC + 8);
long long tsum = 0;
#define GRID_BAR() do { TSB(30); xcd_barrier(bar); TSE(30); } while (0)

    REP(0) if (PHM & 1) ph_mod(lds, c_in, cctx_in, IN(4), IN(5), SM + SM_MOD, vcu, G);
    if (PHM & 1) ph_tables(SM, IN(11), IN(9), vcu, G);
    GRID_BAR();
    REP(1) if (PHM & 2) {
        const int lane = tid_opaque() & 63, wave = __builtin_amdgcn_readfirstlane(tid_opaque() >> 6);
        LAS float* scr = (LAS float*)(lds + wave * 16384);
        const int gw = vcu * NWAVES + wave, NGW = G * NWAVES;
        const TGroup g0{IN(7), WIN, 1024, INW, 2, 0, 1, INP_FP8, 0}, g1{IN(13), WBR, 512, 1024, 6, 0, 3, 0, 0}, g2{IN(14), WO, 1024, 1024, 2, 0, 1, 0, 0}, g3{IN(17), WGU, 1024, 2048, 64, 1, 1, 1, 0}, g4{IN(19), WDN, 1024, 1024, 64, 0, 1, 1, 0}, g5{IN(7), WIN8, 1024, INW, 2, 0, 1, 1, 0};
        const int total = 2 * 16 * 248 + 6 * 8 * 32 + 2 * 16 * 32 + 64 * 16 * 64 + 64 * 16 * 32 + (INP_L1_FP8 ? 2 * 16 * 248 : 0);
        for (int it = gw; it < total; it += NGW) { int r = it;
            if (p0_group(g0, r, scr, lane)) continue; if (p0_group(g1, r, scr, lane)) continue; if (p0_group(g2, r, scr, lane)) continue; if (p0_group(g3, r, scr, lane)) continue; if (p0_group(g4, r, scr, lane)) continue; p0_group(g5, r, scr, lane); }
        const float* ng = IN(6);
        for (int row = gw; row < NTOK; row += NGW) { const int mj = row < NLAT ? row / SEQ : 2; const float* md = SM + SM_MOD + mj * 6144;
            const float* xp = row < NLAT ? x_in + (size_t)row * 1024 : ctx_in + (size_t)(row - NLAT) * 1024;
            f32x4 x[4], h[4]; row_ld(xp, lane, x); row_modulate(x, ng, md, md + 1024, lane, h); if (INP_FP8) row_st_f8(H + (size_t)row * 1024, lane, h, F8_ACT); else row_st_bf(HB + (size_t)row * 1024, lane, h); }
    }
    GRID_BAR();

    for (int l = 0; l < DEPTH; ++l) {
        const bool last = (l == DEPTH - 1);
        const float* MODl = SM + SM_MOD + l * 3 * 6144;
        const float* ng = IN(6) + l * 4096;
        const int nrows = last ? NLAT : NTOK;
#if INP_L1_FP8
        if (l == 1) { pg8::Gemm g{(const bf16*)H, (const bf16*)((const unsigned char*)WIN8 + (size_t)l * INW * 1024), NTOK, INW, 1024}; pg8::StaticOrder S; S.init(NTOK, INW, G, bx);
          EpiIn E{P, LF, SM + SM_TAB, SM + SM_LB + l * 1024, 0, 1.f / (F8_ACT * F8_W)}; pg8::gemm_phase<EpiIn, pg8::StaticOrder, true, true, 1>(lds, g, S, E); } else
#endif
        REP(2) if (PHM & 4) {
          pg8::Gemm g{INP_FP8 ? (const bf16*)H : (const bf16*)HB, INP_FP8 ? (const bf16*)((const unsigned char*)WIN + (size_t)l * INW * 1024) : (const bf16*)(WIN + (size_t)l * INW * 1024), NTOK, INW, 1024};
          pg8::StaticOrder S; S.init(NTOK, INW, G, bx);
          EpiIn E{P, LF, SM + SM_TAB, SM + SM_LB + l * 1024, 0, INP_FP8 ? 1.f / (F8_ACT * F8_W) : 1.f};
          pg8::gemm_phase<EpiIn, pg8::StaticOrder, true, true, INP_FP8 ? 1 : 2>(lds, g, S, E); }
#if GEMM_PROBE == 7 || GEMM_PROBE == 8 || GEMM_PROBE == 9
        { pg8::Gemm g{(const bf16*)HB, (const bf16*)(WIN + (size_t)l * INW * 1024), NTOK, INW, 1024}; pg8::StaticOrder S; S.init(NTOK, INW, G, bx);
          EpiInT<GEMM_PROBE - 7> E{(bf16*)(WSB() + WS_HU), (float*)(WSB() + WS_HU + 256 * MiB), SM + SM_TAB, SM + SM_LB + l * 1024, 0, 1.f};
          pg8::gemm_phase<EpiInT<GEMM_PROBE - 7>, pg8::StaticOrder, true, true, 2>(lds, g, S, E); }
#endif
#if GEMM_PROBE == 1
        { pg8::Gemm g{(const bf16*)HB, (const bf16*)(WIN + (size_t)l * INW * 1024), NTOK, INW, 1024}; pg8::StaticOrder S; S.init(NTOK, INW, G, bx); EpiNull E{(float*)(WSB() + WS_YF)};
          pg8::gemm_phase<EpiNull, pg8::StaticOrder, true, true, 2>(lds, g, S, E); }
#endif
        GRID_BAR();
        REP(3) if (PHM & 8) ph_hg1(lds, P, LF, HU, HD, vcu, G);
        REP(4) if (PHM & 16) ph_attn_a(lds, P, O3, IN(8) + l * 8, !last, vcu, G);
        REP(5) if (PHM & 32) ph_attn_b<0>(lds, P, O3 + 512, IN(10) + l * 128, SM[SM_LAM + l], SM[SM_LAM + 2 + l], !last, vcu, G);
#if AB_PROBE >= 0
        ph_attn_b<AB_PROBE>(lds, P, (bf16*)(WSB() + WS_YF), IN(10) + l * 128, SM[SM_LAM + l], SM[SM_LAM + 2 + l], !last, vcu, G);
#endif
        GRID_BAR();
        REP(6) if (PHM & 64) ph_hg2(HU, HD, HS, vcu, G);
        GRID_BAR();
        REP(7) if (PHM & 128) ph_hg3(lds, P, LF, HS, O3 + 1024, IN(12) + l * 128, !last, vcu, G, (HG3_PROBE && rep_ == 0) ? HG3_PROBE : 0);
        GRID_BAR();
        REP(8) if (PHM & 256) { pg8::Gemm g{O3, WBR + (size_t)l * 3 * 1024 * 512, nrows, 1024, 1536}; pg8::StaticOrder S; S.init(nrows, 1024, G, bx);
          EpiMerge E{P, Y};
          pg8::gemm_phase<EpiMerge, pg8::StaticOrder, true, true>(lds, g, S, E); }
        GRID_BAR();
#if GEMM_PROBE == 10
        { pg8::Gemm g{O3, WBR + (size_t)l * 3 * 1024 * 512, nrows, 1024, 1536}; pg8::StaticOrder S; S.init(nrows, 1024, G, bx); EpiNull E{(float*)(WSB() + WS_YF)};
          pg8::gemm_phase<EpiNull, pg8::StaticOrder, true, true, 2>(lds, g, S, E); }
#endif
        REP(9) if (PHM & 512) { pg8::Gemm g{Y, WO + (size_t)l * 1024 * 1024, nrows, 1024, 1024}; pg8::StaticOrder S; S.init(nrows, 1024, G, bx);
          EpiPlain E{YO, 1024, nullptr, 4, 1.f};
          pg8::gemm_phase<EpiPlain, pg8::StaticOrder, true, true>(lds, g, S, E); }
        GRID_BAR();
        unsigned* cnt = (unsigned*)(ctl + CW_CNT) + l * 32;
        TSB(20); REP(10) if (PHM & 1024) ph_r2(lds, x_in, ctx_in, XA, XA2, rep_ == ((PROF_MASK >> 10) & 1), YO, H, MODl, ng, IN(15) + l * 32768, IN(16) + l * 32, cnt, TOPE, GATE, RANK, l, nrows, vcu, G);
        GRID_BAR(); TSE(20);
        moe_tables(MTB, cnt);
        REP(11) if (PHM & 2048) ph_r3(MTB, H, XG, TOPE, RANK, DEST, nrows, vcu, G);
        GRID_BAR();
        REP(12) if (PHM & 4096) { pg8::Gemm g{(const bf16*)XG, (const bf16*)((const unsigned char*)WGU + (size_t)l * 32 * 2048 * 1024), XG_ROWS, 32 * 2048, 1024}; MoeOrder S{MTB, 8, G, vcu};
          EpiSwiglu E{ACT, IN(18) + (size_t)l * 32 * 2048};
          pg8::gemm_phase<EpiSwiglu, MoeOrder, true, true, 1>(lds, g, S, E); }
#if GEMM_PROBE == 3
        { pg8::Gemm g{(const bf16*)XG, (const bf16*)((const unsigned char*)WGU + (size_t)l * 32 * 2048 * 1024), XG_ROWS, 32 * 2048, 1024}; MoeOrder S{MTB, 8, G, vcu}; EpiNull E{(float*)(WSB() + WS_YO)};
          pg8::gemm_phase<EpiNull, MoeOrder, true, true, 1>(lds, g, S, E); }
#endif
#if GEMM_PROBE == 4 || GEMM_PROBE == 5 || GEMM_PROBE == 6
        { pg8::Gemm g{(const bf16*)XG, (const bf16*)((const unsigned char*)WGU + (size_t)l * 32 * 2048 * 1024), XG_ROWS, 32 * 2048, 1024}; MoeOrder S{MTB, 8, G, vcu};
          EpiSwigluT<GEMM_PROBE - 4> E{(unsigned char*)(WSB() + WS_YS), IN(18) + (size_t)l * 32 * 2048};
          pg8::gemm_phase<EpiSwigluT<GEMM_PROBE - 4>, MoeOrder, true, true, 1>(lds, g, S, E); }
#endif
        GRID_BAR();
        REP(13) if (PHM & 8192) { pg8::Gemm g{(const bf16*)ACT, (const bf16*)((const unsigned char*)WDN + (size_t)l * 32 * 1024 * 1024), XG_ROWS, 32 * 1024, 1024}; MoeOrder S{MTB, 4, G, vcu};
          EpiPlain E{YS, 1024, IN(20) + (size_t)l * 32 * 1024, 4, 1.f / (F8_MID * F8_W)};
          pg8::gemm_phase<EpiPlain, MoeOrder, true, true, 1>(lds, g, S, E); }
        GRID_BAR();
#if GEMM_PROBE == 11
        { pg8::Gemm g{(const bf16*)ACT, (const bf16*)((const unsigned char*)WDN + (size_t)l * 32 * 1024 * 1024), XG_ROWS, 32 * 1024, 1024}; MoeOrder S{MTB, 4, G, vcu}; EpiNull E{(float*)(WSB() + WS_YO)};
          pg8::gemm_phase<EpiNull, MoeOrder, true, true, 1>(lds, g, S, E); }
#endif
        TSB(21); REP(14) if (PHM & 16384) ph_r4(XA, XA2, YS, DEST, GATE, MODl, ng, OUTP(), H, HB, SM + SM_MOD + (l + 1 < DEPTH ? (l + 1) * 3 * 6144 : 0), IN(6) + (l + 1 < DEPTH ? (l + 1) * 4096 : 0), last, nrows, vcu, G);
        if (!last) GRID_BAR();
        TSE(21);
        REP(15) for (int k_ = 0; k_ < (rep_ ? 10 : 0); ++k_) xcd_barrier(bar);
    }
    if (TS_SEL >= 0) {
        if (bx == 0 && tid_opaque() == 0) SM[SM_LAM + 8] = (float)tsum * 0.01f;
        xcd_barrier(bar);
        const float sc = 1.f + sqrtf(SM[SM_LAM + 8] * 1e-4f);
        for (int i = bx * NTHR + tid_opaque(); i < NLAT * DM; i += G * NTHR) OUTP()[i] *= sc;
    }
    if (__hip_atomic_load((gu32*)((unsigned*)(ctl + CW_BAR) + XB_TMO), RLX_AGENT) != 0u) { if (bx == 0) for (int i = tid_opaque(); i < 4096; i += NTHR) OUTP()[i] = __builtin_nanf(""); }
}

#undef ctl
#undef SM
#undef WIN
#undef WIN8
#undef WINB
#undef WBR
#undef WO
#undef WGU
#undef WDN
#undef XA
#undef XA2
#undef H
#undef HB
#undef P
#undef LF
#undef O3
#undef HU
#undef HD
#undef HS
#undef Y
#undef YO
#undef TOPE
#undef GATE
#undef RANK
#undef DEST
#undef XG
#undef ACT
#undef YS
#undef x_in
#undef c_in
#undef ctx_in
#undef cctx_in
extern "C" void kernel_launch(void* const* d_in, const int* in_sizes, int n_in, void* d_out, int out_size, void* d_ws, size_t ws_size, hipStream_t stream) {
    static int grid = 0;
    if (grid == 0) {
        if (n_in != 21 || out_size != NLAT * DM || ws_size < WS_END) { fprintf(stderr, "kernel_launch: unexpected shapes (n_in %d, out %d, ws %zu)\n", n_in, out_size, ws_size); grid = -1; return; }
        int dev = 0, cus = 0, per_cu = 0;
        if (hipGetDevice(&dev) != hipSuccess || hipDeviceGetAttribute(&cus, hipDeviceAttributeMultiprocessorCount, dev) != hipSuccess) { grid = -1; return; }
        if (hipFuncSetAttribute((const void*)fwd_mega, hipFuncAttributeMaxDynamicSharedMemorySize, LDS_BYTES) != hipSuccess) { fprintf(stderr, "kernel_launch: hipFuncSetAttribute failed\n"); grid = -1; return; }
        if (hipOccupancyMaxActiveBlocksPerMultiprocessor(&per_cu, (const void*)fwd_mega, NTHR, LDS_BYTES) != hipSuccess || per_cu < 1) { fprintf(stderr, "kernel_launch: occupancy query reports %d\n", per_cu); per_cu = 1; }
        (void)hipGetLastError();
        grid = cus;
    }
    if (grid < 0) return;
    (void)hipMemsetAsync((char*)d_ws + WS_CTL, 0, CTL_ZERO_BYTES, stream);
    Args a{};
    for (int i = 0; i < 21; ++i) a.in[i] = (const float*)d_in[i];
    a.out = (float*)d_out; a.ws = (unsigned char*)d_ws;
    hipLaunchKernelGGL(fwd_mega, dim3(grid), dim3(NTHR), LDS_BYTES, stream, a);
}
```

```cpp
#include <hip/hip_runtime.h>
#include <cstdio>
#include <cstdint>
namespace pg8 {
#define PG8_LAS __attribute__((address_space(3)))
typedef unsigned short bf16_t;
typedef short bf16x8 __attribute__((ext_vector_type(8)));
typedef float f32x4 __attribute__((ext_vector_type(4)));
typedef unsigned u32x4 __attribute__((ext_vector_type(4)));
constexpr int BM = 256, BK = 64, HALF = 128, HTB = HALF * BK * 2  , STAGE_BYTES = 8 * HTB, NXCD = 8, WGM = 8;

__host__ __device__ __forceinline__ int lds_byte(int r, int c) { const int st = (r >> 4) * 2 + (c >> 5), rr = r & 15, cc = c & 31, ob = rr * 64 + cc * 2; return st * 1024 + (ob ^ (((ob >> 9) & 1) << 5)); }
__host__ __device__ __forceinline__ void stage_rc(int b, int& R, int& C) { const int st = b / 1024, sb = b % 1024, swz = sb ^ (((sb >> 9) & 1) << 5); R = (st >> 1) * 16 + swz / 64; C = (st & 1) * 32 + (swz % 64) / 2; }
__host__ __device__ __forceinline__ int perm32(int rho) { const int n = rho >> 4, i = rho & 15; return 8 * (i >> 2) + 4 * n + (i & 3); }

struct Unit { int pm, pn; };
struct Gemm { const bf16_t* A; const bf16_t* Bt; int M, N, K; };

struct StaticOrder {
    int nM, nN, nwg, G, c;
    __host__ __device__ void init(int M, int N, int G_, int c_) { nM = M / BM; nN = N / BM; nwg = nM * nN; G = G_; c = c_; }
    __host__ __device__ bool next(int i, Unit& u) const {
        const long L = (long)i * G + c; if (L >= nwg) return false;
        int wgid = (int)L; { const int q = nwg / NXCD, r = nwg % NXCD, xcd = wgid % NXCD, off = wgid / NXCD; wgid = (xcd < r ? xcd * (q + 1) : r * (q + 1) + (xcd - r) * q) + off; }
        const int nig = WGM * nN, gid = wgid / nig, fm = gid * WGM, gsz = (nM - fm) < WGM ? (nM - fm) : WGM;
        u.pm = fm + ((wgid % nig) % gsz); u.pn = (wgid % nig) / gsz; return true;
    }
    __device__ __forceinline__ void a_ready(const Unit&) const {}
    __device__ __forceinline__ void done(const Unit&) const {}
};

template <class Epi, class Sched, bool ALIGN_EPI = false, bool SP2 = false, int ES = 2>
__device__ __forceinline__ void gemm_phase(PG8_LAS unsigned char* lds, const Gemm g, const Sched& S, const Epi& E) {
    int tid_ = threadIdx.x; asm volatile("" : "+v"(tid_));
    const int tid = tid_, wid = __builtin_amdgcn_readfirstlane(tid >> 6), lane = tid & 63, wr = wid >> 2, wc = wid & 3, fr = lane & 15, fq = lane >> 4;
    const int K = g.K, nt = K * ES / 128;
    unsigned voffA[2], voffB[2];
#pragma unroll
    for (int i = 0; i < 2; ++i) { int R, C; stage_rc(tid * 16 + i * 8192, R, C); const int Rb = Epi::PERM ? ((R & ~31) + perm32(R & 31)) : R;
        voffA[i] = (unsigned)(R * K * ES + C * 2); voffB[i] = (unsigned)(Rb * K * ES + C * 2); }
    const size_t kstep = (size_t)(BK * 2);
    const size_t hstep = (size_t)HALF * K * ES;
    const size_t tstep = 2 * hstep;
    const unsigned ldsw = (unsigned)wid * 1024u;
    const int aoff = lds_byte(wr * 64 + fr, fq * 8), boff = lds_byte(wc * 32 + fr, fq * 8);
#define PG8_SA(b, h) (((b) * 2 + (h)) * HTB)
#define PG8_SB(b, h) ((4 + (b) * 2 + (h)) * HTB)
#define PG8_STAGE(bufoff, gbase, voff) do { _Pragma("unroll") for (int _i = 0; _i < 2; ++_i) \
        __builtin_amdgcn_global_load_lds((const unsigned*)((const char*)(gbase) + (voff)[_i]), (PG8_LAS unsigned*)(lds + (bufoff) + ldsw + _i * 8192), 16, 0, 0); } while (0)
#define PG8_LDA(dst, b, h) do { _Pragma("unroll") for (int m = 0; m < 4; ++m) _Pragma("unroll") for (int k = 0; k < 2; ++k) dst[m][k] = *(const PG8_LAS bf16x8*)(lds + PG8_SA(b, h) + aoff + m * 2048 + k * 1024); } while (0)
#define PG8_LDB(dst, b, h) do { _Pragma("unroll") for (int n = 0; n < 2; ++n) _Pragma("unroll") for (int k = 0; k < 2; ++k) dst[n][k] = *(const PG8_LAS bf16x8*)(lds + PG8_SB(b, h) + boff + n * 2048 + k * 1024); } while (0)
#define PG8_MMA(ai, bj, At, Bt) do { __builtin_amdgcn_s_setprio(1); _Pragma("unroll") for (int m = 0; m < 4; ++m) _Pragma("unroll") for (int n = 0; n < 2; ++n) _Pragma("unroll") for (int k = 0; k < 2; ++k) \
        acc[ai][bj][m][n] = __builtin_amdgcn_mfma_f32_16x16x32_bf16(Bt[n][k], At[m][k], acc[ai][bj][m][n], 0, 0, 0); __builtin_amdgcn_s_setprio(0); } while (0)
    typedef int v8i_t __attribute__((ext_vector_type(8)));
#define PG8_CAT8(x0, x1) __builtin_shufflevector(__builtin_bit_cast(u32x4, (x0)), __builtin_bit_cast(u32x4, (x1)), 0, 1, 2, 3, 4, 5, 6, 7)
#define PG8_MMA8(ai, bj, At, Bt) do { __builtin_amdgcn_s_setprio(1); _Pragma("unroll") for (int m = 0; m < 4; ++m) _Pragma("unroll") for (int n = 0; n < 2; ++n) { \
        const v8i_t a8_ = __builtin_bit_cast(v8i_t, PG8_CAT8(Bt[n][0], Bt[n][1])), b8_ = __builtin_bit_cast(v8i_t, PG8_CAT8(At[m][0], At[m][1])); \
        asm volatile("v_mfma_scale_f32_16x16x128_f8f6f4 %0, %1, %2, %0, %3, %3 op_sel_hi:[0,0,0]" : "+v"(acc[ai][bj][m][n]) : "v"(a8_), "v"(b8_), "v"(0x7f7f7f7f)); } \
        __builtin_amdgcn_s_setprio(0); } while (0)
#define PG8_MMAX(ai, bj, At, Bt) do { if constexpr (ES == 1) PG8_MMA8(ai, bj, At, Bt); else PG8_MMA(ai, bj, At, Bt); } while (0)
#define PG8_WAIT_V(n) asm volatile("s_waitcnt vmcnt(" #n ")" ::: "memory")
#define PG8_WAIT_L(n) asm volatile("s_waitcnt lgkmcnt(" #n ")" ::: "memory")
#define PG8_BAR __builtin_amdgcn_s_barrier()
#define PG8_SCHED __builtin_amdgcn_sched_barrier(0)
    Unit cur, nxt; int ui = 0;
    if (!S.next(0, cur)) return;
    f32x4 acc[2][2][4][2];
#pragma unroll
    for (int a = 0; a < 2; ++a)
#pragma unroll
        for (int b = 0; b < 2; ++b)
#pragma unroll
            for (int m = 0; m < 4; ++m)
#pragma unroll
                for (int n = 0; n < 2; ++n) acc[a][b][m][n] = (f32x4){0.f, 0.f, 0.f, 0.f};
    bf16x8 At[4][2], B0[2][2], B1[2][2];
    const char* cA = (const char*)g.A + (size_t)cur.pm * tstep; const char* cB = (const char*)g.Bt + (size_t)cur.pn * tstep;
    S.a_ready(cur);
    if constexpr (SP2) {
        PG8_STAGE(PG8_SB(0, 0), cB, voffB); PG8_STAGE(PG8_SB(0, 1), cB + hstep, voffB); PG8_STAGE(PG8_SA(0, 0), cA, voffA); PG8_STAGE(PG8_SA(0, 1), cA + hstep, voffA);
        if (wr == 1) PG8_BAR;
        PG8_WAIT_V(2); PG8_BAR;
        PG8_STAGE(PG8_SB(1, 0), cB + kstep, voffB); PG8_STAGE(PG8_SA(1, 0), cA + kstep, voffA); PG8_STAGE(PG8_SB(1, 1), cB + hstep + kstep, voffB);
        PG8_WAIT_V(6); PG8_BAR;
    } else {
        PG8_STAGE(PG8_SB(0, 0), cB, voffB); PG8_STAGE(PG8_SA(0, 0), cA, voffA); PG8_STAGE(PG8_SB(0, 1), cB + hstep, voffB); PG8_STAGE(PG8_SA(0, 1), cA + hstep, voffA);
        if (wr == 1) PG8_BAR;
        PG8_WAIT_V(4); PG8_BAR;
        PG8_STAGE(PG8_SB(1, 0), cB + kstep, voffB); PG8_STAGE(PG8_SA(1, 0), cA + kstep, voffA); PG8_STAGE(PG8_SB(1, 1), cB + hstep + kstep, voffB);
        PG8_WAIT_V(6); PG8_BAR;
    }
    for (;;) {
        const bool has_next = S.next(ui + 1, nxt);
        const char* nA = has_next ? (const char*)g.A + (size_t)nxt.pm * tstep : cA; const char* nB = has_next ? (const char*)g.Bt + (size_t)nxt.pn * tstep : cB;
        for (int t = 0; t < nt; t += 2) {
            if constexpr (Epi::KHOOK) { if (t == 8 || t == 16) E.khook(acc, cur, t >> 3, wr, wc, fr, fq); }
            const bool last = (t == nt - 2);
            const char* a1 = cA + (size_t)(t + 1) * kstep;
            const char* a2 = last ? nA : cA + (size_t)(t + 2) * kstep; const char* b2 = last ? nB : cB + (size_t)(t + 2) * kstep;
            const char* a3 = a2 + kstep; const char* b3 = b2 + kstep;
            if (last && has_next) S.a_ready(nxt);
            if constexpr (SP2) {
            PG8_LDB(B0, 0, 0); PG8_LDB(B1, 0, 1); PG8_SCHED; PG8_LDA(At, 0, 0); PG8_STAGE(PG8_SA(1, 1), a1 + hstep, voffA);
            PG8_WAIT_V(8); PG8_WAIT_L(0); PG8_BAR; PG8_MMAX(0, 0, At, B0); PG8_MMAX(0, 1, At, B1); PG8_BAR; PG8_SCHED;
            PG8_LDA(At, 0, 1); PG8_STAGE(PG8_SB(0, 0), b2, voffB); PG8_STAGE(PG8_SB(0, 1), b2 + hstep, voffB); PG8_STAGE(PG8_SA(0, 0), a2, voffA);
            PG8_WAIT_V(8); PG8_WAIT_L(0); PG8_BAR; PG8_MMAX(1, 0, At, B0); PG8_MMAX(1, 1, At, B1); PG8_BAR; PG8_SCHED;
            PG8_LDB(B0, 1, 0); PG8_LDB(B1, 1, 1); PG8_SCHED; PG8_LDA(At, 1, 0); PG8_STAGE(PG8_SA(0, 1), a2 + hstep, voffA);
            PG8_WAIT_V(8); PG8_WAIT_L(0); PG8_BAR; PG8_MMAX(0, 0, At, B0); PG8_MMAX(0, 1, At, B1); PG8_BAR; PG8_SCHED;
            PG8_LDA(At, 1, 1); PG8_STAGE(PG8_SB(1, 0), b3, voffB); PG8_STAGE(PG8_SB(1, 1), b3 + hstep, voffB); PG8_STAGE(PG8_SA(1, 0), a3, voffA);
            PG8_WAIT_V(8); PG8_WAIT_L(0); PG8_BAR; PG8_MMAX(1, 0, At, B0); PG8_MMAX(1, 1, At, B1); PG8_BAR; PG8_SCHED;
            } else {
            PG8_LDB(B0, 0, 0); PG8_SCHED; PG8_LDA(At, 0, 0); PG8_STAGE(PG8_SA(1, 1), a1 + hstep, voffA);
            PG8_WAIT_L(8); PG8_BAR; PG8_WAIT_L(0); PG8_MMAX(0, 0, At, B0); PG8_BAR; PG8_SCHED;
            PG8_LDB(B1, 0, 1); PG8_STAGE(PG8_SB(0, 0), b2, voffB);
            PG8_BAR; PG8_WAIT_L(0); PG8_MMAX(0, 1, At, B1); PG8_BAR;
            PG8_LDA(At, 0, 1); PG8_STAGE(PG8_SA(0, 0), a2, voffA);
            PG8_BAR; PG8_WAIT_L(0); PG8_MMAX(1, 0, At, B0); PG8_BAR; PG8_SCHED;
            PG8_STAGE(PG8_SB(0, 1), b2 + hstep, voffB);
            PG8_WAIT_V(6); PG8_BAR; PG8_MMAX(1, 1, At, B1); PG8_BAR;
            PG8_LDB(B0, 1, 0); PG8_SCHED; PG8_LDA(At, 1, 0); PG8_STAGE(PG8_SA(0, 1), a2 + hstep, voffA);
            PG8_WAIT_L(8); PG8_BAR; PG8_WAIT_L(0); PG8_MMAX(0, 0, At, B0); PG8_BAR; PG8_SCHED;
            PG8_LDB(B1, 1, 1); PG8_STAGE(PG8_SB(1, 0), b3, voffB);
            PG8_BAR; PG8_WAIT_L(0); PG8_MMAX(0, 1, At, B1); PG8_BAR;
            PG8_LDA(At, 1, 1); PG8_STAGE(PG8_SA(1, 0), a3, voffA);
            PG8_BAR; PG8_WAIT_L(0); PG8_MMAX(1, 0, At, B0); PG8_BAR; PG8_SCHED;
            PG8_STAGE(PG8_SB(1, 1), b3 + hstep, voffB);
            PG8_WAIT_V(6); PG8_BAR; PG8_MMAX(1, 1, At, B1); PG8_BAR;
            }
        }
        if constexpr (ES == 1) asm volatile("s_nop 15\n\ts_nop 7" ::: "memory");
        if constexpr (ALIGN_EPI) { if (wr == 0) PG8_BAR; }
        if constexpr (!Epi::AFTER_DRAIN) { E(acc, cur, wr, wc, fr, fq); S.done(cur); }
        if (!has_next) break;
#pragma unroll
        for (int a = 0; a < 2; ++a)
#pragma unroll
            for (int b = 0; b < 2; ++b)
#pragma unroll
                for (int m = 0; m < 4; ++m)
#pragma unroll
                    for (int n = 0; n < 2; ++n) acc[a][b][m][n] = (f32x4){0.f, 0.f, 0.f, 0.f};
        cur = nxt; cA = nA; cB = nB; ++ui;
        if constexpr (ALIGN_EPI) { if (wr == 1) PG8_BAR; }
    }
    PG8_WAIT_V(0);
    if constexpr (!ALIGN_EPI) { if (wr == 0) PG8_BAR; }
    PG8_BAR;
    if constexpr (Epi::AFTER_DRAIN) { E.fused(acc, cur, wr, wc, fr, fq, lds, wid, lane); S.done(cur); }
#undef PG8_SA
#undef PG8_SB
#undef PG8_STAGE
#undef PG8_LDA
#undef PG8_LDB
#undef PG8_MMA
#undef PG8_MMA8
#undef PG8_MMAX
#undef PG8_CAT8
#undef PG8_WAIT_V
#undef PG8_WAIT_L
#undef PG8_BAR
#undef PG8_SCHED
}
}
#define GAS __attribute__((address_space(1)))
#define LAS __attribute__((address_space(3)))
typedef unsigned short bf16;
typedef unsigned v4u __attribute__((ext_vector_type(4)));
typedef float f32x4 __attribute__((ext_vector_type(4)));
typedef short bf16x8 __attribute__((ext_vector_type(8)));
typedef GAS unsigned gu32;
typedef GAS unsigned long long gu64;
#define RLX_AGENT __ATOMIC_RELAXED, __HIP_MEMORY_SCOPE_AGENT
#define LDS_WAIT() asm volatile("s_waitcnt lgkmcnt(0)" ::: "memory")
#define VM_WAIT() asm volatile("s_waitcnt vmcnt(0)" ::: "memory")
__device__ __forceinline__ unsigned long long rt() { return __builtin_amdgcn_s_memrealtime(); }
__device__ __forceinline__ unsigned f2bf(float f) { unsigned u = __builtin_bit_cast(unsigned, f); return (u + 0x7fffu + ((u >> 16) & 1u)) >> 16; }
__device__ __forceinline__ unsigned pk2(float lo, float hi) { return f2bf(lo) | (f2bf(hi) << 16); }

#define XB_TMO      128
#define XB_XCNT(j)  (256  + 64 * (j))
#define XB_XSUB(j)  (1280 + 64 * (j))
#define XB_XGEN(j)  (2304 + 64 * (j))
#define XB_TOP      3328
#define XB_TOPGEN   3392
#define XCD_BAR_WORDS 3456
#define XB_SPIN_CAP (1u << 18)

__device__ __forceinline__ unsigned xb_ld(unsigned* p)              { return __hip_atomic_load(p, __ATOMIC_RELAXED, __HIP_MEMORY_SCOPE_AGENT); }
__device__ __forceinline__ unsigned xb_add(unsigned* p, unsigned v) { return __hip_atomic_fetch_add(p, v, __ATOMIC_RELAXED, __HIP_MEMORY_SCOPE_AGENT); }
__device__ __forceinline__ unsigned xb_xcc_id() { return (unsigned)__builtin_amdgcn_s_getreg((3 << 11) | 20) & 0xFu; }
#define XB_SPIN(cond, bar) do { unsigned _sp = 0; while (cond) { __builtin_amdgcn_s_sleep(1); \
    if ((++_sp & 255u) == 0u) { if (xb_ld(&(bar)[XB_TMO])) break; if (_sp > XB_SPIN_CAP) { atomicAdd(&(bar)[XB_TMO], 1u); break; } } } } while (0)

struct XcdBarrier {
    unsigned* bar; unsigned x;
    volatile LAS unsigned* st;
};

__device__ __forceinline__ XcdBarrier xcd_barrier_post(unsigned* bar, volatile LAS unsigned* st) {
    XcdBarrier b; b.bar = bar; b.x = xb_xcc_id(); b.st = st;
    if (threadIdx.x == 0) (void)xb_add(&bar[XB_XCNT(b.x)], 1u);
    return b;
}
__device__ __forceinline__ void xcd_barrier_complete(unsigned* bar, unsigned x, unsigned& nloc, unsigned& nx) {
    const unsigned G = gridDim.x * gridDim.y * gridDim.z;
    unsigned sum, cnt, mine, sp = 0u;
    for (;;) {
        sum = 0u; cnt = 0u; mine = 0u;
#pragma unroll
        for (unsigned j = 0; j < 16; ++j) { const unsigned c = xb_ld(&bar[XB_XCNT(j)]); sum += c; cnt += (c > 0u) ? 1u : 0u; mine = (j == x) ? c : mine; }
        if (sum == G) break;
        __builtin_amdgcn_s_sleep(1);
        if ((++sp & 255u) == 0u) { if (xb_ld(&bar[XB_TMO])) break; if (sp > XB_SPIN_CAP) { atomicAdd(&bar[XB_TMO], 1u); break; } }
    }
    nloc = mine > 0u ? mine : 1u; nx = cnt > 0u ? cnt : 1u;
}

__device__ __forceinline__ void xcd_barrier(const XcdBarrier& b) {
    asm volatile("s_waitcnt vmcnt(0)" ::: "memory");
    __syncthreads();
    if (threadIdx.x == 0) {
        unsigned* bar = b.bar;
        __builtin_amdgcn_s_waitcnt(0);
        unsigned nloc = b.st[0], nx = b.st[1];
        if (nloc == 0u) { xcd_barrier_complete(bar, b.x, nloc, nx); b.st[0] = nloc; b.st[1] = nx; }
        const unsigned old = xb_add(&bar[XB_XSUB(b.x)], 1u);
        const unsigned gen = old / nloc;
        if (old + 1u == (gen + 1u) * nloc) {
            __builtin_amdgcn_fence(__ATOMIC_RELEASE, "agent");
            asm volatile("s_waitcnt vmcnt(0)" ::: "memory");
            const unsigned og = xb_add(&bar[XB_TOP], 1u);
            const unsigned tg = og / nx;
            if (og + 1u == (tg + 1u) * nx) xb_add(&bar[XB_TOPGEN], 1u);
            else XB_SPIN(xb_ld(&bar[XB_TOPGEN]) == tg, bar);
            __builtin_amdgcn_fence(__ATOMIC_ACQUIRE, "agent");
            xb_add(&bar[XB_XGEN(b.x)], 1u);
            asm volatile("s_waitcnt vmcnt(0)" ::: "memory");
        } else {
            XB_SPIN(xb_ld(&bar[XB_XGEN(b.x)]) == gen, bar);
            __builtin_amdgcn_fence(__ATOMIC_ACQUIRE, "agent");
            asm volatile("s_waitcnt vmcnt(0)" ::: "memory");
        }
    }
    __syncthreads();
}

#define DI __device__ __forceinline__
constexpr int DM = 1024, NB = 2, SEQ = 8192, CTXL = 256, DEPTH = 2;
constexpr int NLAT = NB * SEQ, NCTX = NB * CTXL, NTOK = NLAT + NCTX;
constexpr int INW = 7936;
constexpr int C_AQ = 0, C_AK = 512, C_AV = 640, C_BQ = 768, C_BK = 1280, C_BV = 1792, C_CQ = 2304, C_CI = 2816, C_CFF = 3328, C_CFB = 3840, C_CG = 4352, C_GT = 4864;
constexpr int NEXP = 32, EFF = 1024, NCH = 132;
constexpr float RMS_EPS = 1e-6f, LOG2E = 1.4426950408889634f, QSCALE = 0.125f * 1.4426950408889634f;
constexpr int XG_ROWS = 75776;
constexpr int NWAVES = 8, NTHR = 512;

constexpr size_t MiB = 1u << 20;
constexpr size_t WS_CTL = 0, CTL_ZERO_BYTES = 1 * MiB;
constexpr size_t WS_SMALL = 1 * MiB;
constexpr size_t WS_WIN = 2 * MiB, WS_WBR = 33 * MiB, WS_WO = 39 * MiB, WS_WGU = 43 * MiB, WS_WDN = 299 * MiB;
constexpr size_t WS_XA = 427 * MiB, WS_H = 493 * MiB, WS_P = 526 * MiB, WS_LF = 782 * MiB, WS_O3 = 848 * MiB, WS_HU = 898 * MiB, WS_HD = 1030 * MiB, WS_HS = 1032 * MiB;
constexpr size_t WS_YF = 1098 * MiB, WS_Y = 1164 * MiB, WS_YO = 1197 * MiB, WS_ROUTE = 1230 * MiB, WS_XA2 = 1232 * MiB, WS_WIN8 = 1298 * MiB  , WS_END = 1314 * MiB;
constexpr size_t WS_XG = 526 * MiB, WS_ACT = 674 * MiB, WS_YS = 822 * MiB;
static_assert(WS_YS + (size_t)XG_ROWS * 1024 * 2 <= WS_HD, "moe overlay");
static_assert(WS_P + (size_t)NTOK * INW * 2 <= WS_LF && WS_HU + (size_t)2112 * 16384 * 4 <= WS_HD && WS_HS + (size_t)2112 * 16384 * 2 <= WS_YF, "ws map");
constexpr int SM_MOD = 0;
constexpr int SM_LB = 36864;
constexpr int SM_TAB = 38912;
constexpr int SM_LAM = 45056;
constexpr int CW_BAR = 4096;
constexpr int CW_CNT = 16384;

constexpr int RING_BYTES = 147456, LDSCTL_OFF = RING_BYTES, MISC_OFF = LDSCTL_OFF + 320, LDS_BYTES = 163840;

typedef float f32x16 __attribute__((ext_vector_type(16)));
typedef float f32x2 __attribute__((ext_vector_type(2)));
typedef short s16x4 __attribute__((ext_vector_type(4)));
typedef unsigned u32x2 __attribute__((ext_vector_type(2)));
typedef __bf16 bf16x2_t __attribute__((ext_vector_type(2)));
DI unsigned cvtpk(float lo, float hi) { f32x2 v = {lo, hi}; bf16x2_t b = __builtin_convertvector(v, bf16x2_t); return __builtin_bit_cast(unsigned, b); }
DI float bf2f(unsigned short u) { return __uint_as_float(((unsigned)u) << 16); }
DI float bflo(unsigned u) { return __uint_as_float(u << 16); }
DI float bfhi(unsigned u) { return __uint_as_float(u & 0xffff0000u); }
DI float wave_sum(float v) {
#pragma unroll
    for (int o = 1; o < 64; o <<= 1) v += __shfl_xor(v, o);
    return v;
}
constexpr float LOG2E_ = 1.4426950408889634f;
DI float silu_f(float v) { return v * __builtin_amdgcn_rcpf(1.f + __builtin_amdgcn_exp2f(-LOG2E_ * v)); }
DI float sigm_f(float v) { return __builtin_amdgcn_rcpf(1.f + __builtin_amdgcn_exp2f(-LOG2E_ * v)); }
DI bf16x8 pack8(float a0, float a1, float a2, float a3, float a4, float a5, float a6, float a7) {
    v4u p; p.x = cvtpk(a0, a1); p.y = cvtpk(a2, a3); p.z = cvtpk(a4, a5); p.w = cvtpk(a6, a7); return __builtin_bit_cast(bf16x8, p);
}
typedef short v4i16_t __attribute__((ext_vector_type(4)));
DI s16x4 tr_read(LAS const char* p) { return __builtin_bit_cast(s16x4, __builtin_amdgcn_ds_read_tr16_b64_v4i16((LAS v4i16_t*)p)); }
DI bf16x8 cat8(s16x4 lo, s16x4 hi) { return __builtin_shufflevector(lo, hi, 0, 1, 2, 3, 4, 5, 6, 7); }
#define MFMA32(a, b, c) __builtin_amdgcn_mfma_f32_32x32x16_bf16((a), (b), (c), 0, 0, 0)
#define MFMA16(a, b, c) __builtin_amdgcn_mfma_f32_16x16x32_bf16((a), (b), (c), 0, 0, 0)
#ifndef INP_FP8
#define INP_FP8 0
#endif
#define INP_L1_FP8 0
constexpr float F8_ACT = 8.f, F8_W = 256.f, F8_MID = 4.f;
constexpr float INP_OSC = INP_FP8 ? 1.f / (8.f * 256.f) : 1.f;
DI float clamp8(float x) { return fminf(fmaxf(x, -448.f), 448.f); }
DI unsigned f8x4(float a, float b, float c, float d) { int w = __builtin_amdgcn_cvt_pk_fp8_f32(clamp8(a), clamp8(b), 0, false); w = __builtin_amdgcn_cvt_pk_fp8_f32(clamp8(c), clamp8(d), w, true); return (unsigned)w; }
DI int tid_opaque() { int t = threadIdx.x; asm volatile("" : "+v"(t)); return t; }
DI int crow(int r, int hi) { return (r & 3) + 8 * (r >> 2) + 4 * hi; }

DI void ph_mod(LAS unsigned char* lds, const float* c, const float* cctx, const float* wmod, const float* bmod, float* MOD, int vcu, int G) {
    LAS float* red = (LAS float*)lds;
    const int tid = tid_opaque(), col = tid & 31, ks = tid >> 5;
    for (int tile = vcu; tile < 2 * 192; tile += G) {
        const int l = tile / 192, n0 = (tile % 192) * 32;
        const float* W = wmod + (size_t)l * 1024 * 6144 + n0 + col;
        float a0 = 0.f, a1 = 0.f, a2 = 0.f;
#pragma unroll 8
        for (int k = ks * 64; k < ks * 64 + 64; ++k) {
            const float w = W[(size_t)k * 6144];
            a0 += silu_f(c[k]) * w; a1 += silu_f(c[1024 + k]) * w; a2 += silu_f(cctx[k]) * w;
        }
        red[(ks * 3 + 0) * 32 + col] = a0; red[(ks * 3 + 1) * 32 + col] = a1; red[(ks * 3 + 2) * 32 + col] = a2;
        __syncthreads();
        if (tid < 96) { const int j = tid >> 5, cc = tid & 31; float s = 0.f;
#pragma unroll
            for (int k2 = 0; k2 < 16; ++k2) s += red[(k2 * 3 + j) * 32 + cc];
            MOD[(l * 3 + j) * 6144 + n0 + cc] = s + bmod[l * 6144 + n0 + cc]; }
        __syncthreads();
    }
}
DI void sincos_tab(double a, float& s, float& c) {
    const double TWO_PI = 6.283185307179586476925;
    const double k = rint(a / TWO_PI), r = a - k * TWO_PI, r2 = r * r;
    double ts = r, ss = r, tc = 1.0, cs = 1.0;
    for (int n = 1; n <= 15; ++n) { ts *= -r2 / (double)((2 * n) * (2 * n + 1)); ss += ts; tc *= -r2 / (double)((2 * n - 1) * (2 * n)); cs += tc; }
    s = (float)ss; c = (float)cs;
}
DI void ph_tables(float* SM, const float* lb_logits, const float* dlam, int vcu, int G) {
    const int gt = vcu * NTHR + tid_opaque(), NT = G * NTHR;
    for (int i = gt; i < 192 * 16; i += NT) {
        const int pos = i >> 4, f = i & 15;
        const float invf = f == 0 ? 1.0f : f == 1 ? 0.5623413324356079f : f == 2 ? 0.3162277638912201f : f == 3 ? 0.17782793939113617f : f == 4 ? 0.10000000149011612f : f == 5 ? 0.05623413249850273f
                         : f == 6 ? 0.03162277489900589f : f == 7 ? 0.017782794311642647f : f == 8 ? 0.009999999776482582f : f == 9 ? 0.005623413249850273f : f == 10 ? 0.003162277629598975f
                         : f == 11 ? 0.0017782794311642647f : f == 12 ? 0.0010000000474974513f : f == 13 ? 0.000562341301701963f : f == 14 ? 0.0003162277571391314f : 0.00017782794020604342f;
        const int p = pos < 128 ? pos : pos - 128;
        const float ang = (float)p * invf;
        float s, c; sincos_tab((double)ang, s, c);
        if (pos < 128) { SM[SM_TAB + p * 16 + f] = c; SM[SM_TAB + 2048 + p * 16 + f] = s; }
        else { SM[SM_TAB + 4096 + p * 16 + f] = c; SM[SM_TAB + 4096 + 1024 + p * 16 + f] = s; }
    }
    for (int i = gt; i < 1024; i += NT) {
        const float l0 = lb_logits[i], l1 = lb_logits[1024 + i];
        SM[SM_LB + i] = 0.f; SM[SM_LB + 1024 + i] = 1.f / (1.f + expf(l0 - l1));
    }
    if (gt < 2) { const float* lp = dlam + gt * 256; float s0 = 0.f, s1 = 0.f;
        for (int d = 0; d < 64; ++d) { s0 += lp[d] * lp[64 + d]; s1 += lp[128 + d] * lp[192 + d]; }
        const float li = 0.8f - 0.6f * expf(-0.3f * (float)gt);
        SM[SM_LAM + gt] = expf(s0) - expf(s1) + li; SM[SM_LAM + 2 + gt] = li; }
}
DI void p0_transpose_item(const float* W, int K, int N, int spitch, bf16* WT, int dpitch, int gu, int f8, LAS float* scr, int item, int lane) {
    const int nblk = N / 32, kb = item / nblk, nb = item % nblk, k0 = 64 * kb, n0 = 32 * nb;
    float wv[32];
#pragma unroll
    for (int i = 0; i < 32; ++i) wv[i] = __builtin_nontemporal_load(W + (size_t)(k0 + 2 * i + (lane >> 5)) * spitch + n0 + (lane & 31));
#pragma unroll
    for (int i = 0; i < 32; ++i) scr[(2 * i + (lane >> 5)) * 33 + (lane & 31)] = wv[i];
    LDS_WAIT(); asm volatile("" ::: "memory");
    const int c = lane & 7;
    const int r0 = gu ? (256 * ((n0 & 1023) >> 7) + 128 * (n0 >> 10) + (n0 & 127)) : n0;
#pragma unroll
    for (int j = 0; j < 4; ++j) { const int n = (lane >> 3) + 8 * j; const LAS float* s = scr + (8 * c) * 33 + n;
        if (f8) { u32x2 o8; o8.x = f8x4(s[0 * 33] * F8_W, s[1 * 33] * F8_W, s[2 * 33] * F8_W, s[3 * 33] * F8_W); o8.y = f8x4(s[4 * 33] * F8_W, s[5 * 33] * F8_W, s[6 * 33] * F8_W, s[7 * 33] * F8_W);
            *(GAS u32x2*)((unsigned char*)WT + (size_t)(r0 + n) * dpitch + k0 + 8 * c) = o8; }
        else { v4u o; o.x = pk2(s[0 * 33], s[1 * 33]); o.y = pk2(s[2 * 33], s[3 * 33]); o.z = pk2(s[4 * 33], s[5 * 33]); o.w = pk2(s[6 * 33], s[7 * 33]);
            *(GAS v4u*)(WT + (size_t)(r0 + n) * dpitch + k0 + 8 * c) = o; } }
    LDS_WAIT(); asm volatile("" ::: "memory");
}
struct TGroup { const float* src; bf16* dst; int K, N, nmat, gu, sub, f8, spitch; };
DI bool p0_group(const TGroup& g, int& r, LAS float* scr, int lane) {
    const int per = (g.K / 64) * (g.N / 32), cnt = per * g.nmat;
    if (r >= cnt) { r -= cnt; return false; }
    const int m = r / per, it = r % per;
    p0_transpose_item(g.src + (size_t)m * g.K * g.N, g.K, g.N, g.spitch ? g.spitch : g.N, g.f8 ? (bf16*)((unsigned char*)g.dst + (size_t)m * g.K * g.N) : g.dst + (size_t)(m / g.sub) * g.sub * g.K * g.N + (size_t)(m % g.sub) * g.K, g.sub * g.K, g.gu, g.f8, scr, it, lane);
    return true;
}
DI void row_ld(const float* p, int lane, f32x4 (&v)[4]) {
#pragma unroll
    for (int j = 0; j < 4; ++j) v[j] = ((const GAS f32x4*)p)[lane + 64 * j];
}
DI void row_ld_bf(const bf16* p, int lane, f32x4 (&v)[4]) {
#pragma unroll
    for (int j = 0; j < 4; ++j) { const u32x2 w = ((const GAS u32x2*)p)[lane + 64 * j]; v[j] = (f32x4){bflo(w.x), bfhi(w.x), bflo(w.y), bfhi(w.y)}; }
}
DI void row_st(float* p, int lane, const f32x4 (&v)[4]) {
#pragma unroll
    for (int j = 0; j < 4; ++j) ((GAS f32x4*)p)[lane + 64 * j] = v[j];
}
DI void row_st_bf(bf16* p, int lane, const f32x4 (&v)[4]) {
#pragma unroll
    for (int j = 0; j < 4; ++j) { u32x2 w; w.x = cvtpk(v[j].x, v[j].y); w.y = cvtpk(v[j].z, v[j].w); ((GAS u32x2*)p)[lane + 64 * j] = w; }
}
DI void row_st_f8(unsigned char* p, int lane, const f32x4 (&v)[4], float s) {
#pragma unroll
    for (int j = 0; j < 4; ++j) ((GAS unsigned*)p)[lane + 64 * j] = f8x4(v[j].x * s, v[j].y * s, v[j].z * s, v[j].w * s);
}
DI float row_rstd(const f32x4 (&v)[4]) {
    float s = 0.f;
#pragma unroll
    for (int j = 0; j < 4; ++j) s += (v[j].x * v[j].x + v[j].y * v[j].y) + (v[j].z * v[j].z + v[j].w * v[j].w);
    return rsqrtf(wave_sum(s) * (1.f / 1024.f) + RMS_EPS);
}
DI void row_modulate(const f32x4 (&x)[4], const float* g, const float* shift, const float* scale, int lane, f32x4 (&h)[4]) {
    const float r = row_rstd(x);
#pragma unroll
    for (int j = 0; j < 4; ++j) { const f32x4 gg = ((const GAS f32x4*)g)[lane + 64 * j], sh = ((const GAS f32x4*)shift)[lane + 64 * j], sc = ((const GAS f32x4*)scale)[lane + 64 * j];
        h[j] = x[j] * r * gg * (sc + 1.f) + sh; }
}

DI v4u pack8u(const f32x4& a, const f32x4& b) { v4u w; w.x = cvtpk(a[0], a[1]); w.y = cvtpk(a[2], a[3]); w.z = cvtpk(b[0], b[1]); w.w = cvtpk(b[2], b[3]); return w; }
template <int MODE> struct EpiInT {
    static constexpr bool PERM = true, AFTER_DRAIN = false, KHOOK = false;
    bf16* P; float* LF; const float* tab; const float* lb; int pn_off; float osc;
    DI void operator()(const pg8::f32x4 (&acc)[2][2][4][2], const pg8::Unit& u, int wr, int wc, int fr_, int fq_) const {
        const int lane_ = tid_opaque() & 63, fr = lane_ & 15, fq = lane_ >> 4;
        const int pn = u.pn + pn_off; const bool lat = u.pm < 64;
#pragma unroll
        for (int bj = 0; bj < 2; ++bj) {
            int mode;
            float sc = 1.f;
            if (pn <= 1 || pn == 3 || pn == 4) { mode = 1; sc = QSCALE; }
            else if (pn == 2) mode = (bj == 0) ? 1 : 0;
            else if (pn == 5 || pn == 6) mode = 1;
            else if (pn == 9 || pn == 10 || pn == 17 || pn == 18) mode = 2;
            else if (pn >= 13 && pn <= 16) mode = 3;
            else if (pn >= 19) mode = 4;
            else mode = 0;
            if (mode == 1 && !lat) mode = 0;
            if (MODE == 2) mode = (mode == 3) ? 5 : 0;
            unsigned keep_ = 0u;
            const int cu = pn * 256 + bj * 128 + wc * 32;
            if (mode == 3 || mode == 5) {
                const int dir = (pn >= 15) ? 1 : 0; const int ch = (pn - 13 - 2 * dir) * 256 + bj * 128 + wc * 32 + 8 * fq;
                const f32x4 l0 = *(const GAS f32x4*)(lb + dir * 512 + ch), l1 = *(const GAS f32x4*)(lb + dir * 512 + ch + 4);
#pragma unroll
                for (int ai = 0; ai < 2; ++ai)
#pragma unroll
                    for (int m = 0; m < 4; ++m) {
                        const int rowu = u.pm * 256 + ai * 128 + wr * 64 + m * 16;
                        f32x4 v0 = acc[ai][bj][m][0] * osc, v1 = acc[ai][bj][m][1] * osc;
                        if (mode == 3) {
#pragma unroll
                            for (int j = 0; j < 4; ++j) { v0[j] = fmaxf(__logf(l0[j] + (1.f - l0[j]) * sigm_f(v0[j])), -60.f); v1[j] = fmaxf(__logf(l1[j] + (1.f - l1[j]) * sigm_f(v1[j])), -60.f); } }
                        float* lp = LF + (size_t)rowu * 1024 + dir * 512 + (pn - 13 - 2 * dir) * 256 + bj * 128 + wc * 32;
                        if (MODE != 1) { *(GAS f32x4*)(lp + fr * 1024 + 8 * fq) = v0; *(GAS f32x4*)(lp + fr * 1024 + 8 * fq + 4) = v1; } else keep_ ^= __float_as_uint(v0[0] + v0[1] + v0[2] + v0[3] + v1[0] + v1[1] + v1[2] + v1[3]);
                        if (MODE == 1 && ai == 1 && m == 3) *(GAS unsigned*)(lp + fr * 1024 + 8 * fq) = keep_;
                    }
                continue;
            }
            v4u wout[2][4];
#pragma unroll
            for (int ai = 0; ai < 2; ++ai)
#pragma unroll
                for (int m = 0; m < 4; ++m) {
                    const int rowu = u.pm * 256 + ai * 128 + wr * 64 + m * 16, row = rowu + fr;
                    f32x4 v0 = acc[ai][bj][m][0] * osc, v1 = acc[ai][bj][m][1] * osc;
                    if (mode == 1) {
                        const int s = row & (SEQ - 1); const int half = wc & 1; const int pos = half ? (s & 63) : (s >> 6);
                        const float* tb = tab + (half ? 4096 : 0) + pos * 16 + 8 * (fq & 1); const int so = half ? 1024 : 2048;
                        const f32x4 c0 = *(const GAS f32x4*)tb, c1 = *(const GAS f32x4*)(tb + 4), s0 = *(const GAS f32x4*)(tb + so), s1 = *(const GAS f32x4*)(tb + so + 4);
                        const float sg = (fq < 2) ? -sc : sc;
                        f32x4 p0, p1;
#pragma unroll
                        for (int j = 0; j < 4; ++j) { p0[j] = __shfl_xor(v0[j], 32); p1[j] = __shfl_xor(v1[j], 32); }
                        v0 = v0 * c0 * sc + p0 * s0 * sg; v1 = v1 * c1 * sc + p1 * s1 * sg;
                    } else if (mode == 0) { v0 = v0 * sc; v1 = v1 * sc; }
                    else if (mode == 2) {
#pragma unroll
                        for (int j = 0; j < 4; ++j) { v0[j] = silu_f(v0[j]); v1[j] = silu_f(v1[j]); }
                    } else {
#pragma unroll
                        for (int j = 0; j < 4; ++j) { v0[j] = sigm_f(v0[j]); v1[j] = sigm_f(v1[j]); }
                    }
                    wout[ai][m] = pack8u(v0, v1);
                }
#pragma unroll
            for (int ai = 0; ai < 2; ++ai)
#pragma unroll
                for (int m = 0; m < 4; ++m) {
                    bf16* op = P + (size_t)(u.pm * 256 + ai * 128 + wr * 64 + m * 16) * INW + cu;
                    if (MODE != 1) *(GAS v4u*)(op + fr * INW + 8 * fq) = wout[ai][m]; else { const v4u pw = wout[ai][m]; keep_ ^= pw.x ^ pw.y ^ pw.z ^ pw.w; if (ai == 1 && m == 3) *(GAS unsigned*)(op + fr * INW + 8 * fq) = keep_; }
                }
        }
    }
};
typedef EpiInT<0> EpiIn;
struct EpiMerge {
    static constexpr bool PERM = true, AFTER_DRAIN = false, KHOOK = true;
    const bf16* P; bf16* Y;
    DI void khook(pg8::f32x4 (&acc)[2][2][4][2], const pg8::Unit& u, int seam, int wr, int wc, int fr_, int fq_) const {
        const int lane_ = tid_opaque() & 63, fr = lane_ & 15, fq = lane_ >> 4;
        const int loff = fr * INW + 8 * fq;
#pragma unroll
        for (int ai = 0; ai < 2; ++ai)
#pragma unroll
            for (int m = 0; m < 4; ++m) {
                const bf16* gb = P + (size_t)(u.pm * 256 + ai * 128 + wr * 64 + m * 16) * INW + C_GT + (seam - 1) * 1024 + u.pn * 256 + wc * 32;
#pragma unroll
                for (int bj = 0; bj < 2; ++bj) {
                    const bf16* gp = gb + bj * 128 + loff;
                    const v4u ga = *(const GAS v4u*)gp, gn = *(const GAS v4u*)(gp + 1024);
                    const f32x4 r0 = (f32x4){bflo(ga.x) * __builtin_amdgcn_rcpf(bflo(gn.x)), bfhi(ga.x) * __builtin_amdgcn_rcpf(bfhi(gn.x)), bflo(ga.y) * __builtin_amdgcn_rcpf(bflo(gn.y)), bfhi(ga.y) * __builtin_amdgcn_rcpf(bfhi(gn.y))};
                    const f32x4 r1 = (f32x4){bflo(ga.z) * __builtin_amdgcn_rcpf(bflo(gn.z)), bfhi(ga.z) * __builtin_amdgcn_rcpf(bfhi(gn.z)), bflo(ga.w) * __builtin_amdgcn_rcpf(bflo(gn.w)), bfhi(ga.w) * __builtin_amdgcn_rcpf(bfhi(gn.w))};
                    acc[ai][bj][m][0] = acc[ai][bj][m][0] * r0; acc[ai][bj][m][1] = acc[ai][bj][m][1] * r1;
                }
                { asm volatile("" ::: "memory");
                    __builtin_amdgcn_sched_barrier(0); }
            }
    }
    DI void operator()(const pg8::f32x4 (&acc)[2][2][4][2], const pg8::Unit& u, int wr, int wc, int fr_, int fq_) const {
        const int lane_ = tid_opaque() & 63, fr = lane_ & 15, fq = lane_ >> 4;
        const int loff = fr * INW + 8 * fq, yoff = fr * 1024 + 8 * fq;
#pragma unroll
        for (int ai = 0; ai < 2; ++ai)
#pragma unroll
            for (int m = 0; m < 4; ++m) {
                const int rowu = u.pm * 256 + ai * 128 + wr * 64 + m * 16, colu = u.pn * 256 + wc * 32;
                const bf16* gb = P + (size_t)rowu * INW + C_GT + 2 * 1024 + colu; bf16* yb = Y + (size_t)rowu * 1024 + colu;
#pragma unroll
                for (int bj = 0; bj < 2; ++bj) {
                    const v4u gw = *(const GAS v4u*)(gb + bj * 128 + loff);
                    const f32x4 v0 = acc[ai][bj][m][0] * (f32x4){bflo(gw.x), bfhi(gw.x), bflo(gw.y), bfhi(gw.y)}, v1 = acc[ai][bj][m][1] * (f32x4){bflo(gw.z), bfhi(gw.z), bflo(gw.w), bfhi(gw.w)};
                    *(GAS v4u*)(yb + bj * 128 + yoff) = pack8u(v0, v1);
                }
                asm volatile("" ::: "memory");
            }
    }
};
struct EpiNull {
    static constexpr bool PERM = true, AFTER_DRAIN = false, KHOOK = false;
    float* O;
    DI void operator()(const pg8::f32x4 (&acc)[2][2][4][2], const pg8::Unit& u, int wr, int wc, int fr_, int fq_) const {
        float s = 0.f;
#pragma unroll
        for (int ai = 0; ai < 2; ++ai)
#pragma unroll
            for (int bj = 0; bj < 2; ++bj)
#pragma unroll
                for (int m = 0; m < 4; ++m)
#pragma unroll
                    for (int n = 0; n < 2; ++n) s += (acc[ai][bj][m][n][0] + acc[ai][bj][m][n][1]) + (acc[ai][bj][m][n][2] + acc[ai][bj][m][n][3]);
        O[(size_t)(u.pm * 31 + (u.pn % 31)) * 512 + tid_opaque()] = s;
    }
};
struct EpiPlain {
    static constexpr bool PERM = true, AFTER_DRAIN = false, KHOOK = false;
    bf16* O; int ldc; const float* bias; int npn; float osc;
    DI void operator()(const pg8::f32x4 (&acc)[2][2][4][2], const pg8::Unit& u, int wr, int wc, int fr_, int fq_) const {
        const int lane_ = tid_opaque() & 63, fr = lane_ & 15, fq = lane_ >> 4;
        const int e = u.pn / npn, pn = u.pn % npn;
#pragma unroll
        for (int bj = 0; bj < 2; ++bj) {
            const int colu = pn * 256 + bj * 128 + wc * 32;
            f32x4 b0 = (f32x4){0.f, 0.f, 0.f, 0.f}, b1 = b0;
            if (bias) { const float* bp = bias + (size_t)e * npn * 256 + colu + 8 * fq; b0 = *(const GAS f32x4*)bp; b1 = *(const GAS f32x4*)(bp + 4); }
#pragma unroll
            for (int ai = 0; ai < 2; ++ai)
#pragma unroll
                for (int m = 0; m < 4; ++m) {
                    bf16* ob = O + (size_t)(u.pm * 256 + ai * 128 + wr * 64 + m * 16) * ldc + colu;
                    *(GAS v4u*)(ob + fr * ldc + 8 * fq) = pack8u(acc[ai][bj][m][0] * osc + b0, acc[ai][bj][m][1] * osc + b1);
                }
        }
    }
};
template <int MODE> struct EpiSwigluT {
    static constexpr bool PERM = true, AFTER_DRAIN = false, KHOOK = false;
    unsigned char* O; const float* bias;
    DI void operator()(const pg8::f32x4 (&acc)[2][2][4][2], const pg8::Unit& u, int wr, int wc, int fr_, int fq_) const {
        const int lane_ = tid_opaque() & 63, fr = lane_ & 15, fq = lane_ >> 4;
        const int e = u.pn >> 3, nt = u.pn & 7;
        const int colu = nt * 128 + wc * 32;
        const float* bp = bias + (size_t)e * 2048 + colu + 8 * fq;
        const f32x4 bg0 = *(const GAS f32x4*)bp, bg1 = *(const GAS f32x4*)(bp + 4), bu0 = *(const GAS f32x4*)(bp + 1024), bu1 = *(const GAS f32x4*)(bp + 1028);
        unsigned keep_ = 0u;
#pragma unroll
        for (int ai = 0; ai < 2; ++ai)
#pragma unroll
            for (int m = 0; m < 4; ++m) {
                f32x4 v[2];
#pragma unroll
                for (int n = 0; n < 2; ++n) { const f32x4 g = acc[ai][0][m][n] * (1.f / (F8_ACT * F8_W)) + (n ? bg1 : bg0), uu = acc[ai][1][m][n] * (1.f / (F8_ACT * F8_W)) + (n ? bu1 : bu0);
#pragma unroll
                    for (int j = 0; j < 4; ++j) { if (MODE == 2) v[n][j] = g[j] + uu[j]; else { const float gc = fminf(g[j], 7.f), uc = fminf(fmaxf(uu[j], -7.f), 7.f); v[n][j] = (uc + 1.f) * (gc * sigm_f(1.702f * gc)); } } }
                unsigned char* ob = O + (size_t)(u.pm * 256 + ai * 128 + wr * 64 + m * 16) * 1024 + colu;
                u32x2 w8; w8.x = f8x4(v[0][0] * F8_MID, v[0][1] * F8_MID, v[0][2] * F8_MID, v[0][3] * F8_MID); w8.y = f8x4(v[1][0] * F8_MID, v[1][1] * F8_MID, v[1][2] * F8_MID, v[1][3] * F8_MID);
                if (MODE != 1) *(GAS u32x2*)(ob + fr * 1024 + 8 * fq) = w8; else if (ai == 1 && m == 3) *(GAS unsigned*)(ob + fr * 1024 + 8 * fq) = w8.x ^ w8.y ^ keep_; else keep_ ^= w8.x + w8.y;
            }
    }
};
typedef EpiSwigluT<0> EpiSwiglu;
struct SubOrder {
    pg8::StaticOrder base; int skip_from, skip_n;
    DI bool next(int i, pg8::Unit& u) const { if (!base.next(i, u)) return false; if (u.pn >= skip_from) u.pn += skip_n; return true; }
    DI void a_ready(const pg8::Unit&) const {}
    DI void done(const pg8::Unit&) const {}
};
struct MoeOrder {
    const volatile LAS int* tpre; int NT, G, c;
    DI bool next(int i, pg8::Unit& u) const {
        const int L = i * G + c, total = __builtin_amdgcn_readfirstlane(tpre[32]) * NT; if (L >= total) return false;
        const int mt = L / NT, nt = L % NT; int e = 0;
        for (int k = 1; k < 32; ++k) e += (tpre[k] <= mt) ? 1 : 0;
        u.pm = mt; u.pn = __builtin_amdgcn_readfirstlane(e) * NT + nt; return true;
    }
    DI void a_ready(const pg8::Unit&) const {}
    DI void done(const pg8::Unit&) const {}
};

template <int KW> DI int swzK(int row) { return KW == 128 ? (row & 15) : ((row >> 1) & 7); }
template <int VD> DI int swzV(int row) { return VD == 128 ? (row & 3) : ((row >> 1) & 1); }
struct AttnJob {
    int qrow;
    int qcol;
    int kcolT, vcolT, kc8;
    int seg0_row, n0, seg0_kpos0;
    int seg1_row, n1;
    int qpos0;
};
template <int KW, int VD, bool WINDOW>
DI void attn_run(LAS unsigned char* lds, const bf16* P, const AttnJob& J, f32x16 (&O)[VD / 32], float& m_out, float& l_out) {
    const int tid = tid_opaque(), lane = tid & 63, r32 = lane & 31, hi = lane >> 5;
    constexpr int KCH = KW / 8, VCH = VD / 8, NKR = KW / 64, NVR = VD / 64;
    bf16x8 qf[4];
#pragma unroll
    for (int d0 = 0; d0 < 4; ++d0) qf[d0] = *(const GAS bf16x8*)(P + (size_t)(J.qrow + r32) * INW + J.qcol + d0 * 16 + hi * 8);
#pragma unroll
    for (int d = 0; d < VD / 32; ++d) O[d] = (f32x16){0.f, 0.f, 0.f, 0.f, 0.f, 0.f, 0.f, 0.f, 0.f, 0.f, 0.f, 0.f, 0.f, 0.f, 0.f, 0.f};
    float m = -1e30f, l = 0.f;
    const int nt = J.n0 + J.n1;
    v4u kr[NKR], vr[NVR];
#define ATT_TROW(t) ((t) < J.n0 ? J.seg0_row + 64 * (t) : J.seg1_row + 64 * ((t) - J.n0))
#define ATT_LOAD(t) do { const int rs_ = ATT_TROW(t); \
        _Pragma("unroll") for (int i = 0; i < NKR; ++i) { const int ci = tid + NTHR * i, row = ci / KCH, cc = ci % KCH; kr[i] = *(const GAS v4u*)(P + (size_t)(rs_ + row) * INW + J.kcolT + cc * 8); } \
        _Pragma("unroll") for (int i = 0; i < NVR; ++i) { const int ci = tid + NTHR * i, row = ci / VCH, cc = ci % VCH; vr[i] = *(const GAS v4u*)(P + (size_t)(rs_ + row) * INW + J.vcolT + cc * 8); } } while (0)
#define ATT_STORE(buf) do { \
        _Pragma("unroll") for (int i = 0; i < NKR; ++i) { const int ci = tid + NTHR * i, row = ci / KCH, cc = ci % KCH; *(LAS v4u*)(lds + (buf) * 16384 + row * (KW * 2) + ((cc ^ swzK<KW>(row)) << 4)) = kr[i]; } \
        _Pragma("unroll") for (int i = 0; i < NVR; ++i) { const int ci = tid + NTHR * i, row = ci / VCH, cc = ci % VCH; *(LAS v4u*)(lds + 32768 + (buf) * 16384 + row * (VD * 2) + ((((cc >> 2) ^ swzV<VD>(row)) << 6) | ((cc & 3) << 4))) = vr[i]; } } while (0)
    if (nt > 0) { ATT_LOAD(0); ATT_STORE(0); }
    __syncthreads();
    for (int t = 0; t < nt; ++t) {
        const int cur = t & 1;
        if (t + 1 < nt) ATT_LOAD(t + 1);
        const LAS unsigned char* kb = lds + cur * 16384; const LAS unsigned char* vb = lds + 32768 + cur * 16384;
        f32x16 st[2];
#pragma unroll
        for (int sub = 0; sub < 2; ++sub) {
            f32x16 a = (f32x16){0.f, 0.f, 0.f, 0.f, 0.f, 0.f, 0.f, 0.f, 0.f, 0.f, 0.f, 0.f, 0.f, 0.f, 0.f, 0.f};
            const int row = 32 * sub + r32;
#pragma unroll
            for (int d0 = 0; d0 < 4; ++d0) { const int ch = J.kc8 + 2 * d0 + hi;
                const bf16x8 kf = *(const LAS bf16x8*)(kb + row * (KW * 2) + ((ch ^ swzK<KW>(row)) << 4));
                a = MFMA32(kf, qf[d0], a); }
            st[sub] = a;
        }
        if (WINDOW && t < J.n0) {
            const int kp0 = J.seg0_kpos0 + 64 * t - (J.qpos0 + r32);
#pragma unroll
            for (int sub = 0; sub < 2; ++sub)
#pragma unroll
                for (int r = 0; r < 16; ++r) { const int rel = kp0 + 32 * sub + crow(r, hi); if (rel > 128 || rel < -128) st[sub][r] = -INFINITY; }
        }
        float tm = st[0][0];
#pragma unroll
        for (int r = 1; r < 16; ++r) tm = fmaxf(tm, st[0][r]);
#pragma unroll
        for (int r = 0; r < 16; ++r) tm = fmaxf(tm, st[1][r]);
        tm = fmaxf(tm, __shfl_xor(tm, 32));
        const float mn = fmaxf(m, tm), alpha = __builtin_amdgcn_exp2f(m - mn); m = mn;
        float ls = 0.f;
#pragma unroll
        for (int sub = 0; sub < 2; ++sub)
#pragma unroll
            for (int r = 0; r < 16; ++r) { const float p = __builtin_amdgcn_exp2f(st[sub][r] - mn); st[sub][r] = p; ls += p; }
        l = l * alpha + ls;
#pragma unroll
        for (int d = 0; d < VD / 32; ++d) O[d] = O[d] * alpha;
        bf16x8 pb[2][2];
#pragma unroll
        for (int sub = 0; sub < 2; ++sub)
#pragma unroll
            for (int s = 0; s < 2; ++s) pb[sub][s] = pack8(st[sub][8 * s], st[sub][8 * s + 1], st[sub][8 * s + 2], st[sub][8 * s + 3], st[sub][8 * s + 4], st[sub][8 * s + 5], st[sub][8 * s + 6], st[sub][8 * s + 7]);
        const int q4 = (lane & 15) >> 2, p4 = lane & 3, blk = (lane >> 4) & 1;
#pragma unroll
        for (int d = 0; d < VD / 32; ++d)
#pragma unroll
            for (int sub = 0; sub < 2; ++sub)
#pragma unroll
                for (int s = 0; s < 2; ++s) {
                    const int r0 = 32 * sub + 16 * s + 4 * hi + q4, r1 = r0 + 8;
                    const s16x4 lo = tr_read((LAS const char*)(vb + r0 * (VD * 2) + (((d ^ swzV<VD>(r0)) << 6) | (blk << 5) | (p4 << 3))));
                    const s16x4 hh = tr_read((LAS const char*)(vb + r1 * (VD * 2) + (((d ^ swzV<VD>(r1)) << 6) | (blk << 5) | (p4 << 3))));
                    O[d] = MFMA32(cat8(lo, hh), pb[sub][s], O[d]);
                }
        if (t + 1 < nt) ATT_STORE(cur ^ 1);
        __syncthreads();
    }
#undef ATT_TROW
#undef ATT_LOAD
#undef ATT_STORE
    l += __shfl_xor(l, 32);
    m_out = m; l_out = l;
}

DI void ph_attn_a(LAS unsigned char* lds, const bf16* P, bf16* OA, const float* sink, bool with_ctx, int vcu, int G) {
    const int lane = tid_opaque() & 63, wave = __builtin_amdgcn_readfirstlane(tid_opaque() >> 6), r32 = lane & 31, hi = lane >> 5;
    const int nun = 512 + (with_ctx ? 16 : 0);
    for (int u = vcu; u < nun; u += G) {
        AttnJob J; int b, kvh, q0; const bool cq = u >= 512;
        if (!cq) { b = u >> 8; kvh = (u >> 7) & 1; q0 = (u & 127) * 64;
            int jlo = 0, jhi = 4; if (q0 == 0) jlo = 2; else if (q0 == 64) jlo = 1; if (q0 == SEQ - 64) jhi = 2; else if (q0 == SEQ - 128) jhi = 3;
            J.seg0_kpos0 = q0 - 128 + 64 * jlo; J.seg0_row = b * SEQ + J.seg0_kpos0; J.n0 = jhi - jlo + 1; J.qrow = b * SEQ + q0 + 32 * (wave & 1); J.qpos0 = q0 + 32 * (wave & 1); }
        else { const int v = u - 512; b = v >> 3; kvh = (v >> 2) & 1; q0 = (v & 3) * 64; J.seg0_kpos0 = 0; J.seg0_row = 0; J.n0 = 0; J.qrow = NLAT + b * CTXL + q0 + 32 * (wave & 1); J.qpos0 = 0; }
        const int head = kvh * 4 + (wave >> 1);
        J.qcol = C_AQ + head * 64; J.kcolT = C_AK + kvh * 64; J.vcolT = C_AV + kvh * 64; J.kc8 = 0; J.seg1_row = NLAT + b * CTXL; J.n1 = 4;
        f32x16 O[2]; float m, l;
        attn_run<64, 64, true>(lds, P, J, O, m, l);
        l += __builtin_amdgcn_exp2f(sink[head] * LOG2E - m);
        const float inv = 1.f / l;
        bf16* op = OA + (size_t)(J.qrow + r32) * 1536 + head * 64;
#pragma unroll
        for (int d = 0; d < 2; ++d)
#pragma unroll
            for (int rg = 0; rg < 4; ++rg) { u32x2 w; w.x = cvtpk(O[d][4 * rg] * inv, O[d][4 * rg + 1] * inv); w.y = cvtpk(O[d][4 * rg + 2] * inv, O[d][4 * rg + 3] * inv);
                *(GAS u32x2*)(op + 32 * d + 8 * rg + 4 * hi) = w; }
    }
}
#ifndef AB_WIDE
#define AB_WIDE 1
#endif
#define SPLAT16(x) ((f32x16){(x), (x), (x), (x), (x), (x), (x), (x), (x), (x), (x), (x), (x), (x), (x), (x)})
DI float max3_asm(float a, float b, float c) { float r; asm("v_max3_f32 %0, %1, %2, %3" : "=v"(r) : "v"(a), "v"(b), "v"(c)); return r; }
DI float rowmax32(const f32x16& a, const f32x16& b) {
    float x = max3_asm(a[0], a[1], b[0]), y = max3_asm(a[2], a[3], b[1]);
    x = max3_asm(x, b[2], b[3]);
#pragma unroll
    for (int r = 4; r < 16; r += 4) { x = max3_asm(x, a[r], a[r + 1]); y = max3_asm(y, a[r + 2], a[r + 3]); x = max3_asm(x, b[r], b[r + 1]); y = max3_asm(y, b[r + 2], b[r + 3]); }
    x = fmaxf(x, y);
    const auto sw = __builtin_amdgcn_permlane32_swap(__float_as_uint(x), __float_as_uint(x), false, false);
    return max3_asm(__uint_as_float(sw[0]), __uint_as_float(sw[1]), x);
}
#define LDSRD128(dst, addr, off) asm volatile("ds_read_b128 %0, %1 offset:%c2" : "=&v"(dst) : "v"(addr), "i"(off) : "memory")
#define LDSTR64(dst, addr, off) asm volatile("ds_read_b64_tr_b16 %0, %1 offset:%c2" : "=&v"(dst) : "v"(addr), "i"(off) : "memory")
#define LGKM_WAIT(n) do { asm volatile("s_waitcnt lgkmcnt(" #n ")" ::: "memory"); __builtin_amdgcn_sched_barrier(0); } while (0)
template <int VAR> DI void attn_b_run(LAS unsigned char* lds, const bf16* P, const AttnJob& J, f32x16 (&O)[4], float& l_out) {
    const int tid = tid_opaque(), lane = tid & 63, r32 = lane & 31, hi = lane >> 5, wave = __builtin_amdgcn_readfirstlane(tid >> 6);
    bf16x8 qf[4];
#pragma unroll
    for (int d0 = 0; d0 < 4; ++d0) qf[d0] = *(const GAS bf16x8*)(P + (size_t)(J.qrow + r32) * INW + J.qcol + d0 * 16 + hi * 8);
#pragma unroll
    for (int d = 0; d < 4; ++d) O[d] = SPLAT16(0.f);
    const int nt = J.n0 + J.n1;
    const unsigned lds0 = (unsigned)(uintptr_t)lds;
    unsigned ka0, va0;
    { const int q4 = (lane & 15) >> 2, p4 = lane & 3, blk = (lane >> 4) & 1;
      ka0 = lds0 + r32 * 256 + (((J.kc8 + hi) ^ (r32 & 15)) << 4);
      va0 = lds0 + 49152 + (4 * hi + q4) * 256 + ((q4 << 6) | (blk << 5) | (p4 << 3)); }
#define ka(i) (ka0 ^ ((i) << 5))
#define va(i) (va0 ^ ((i) << 6))
#define AB_TROW(t) ((t) < J.n0 ? J.seg0_row + 64 * (t) : J.seg1_row + 64 * ((t) - J.n0))
    unsigned dko[2], dvo[2];
#pragma unroll
    for (int i = 0; i < 2; ++i) { const int row_ = 4 * (2 * wave + i) + (lane >> 4), cp_ = lane & 15;
        dko[i] = (unsigned)(row_ * INW + J.kcolT + ((cp_ ^ (row_ & 15)) << 3)) * 2u; dvo[i] = (unsigned)(row_ * INW + J.vcolT + (((((cp_ >> 2) ^ (row_ & 3)) << 2) | (cp_ & 3)) << 3)) * 2u; }
#define AB_DMA(t, st) do { const char* src_ = (const char*)(P + (size_t)AB_TROW(t) * INW); \
        _Pragma("unroll") for (int i = 0; i < 2; ++i) __builtin_amdgcn_global_load_lds((const unsigned*)(src_ + dko[i]), (LAS unsigned*)(lds + (st) * 16384 + (2 * wave + i) * 1024), 16, 0, 0); \
        _Pragma("unroll") for (int i = 0; i < 2; ++i) __builtin_amdgcn_global_load_lds((const unsigned*)(src_ + dvo[i]), (LAS unsigned*)(lds + 49152 + (st) * 16384 + (2 * wave + i) * 1024), 16, 0, 0); } while (0)
#define AB_KREAD(ST) do { \
        LDSRD128(kf[0], ka(0), (ST) * 16384); LDSRD128(kf[1], ka(0), (ST) * 16384 + 8192); LDSRD128(kf[2], ka(1), (ST) * 16384); LDSRD128(kf[3], ka(1), (ST) * 16384 + 8192); \
        LDSRD128(kf[4], ka(2), (ST) * 16384); LDSRD128(kf[5], ka(2), (ST) * 16384 + 8192); LDSRD128(kf[6], ka(3), (ST) * 16384); LDSRD128(kf[7], ka(3), (ST) * 16384 + 8192); } while (0)
#define AB_QKM(S0, S1) do { S0 = MFMA32(kf[0], qf[0], negm); S1 = MFMA32(kf[1], qf[0], negm); S0 = MFMA32(kf[2], qf[1], S0); S1 = MFMA32(kf[3], qf[1], S1); \
        S0 = MFMA32(kf[4], qf[2], S0); S1 = MFMA32(kf[5], qf[2], S1); S0 = MFMA32(kf[6], qf[3], S0); S1 = MFMA32(kf[7], qf[3], S1); } while (0)
#define AB_VREAD(VB, D, ST) do { \
        LDSTR64(VB[0], va(D), (ST) * 16384 + 0 * 4096); LDSTR64(VB[1], va(D), (ST) * 16384 + 0 * 4096 + 2048); LDSTR64(VB[2], va(D), (ST) * 16384 + 1 * 4096); LDSTR64(VB[3], va(D), (ST) * 16384 + 1 * 4096 + 2048); \
        LDSTR64(VB[4], va(D), (ST) * 16384 + 2 * 4096); LDSTR64(VB[5], va(D), (ST) * 16384 + 2 * 4096 + 2048); LDSTR64(VB[6], va(D), (ST) * 16384 + 3 * 4096); LDSTR64(VB[7], va(D), (ST) * 16384 + 3 * 4096 + 2048); } while (0)
#define AB_PVM(VB, D) do { O[D] = MFMA32(cat8(VB[0], VB[1]), pb00, O[D]); O[D] = MFMA32(cat8(VB[2], VB[3]), pb01, O[D]); O[D] = MFMA32(cat8(VB[4], VB[5]), pb10, O[D]); O[D] = MFMA32(cat8(VB[6], VB[7]), pb11, O[D]); } while (0)
    float m = 0.f, l = 0.f;
    f32x16 c0, c1, negm = SPLAT16(0.f);
    bf16x8 kf[8]; s16x4 vA[8], vB[8];
    AB_DMA(0, 0); if (nt > 1) AB_DMA(1, 1);
    if (nt > 1) asm volatile("s_waitcnt vmcnt(4)" ::: "memory"); else asm volatile("s_waitcnt vmcnt(0)" ::: "memory");
    __syncthreads();
#define AB_VREADK(VB, SS, ST) do { \
        LDSTR64(VB[0], va(0), (ST) * 16384 + (SS) * 4096); LDSTR64(VB[1], va(0), (ST) * 16384 + (SS) * 4096 + 2048); LDSTR64(VB[2], va(1), (ST) * 16384 + (SS) * 4096); LDSTR64(VB[3], va(1), (ST) * 16384 + (SS) * 4096 + 2048); \
        LDSTR64(VB[4], va(2), (ST) * 16384 + (SS) * 4096); LDSTR64(VB[5], va(2), (ST) * 16384 + (SS) * 4096 + 2048); LDSTR64(VB[6], va(3), (ST) * 16384 + (SS) * 4096); LDSTR64(VB[7], va(3), (ST) * 16384 + (SS) * 4096 + 2048); } while (0)
#define AB_EX2(C, B) do { C[B] = __builtin_amdgcn_exp2f(C[B]); C[(B) + 1] = __builtin_amdgcn_exp2f(C[(B) + 1]); } while (0)
#define AB_GAP(VB, D, PB, C, B) do { O[D] = MFMA32(cat8(VB[2 * (D)], VB[2 * (D) + 1]), PB, O[D]); AB_EX2(C, B); __builtin_amdgcn_sched_barrier(0); } while (0)
#define AB_GAPN(VB, D, PB) do { O[D] = MFMA32(cat8(VB[2 * (D)], VB[2 * (D) + 1]), PB, O[D]); __builtin_amdgcn_sched_barrier(0); } while (0)
#define AB_PK(C, B) pack8(C[B], C[(B) + 1], C[(B) + 2], C[(B) + 3], C[(B) + 4], C[(B) + 5], C[(B) + 6], C[(B) + 7])
#define AB_STEP(t, ST) do { \
        if ((t) + 2 < nt && (!(VAR & 4) || (t) < 1)) AB_DMA((t) + 2, ((ST) + 2) % 3); \
        if (!(VAR & 16) || wave < 4) { \
        if (!(VAR & 8)) { AB_KREAD(ST); LGKM_WAIT(0); AB_QKM(c0, c1); } else { c0 = negm; c1 = negm; } \
        AB_VREAD(vA, 0, ST); \
        asm volatile("s_nop 15\n\ts_nop 7" : "+v"(c0), "+v"(c1));     \
        { const float tm_ = rowmax32(c0, c1); const float sh_ = ((t) == 0) ? tm_ : (tm_ > 8.f ? tm_ : 0.f); \
          if (__any(sh_ != 0.f)) { _Pragma("unroll") for (int r = 0; r < 16; ++r) { c0[r] -= sh_; c1[r] -= sh_; } m += sh_; negm = SPLAT16(-m); \
              if ((t) > 0) { const float al_ = __builtin_amdgcn_exp2f(-sh_); l *= al_; _Pragma("unroll") for (int d = 0; d < 4; ++d) O[d] = O[d] * al_; } } } \
        float ls_ = 0.f; \
        { \
        if (!(VAR & 1)) { _Pragma("unroll") for (int r = 0; r < 16; ++r) { c0[r] = __builtin_amdgcn_exp2f(c0[r]); c1[r] = __builtin_amdgcn_exp2f(c1[r]); } } \
        { const f32x16 s_ = c0 + c1; const float s0_ = (s_[0] + s_[1]) + (s_[2] + s_[3]), s1_ = (s_[4] + s_[5]) + (s_[6] + s_[7]), s2_ = (s_[8] + s_[9]) + (s_[10] + s_[11]), s3_ = (s_[12] + s_[13]) + (s_[14] + s_[15]); ls_ = (s0_ + s1_) + (s2_ + s3_); } \
        l += ls_; \
        const bf16x8 pb00 = pack8(c0[0], c0[1], c0[2], c0[3], c0[4], c0[5], c0[6], c0[7]), pb01 = pack8(c0[8], c0[9], c0[10], c0[11], c0[12], c0[13], c0[14], c0[15]); \
        const bf16x8 pb10 = pack8(c1[0], c1[1], c1[2], c1[3], c1[4], c1[5], c1[6], c1[7]), pb11 = pack8(c1[8], c1[9], c1[10], c1[11], c1[12], c1[13], c1[14], c1[15]); \
        if (!(VAR & 2)) { AB_VREAD(vB, 1, ST); LGKM_WAIT(8); AB_PVM(vA, 0); \
        AB_VREAD(vA, 2, ST); LGKM_WAIT(8); AB_PVM(vB, 1); \
        AB_VREAD(vB, 3, ST); LGKM_WAIT(8); AB_PVM(vA, 2); \
        LGKM_WAIT(0); AB_PVM(vB, 3); } else { LGKM_WAIT(0); O[0][0] += c0[0] + (float)vA[0][0]; } } } \
        if ((t) + 2 < nt) asm volatile("s_waitcnt vmcnt(4)" ::: "memory"); else asm volatile("s_waitcnt vmcnt(0)" ::: "memory"); \
        if (!(VAR & 32) || (t) < 2 || (t) + 3 >= nt) __syncthreads(); } while (0)
    for (int t = 0; t < nt; t += 3) {
        AB_STEP(t, 0);
        if (t + 1 < nt) AB_STEP(t + 1, 1);
        if (t + 2 < nt) AB_STEP(t + 2, 2);
    }
#undef ka
#undef va
#undef AB_TROW
#undef AB_DMA
#undef AB_KREAD
#undef AB_QKM
#undef AB_VREAD
#undef AB_PVM
#undef AB_STEP
#undef AB_VREADK
#undef AB_EX2
#undef AB_GAP
#undef AB_GAPN
#undef AB_PK
    l += __shfl_xor(l, 32);
    l_out = l;
}
DI void attn_b_run_w(LAS unsigned char* lds, const bf16* P, const AttnJob& J, f32x16 (&O)[4], float& l_out) {
    const int tid = tid_opaque(), lane = tid & 63, r32 = lane & 31, hi = lane >> 5, wave = __builtin_amdgcn_readfirstlane(tid >> 6);
    bf16x8 qf[4];
#pragma unroll
    for (int d0 = 0; d0 < 4; ++d0) qf[d0] = *(const GAS bf16x8*)(P + (size_t)(J.qrow + r32) * INW + J.qcol + d0 * 16 + hi * 8);
#pragma unroll
    for (int d = 0; d < 4; ++d) O[d] = SPLAT16(0.f);
    const int ns = (J.n0 + J.n1) >> 1;
    const unsigned lds0 = (unsigned)(uintptr_t)lds;
    unsigned ka0, va0;
    { const int q4 = (lane & 15) >> 2, p4 = lane & 3, blk = (lane >> 4) & 1;
      ka0 = lds0 + r32 * 256 + (((J.kc8 + hi) ^ (r32 & 15)) << 4);
      va0 = lds0 + 65536 + (4 * hi + q4) * 256 + ((q4 << 6) | (blk << 5) | (p4 << 3)); }
#define ka(i) (ka0 ^ ((i) << 5))
#define va(i) (va0 ^ ((i) << 6))
#define AW_TROW(t) ((t) < J.n0 ? J.seg0_row + 64 * (t) : J.seg1_row + 64 * ((t) - J.n0))
    unsigned dko[2], dvo[2];
#pragma unroll
    for (int i = 0; i < 2; ++i) { const int row_ = 4 * (2 * wave + i) + (lane >> 4), cp_ = lane & 15;
        dko[i] = (unsigned)(row_ * INW + J.kcolT + ((cp_ ^ (row_ & 15)) << 3)) * 2u; dvo[i] = (unsigned)(row_ * INW + J.vcolT + (((((cp_ >> 2) ^ (row_ & 3)) << 2) | (cp_ & 3)) << 3)) * 2u; }
#define AW_DMA1(t, off) do { const char* src_ = (const char*)(P + (size_t)AW_TROW(t) * INW); \
        _Pragma("unroll") for (int i = 0; i < 2; ++i) __builtin_amdgcn_global_load_lds((const unsigned*)(src_ + dko[i]), (LAS unsigned*)(lds + (off) + (2 * wave + i) * 1024), 16, 0, 0); \
        _Pragma("unroll") for (int i = 0; i < 2; ++i) __builtin_amdgcn_global_load_lds((const unsigned*)(src_ + dvo[i]), (LAS unsigned*)(lds + 65536 + (off) + (2 * wave + i) * 1024), 16, 0, 0); } while (0)
#define AW_DMA(j, st) do { AW_DMA1(2 * (j), (st) * 32768); AW_DMA1(2 * (j) + 1, (st) * 32768 + 16384); } while (0)
#define AW_KREAD(OFF, H) do { \
        LDSRD128(kf[0], ka(2 * (H)), (OFF)); LDSRD128(kf[1], ka(2 * (H)), (OFF) + 8192); LDSRD128(kf[2], ka(2 * (H) + 1), (OFF)); LDSRD128(kf[3], ka(2 * (H) + 1), (OFF) + 8192); } while (0)
#define AW_QKM0(S0, S1) do { S0 = MFMA32(kf[0], qf[0], negm); S1 = MFMA32(kf[1], qf[0], negm); S0 = MFMA32(kf[2], qf[1], S0); S1 = MFMA32(kf[3], qf[1], S1); } while (0)
#define AW_QKM1(S0, S1) do { S0 = MFMA32(kf[0], qf[2], S0); S1 = MFMA32(kf[1], qf[2], S1); S0 = MFMA32(kf[2], qf[3], S0); S1 = MFMA32(kf[3], qf[3], S1); } while (0)
#define AW_VREAD(VB, D, OFF) do { \
        LDSTR64(VB[0], va(D), (OFF) + 0 * 4096); LDSTR64(VB[1], va(D), (OFF) + 0 * 4096 + 2048); LDSTR64(VB[2], va(D), (OFF) + 1 * 4096); LDSTR64(VB[3], va(D), (OFF) + 1 * 4096 + 2048); \
        LDSTR64(VB[4], va(D), (OFF) + 2 * 4096); LDSTR64(VB[5], va(D), (OFF) + 2 * 4096 + 2048); LDSTR64(VB[6], va(D), (OFF) + 3 * 4096); LDSTR64(VB[7], va(D), (OFF) + 3 * 4096 + 2048); } while (0)
#define AW_PVM(VB, D, PA, PB_, PC, PD) do { O[D] = MFMA32(cat8(VB[0], VB[1]), PA, O[D]); O[D] = MFMA32(cat8(VB[2], VB[3]), PB_, O[D]); O[D] = MFMA32(cat8(VB[4], VB[5]), PC, O[D]); O[D] = MFMA32(cat8(VB[6], VB[7]), PD, O[D]); } while (0)
#define AW_PK(C, B) pack8(C[B], C[(B) + 1], C[(B) + 2], C[(B) + 3], C[(B) + 4], C[(B) + 5], C[(B) + 6], C[(B) + 7])
    float m = 0.f, l = 0.f;
    f32x16 c00, c01, c10, c11;
    bf16x8 kf[4]; s16x4 vA[8], vB[8];
    AW_DMA(0, 0);
    asm volatile("s_waitcnt vmcnt(0)" ::: "memory"); __syncthreads();
#define AW_STEP(j, ST) do { \
        if ((j) + 1 < ns) AW_DMA((j) + 1, 1 - (ST)); \
        const f32x16 negm = SPLAT16(-m); \
        AW_KREAD((ST) * 32768, 0); LGKM_WAIT(0); AW_QKM0(c00, c01); AW_KREAD((ST) * 32768, 1); LGKM_WAIT(0); AW_QKM1(c00, c01); \
        AW_KREAD((ST) * 32768 + 16384, 0); LGKM_WAIT(0); AW_QKM0(c10, c11); AW_KREAD((ST) * 32768 + 16384, 1); LGKM_WAIT(0); AW_QKM1(c10, c11); \
        AW_VREAD(vA, 0, (ST) * 32768); \
        asm volatile("s_nop 15\n\ts_nop 7" : "+v"(c00), "+v"(c01), "+v"(c10), "+v"(c11)); \
        { const float tm_ = fmaxf(rowmax32(c00, c01), rowmax32(c10, c11)); const float sh_ = ((j) == 0) ? tm_ : (tm_ > 8.f ? tm_ : 0.f); \
          if (__any(sh_ != 0.f)) { _Pragma("unroll") for (int r = 0; r < 16; ++r) { c00[r] -= sh_; c01[r] -= sh_; c10[r] -= sh_; c11[r] -= sh_; } m += sh_; \
              if ((j) > 0) { const float al_ = __builtin_amdgcn_exp2f(-sh_); l *= al_; _Pragma("unroll") for (int d = 0; d < 4; ++d) O[d] = O[d] * al_; } } } \
        _Pragma("unroll") for (int r = 0; r < 16; ++r) { c00[r] = __builtin_amdgcn_exp2f(c00[r]); c01[r] = __builtin_amdgcn_exp2f(c01[r]); c10[r] = __builtin_amdgcn_exp2f(c10[r]); c11[r] = __builtin_amdgcn_exp2f(c11[r]); } \
        { const f32x16 s_ = (c00 + c01) + (c10 + c11); const float s0_ = (s_[0] + s_[1]) + (s_[2] + s_[3]), s1_ = (s_[4] + s_[5]) + (s_[6] + s_[7]), s2_ = (s_[8] + s_[9]) + (s_[10] + s_[11]), s3_ = (s_[12] + s_[13]) + (s_[14] + s_[15]); l += (s0_ + s1_) + (s2_ + s3_); } \
        const bf16x8 pa0 = AW_PK(c00, 0), pa1 = AW_PK(c00, 8), pa2 = AW_PK(c01, 0), pa3 = AW_PK(c01, 8); \
        AW_VREAD(vB, 1, (ST) * 32768); LGKM_WAIT(8); AW_PVM(vA, 0, pa0, pa1, pa2, pa3); \
        AW_VREAD(vA, 2, (ST) * 32768); LGKM_WAIT(8); AW_PVM(vB, 1, pa0, pa1, pa2, pa3); \
        AW_VREAD(vB, 3, (ST) * 32768); LGKM_WAIT(8); AW_PVM(vA, 2, pa0, pa1, pa2, pa3); \
        AW_VREAD(vA, 0, (ST) * 32768 + 16384); LGKM_WAIT(8); AW_PVM(vB, 3, pa0, pa1, pa2, pa3); \
        const bf16x8 pb0 = AW_PK(c10, 0), pb1 = AW_PK(c10, 8), pb2 = AW_PK(c11, 0), pb3 = AW_PK(c11, 8); \
        AW_VREAD(vB, 1, (ST) * 32768 + 16384); LGKM_WAIT(8); AW_PVM(vA, 0, pb0, pb1, pb2, pb3); \
        AW_VREAD(vA, 2, (ST) * 32768 + 16384); LGKM_WAIT(8); AW_PVM(vB, 1, pb0, pb1, pb2, pb3); \
        AW_VREAD(vB, 3, (ST) * 32768 + 16384); LGKM_WAIT(8); AW_PVM(vA, 2, pb0, pb1, pb2, pb3); \
        LGKM_WAIT(0); AW_PVM(vB, 3, pb0, pb1, pb2, pb3); \
        asm volatile("s_waitcnt vmcnt(0)" ::: "memory"); __syncthreads(); } while (0)
    for (int j = 0; j < ns; j += 2) {
        AW_STEP(j, 0);
        if (j + 1 < ns) AW_STEP(j + 1, 1);
    }
#undef ka
#undef va
#undef AW_TROW
#undef AW_DMA1
#undef AW_DMA
#undef AW_KREAD
#undef AW_QKM0
#undef AW_QKM1
#undef AW_VREAD
#undef AW_PVM
#undef AW_PK
#undef AW_STEP
    l += __shfl_xor(l, 32);
    l_out = l;
}
template <int VAR> DI void ph_attn_b(LAS unsigned char* lds, const bf16* P, bf16* OB, const float* dnw, float lam, float lam_init, bool with_ctx, int vcu, int G) {
    const int lane = tid_opaque() & 63, wave = __builtin_amdgcn_readfirstlane(tid_opaque() >> 6), r32 = lane & 31, hi = lane >> 5;
    const int nun = 512 + (with_ctx ? 16 : 0);
    LAS float* XB = (LAS float*)lds;
    for (int u = vcu; u < nun; u += G) {
        AttnJob J; int b, h, q0; const bool cq = u >= 512; const int qs = wave & 3, comp = wave >> 2;
        if (!cq) { b = u >> 8; h = (u >> 6) & 3; q0 = (u & 63) * 128; J.seg0_row = b * SEQ; J.n0 = 128; J.qrow = b * SEQ + q0 + 32 * qs; }
        else { const int v = u - 512; b = v >> 3; h = (v >> 1) & 3; q0 = (v & 1) * 128; J.seg0_row = 0; J.n0 = 0; J.qrow = NLAT + b * CTXL + q0 + 32 * qs; }
        J.seg0_kpos0 = 0; J.qpos0 = 0;
        J.qcol = C_BQ + h * 128 + comp * 64; J.kcolT = C_BK + h * 128; J.vcolT = C_BV + h * 128; J.kc8 = comp * 8; J.seg1_row = NLAT + b * CTXL; J.n1 = 4;
        f32x16 O[4]; float l;
        if (VAR == 64 || AB_WIDE) attn_b_run_w(lds, P, J, O, l); else attn_b_run<VAR>(lds, P, J, O, l);
        const float inv = 1.f / l;
        if (comp == 1) {
#pragma unroll
            for (int d = 0; d < 4; ++d)
#pragma unroll
                for (int r = 0; r < 16; ++r) XB[(qs * 128 + 32 * d + crow(r, hi)) * 32 + r32] = O[d][r] * inv;
        }
        __syncthreads();
        if (comp == 0) {
            float ss = 0.f;
#pragma unroll
            for (int d = 0; d < 4; ++d)
#pragma unroll
                for (int r = 0; r < 16; ++r) { const float o = O[d][r] * inv - lam * XB[(qs * 128 + 32 * d + crow(r, hi)) * 32 + r32]; O[d][r] = o; ss += o * o; }
            ss += __shfl_xor(ss, 32);
            const float rs = rsqrtf(ss * (1.f / 128.f) + RMS_EPS) * (1.f - lam_init);
            bf16* op = OB + (size_t)(J.qrow + r32) * 1536 + h * 128;
#pragma unroll
            for (int d = 0; d < 4; ++d)
#pragma unroll
                for (int rg = 0; rg < 4; ++rg) { const int e0 = 32 * d + 8 * rg + 4 * hi; const f32x4 wv = *(const GAS f32x4*)(dnw + e0);
                    u32x2 w; w.x = cvtpk(O[d][4 * rg] * rs * wv[0], O[d][4 * rg + 1] * rs * wv[1]); w.y = cvtpk(O[d][4 * rg + 2] * rs * wv[2], O[d][4 * rg + 3] * rs * wv[3]);
                    *(GAS u32x2*)(op + e0) = w; }
        }
        __syncthreads();
    }
}

DI int hg_row0(int b, int dir, int c) {
    if (dir == 0) return c < 4 ? NLAT + b * CTXL + 64 * c : b * SEQ + 64 * (c - 4);
    return c < 4 ? NLAT + b * CTXL + 64 * (3 - c) : b * SEQ + 64 * (131 - c);
}
DI void glds16(const void* src, LAS unsigned char* dst) { __builtin_amdgcn_global_load_lds((const unsigned*)src, (LAS unsigned*)dst, 16, 0, 0); }
DI void ph_hg1(LAS unsigned char* lds, const bf16* P, const float* LF, bf16* HU, float* HD, int vcu, int G) {
    const int tid = tid_opaque(), lane = tid & 63, wave = __builtin_amdgcn_readfirstlane(tid >> 6), r32 = lane & 31, hi = lane >> 5;
    LAS float* LFs = (LAS float*)lds; LAS unsigned char* Vs = lds + 32768; LAS unsigned char* KH = lds + 49152; LAS float* TOT = (LAS float*)(lds + 65536);
    for (int u = vcu; u < NB * 2 * NCH * 4; u += G) {
        const int h = u & 3, c = (u >> 2) % NCH, dir = ((u >> 2) / NCH) & 1, b = (u >> 2) / (2 * NCH), row0 = hg_row0(b, dir, c);
        const int uidx = ((b * 2 + dir) * 4 + h) * NCH + c;
#pragma unroll
        for (int i = 0; i < 4; ++i) { const int slot = 4 * wave + i, row = 2 * slot + (lane >> 5), ch = lane & 31;
            glds16(LF + (size_t)(row0 + row) * 1024 + dir * 512 + h * 128 + ch * 4, lds + slot * 1024); }
#pragma unroll
        for (int i = 0; i < 2; ++i) { const int slot = 2 * wave + i, row = 4 * slot + (lane >> 4), cp = lane & 15, sc = ((((cp >> 2) ^ (row & 3)) << 2) | (cp & 3));
            glds16(P + (size_t)(row0 + row) * INW + C_CI + h * 128 + sc * 8, Vs + slot * 1024); }
        asm volatile("s_waitcnt vmcnt(0)" ::: "memory"); __syncthreads();
        const int d = tid & 127, q = tid >> 7;
        float lf[16]; float sum = 0.f;
#pragma unroll
        for (int j = 0; j < 16; ++j) { lf[j] = LFs[(16 * q + j) * 128 + d]; sum += lf[j]; }
        TOT[q * 128 + d] = sum;
        __syncthreads();
        const float t0 = TOT[d], t1 = TOT[128 + d], t2 = TOT[256 + d], t3 = TOT[384 + d], total = (t0 + t1) + (t2 + t3);
        float pre = (q > 0 ? t0 : 0.f) + (q > 1 ? t1 : 0.f) + (q > 2 ? t2 : 0.f);
        float kv[16];
#pragma unroll
        for (int j = 0; j < 16; ++j) { const float arg = dir == 0 ? (total - pre - lf[j]) : pre; pre += lf[j]; kv[j] = (1.f - __expf(lf[j])) * __expf(arg); }
        *(LAS bf16x8*)(KH + d * 128 + (((2 * q) ^ ((d >> 1) & 7)) << 4)) = pack8(kv[0], kv[1], kv[2], kv[3], kv[4], kv[5], kv[6], kv[7]);
        *(LAS bf16x8*)(KH + d * 128 + (((2 * q + 1) ^ ((d >> 1) & 7)) << 4)) = pack8(kv[8], kv[9], kv[10], kv[11], kv[12], kv[13], kv[14], kv[15]);
        if (q == 0) HD[(size_t)uidx * 128 + d] = __expf(total);
        __syncthreads();
        const int eb = wave & 3, dkb0 = 2 * (wave >> 2), q4 = (lane & 15) >> 2, p4 = lane & 3, blk = (lane >> 4) & 1;
        f32x16 acc[2]; acc[0] = SPLAT16(0.f); acc[1] = SPLAT16(0.f);
#pragma unroll
        for (int ks = 0; ks < 4; ++ks) {
            const int r0 = 16 * ks + 8 * hi + q4, r1 = r0 + 4;
            const s16x4 lo = tr_read((LAS const char*)(Vs + r0 * 256 + (((eb ^ (r0 & 3)) << 6) | (blk << 5) | (p4 << 3))));
            const s16x4 hh = tr_read((LAS const char*)(Vs + r1 * 256 + (((eb ^ (r1 & 3)) << 6) | (blk << 5) | (p4 << 3))));
            const bf16x8 vf = cat8(lo, hh);
#pragma unroll
            for (int j = 0; j < 2; ++j) { const int R = 32 * (dkb0 + j) + r32, ch = 2 * ks + hi;
                const bf16x8 kf = *(const LAS bf16x8*)(KH + R * 128 + ((ch ^ ((R >> 1) & 7)) << 4));
                acc[j] = MFMA32(vf, kf, acc[j]); }
        }
        bf16* hu = HU + (size_t)uidx * 16384;
#pragma unroll
        for (int j = 0; j < 2; ++j)
#pragma unroll
            for (int r = 0; r < 16; ++r) hu[(32 * eb + crow(r, hi)) * 128 + 32 * (dkb0 + j) + r32] = (bf16)(cvtpk(acc[j][r], 0.f) & 0xffffu);
        __syncthreads();
    }
}
DI void ph_hg2(const bf16* HU, const float* HD, bf16* HS, int vcu, int G) {
    const int gt = vcu * NTHR + tid_opaque(), NT = G * NTHR;
    for (int idx = gt; idx < 16 * 8192; idx += NT) {
        const int chain = idx >> 13, pr = idx & 8191, e = pr >> 6, dk = (pr & 63) * 2;
        const bf16* up = HU + (size_t)chain * NCH * 16384 + e * 128 + dk; const float* dp = HD + (size_t)chain * NCH * 128 + dk; bf16* sp = HS + (size_t)chain * NCH * 16384 + e * 128 + dk;
        float s0 = 0.f, s1 = 0.f;
        for (int c0 = 0; c0 < NCH; c0 += 22) {
            unsigned uu[22]; f32x2 dd[22];
#pragma unroll
            for (int j = 0; j < 22; ++j) { uu[j] = *(const GAS unsigned*)(up + (size_t)(c0 + j) * 16384); dd[j] = *(const GAS f32x2*)(dp + (size_t)(c0 + j) * 128); }
#pragma unroll
            for (int j = 0; j < 22; ++j) { *(GAS unsigned*)(sp + (size_t)(c0 + j) * 16384) = cvtpk(s0, s1); s0 = dd[j].x * s0 + bflo(uu[j]); s1 = dd[j].y * s1 + bfhi(uu[j]); }
        }
    }
}
DI void ph_hg3(LAS unsigned char* lds, const bf16* P, const float* LF, const bf16* HS, bf16* OC, const float* hw, bool with_ctx, int vcu, int G, int probe_mode = 0) {
    const int tid = tid_opaque(), lane = tid & 63, wave = __builtin_amdgcn_readfirstlane(tid >> 6), tl = lane & 15, kg = lane >> 4;
    LAS float* BC = (LAS float*)lds; LAS unsigned char* VT = lds + 65536; LAS unsigned char* HSs = lds + 81920; LAS float* CB = (LAS float*)(lds + 81920);
    const int tc_lo = with_ctx ? 0 : 4, ntc = NCH - tc_lo, nun = NB * ntc * 4;
    for (int u = vcu; u < nun; u += G) {
        const int b = u / (ntc * 4), tc = tc_lo + (u / 4) % ntc, h = u & 3;
        const int row0 = tc < 4 ? NLAT + b * CTXL + 64 * tc : b * SEQ + 64 * (tc - 4);
        const int dir = wave >> 2, I = wave & 3, t = 16 * I + tl;
        v4u qw[4];
#pragma unroll
        for (int ks = 0; ks < 4; ++ks) qw[ks] = *(const GAS v4u*)(P + (size_t)(row0 + t) * INW + C_CQ + h * 128 + 32 * ks + 8 * kg);
        u32x2 gwv[8];
#pragma unroll
        for (int eb = 0; eb < 8; ++eb) gwv[eb] = *(const GAS u32x2*)(P + (size_t)(row0 + t) * INW + C_CG + h * 128 + 16 * eb + 4 * kg);
#pragma unroll
        for (int i = 0; i < 8; ++i) { const int slot = 8 * wave + i, dd = slot >> 5, row = 2 * (slot & 31) + (lane >> 5), ch = lane & 31;
            glds16(LF + (size_t)(row0 + row) * 1024 + dd * 512 + h * 128 + ch * 4, lds + slot * 1024); }
#pragma unroll
        for (int i = 0; i < 2; ++i) { const int slot = 2 * wave + i, row = 4 * slot + (lane >> 4), cp = lane & 15, sc = ((((cp >> 2) ^ (row & 3)) << 2) | (cp & 3));
            glds16(P + (size_t)(row0 + row) * INW + C_CI + h * 128 + sc * 8, VT + slot * 1024); }
#pragma unroll
        for (int i = 0; i < 8; ++i) { const int slot = 8 * wave + i, dd = slot >> 5, row = 4 * (slot & 31) + (lane >> 4), cp = lane & 15;
            const int cs = dd == 0 ? tc : (tc < 4 ? 3 - tc : 135 - tc);
            glds16(HS + ((size_t)(((b * 2 + dd) * 4 + h) * NCH + cs) * 128 + row) * 128 + ((cp ^ (row & 15)) << 3), HSs + slot * 1024); }
        asm volatile("s_waitcnt vmcnt(0)" ::: "memory"); __syncthreads();
        if (probe_mode == 1) { asm volatile("" :: "v"(qw[0]), "v"(qw[3])); __syncthreads(); continue; }
        if (tid < 256) { const int dd = tid >> 7, d = tid & 127; LAS float* col = BC + dd * 8192 + d; float v[64];
#pragma unroll
            for (int j = 0; j < 64; ++j) v[j] = col[j * 128];
            float a = 0.f;
            if (dd == 0) {
#pragma unroll
                for (int j = 0; j < 64; ++j) { a += v[j]; col[j * 128] = a; }
            } else {
#pragma unroll
                for (int j = 63; j >= 0; --j) { a += v[j]; col[j * 128] = a; }
            }
        }
        __syncthreads();
        if (probe_mode == 2) { asm volatile("" :: "v"(qw[0]), "v"(qw[3])); continue; }
        const LAS float* bc = BC + dir * 8192;
        const bool hasb = dir == 0 ? (I > 0) : (I < 3); const int brow = dir == 0 ? 16 * I - 1 : 16 * I + 16;
        bf16x8 qh[4], qt[4];
#pragma unroll
        for (int ks = 0; ks < 4; ++ks) { const int dk0 = 32 * ks + 8 * kg;
            const f32x4 b0 = *(const LAS f32x4*)(bc + t * 128 + dk0), b1 = *(const LAS f32x4*)(bc + t * 128 + dk0 + 4);
            f32x4 e0 = (f32x4){0.f, 0.f, 0.f, 0.f}, e1 = e0; if (hasb) { e0 = *(const LAS f32x4*)(bc + brow * 128 + dk0); e1 = *(const LAS f32x4*)(bc + brow * 128 + dk0 + 4); }
            const float q0 = bflo(qw[ks].x), q1 = bfhi(qw[ks].x), q2 = bflo(qw[ks].y), q3 = bfhi(qw[ks].y), q4 = bflo(qw[ks].z), q5 = bfhi(qw[ks].z), q6 = bflo(qw[ks].w), q7 = bfhi(qw[ks].w);
            qh[ks] = pack8(q0 * __expf(b0[0]), q1 * __expf(b0[1]), q2 * __expf(b0[2]), q3 * __expf(b0[3]), q4 * __expf(b1[0]), q5 * __expf(b1[1]), q6 * __expf(b1[2]), q7 * __expf(b1[3]));
            qt[ks] = pack8(q0 * __expf(b0[0] - e0[0]), q1 * __expf(b0[1] - e0[1]), q2 * __expf(b0[2] - e0[2]), q3 * __expf(b0[3] - e0[3]),
                           q4 * __expf(b1[0] - e1[0]), q5 * __expf(b1[1] - e1[1]), q6 * __expf(b1[2] - e1[2]), q7 * __expf(b1[3] - e1[3])); }
        f32x4 acc[8];
#pragma unroll
        for (int eb = 0; eb < 8; ++eb) acc[eb] = (f32x4){0.f, 0.f, 0.f, 0.f};
#pragma unroll
        for (int ks = 0; ks < 4; ++ks)
#pragma unroll
            for (int eb = 0; eb < 8; ++eb) { const int er = 16 * eb + tl;
                const bf16x8 sf = *(const LAS bf16x8*)(HSs + dir * 32768 + er * 256 + (((4 * ks + kg) ^ (er & 15)) << 4)); acc[eb] = MFMA16(sf, qh[ks], acc[eb]); }
        if (probe_mode == 3) { asm volatile("" :: "v"(acc[0]), "v"(acc[7]), "v"(qt[0]), "v"(qt[3])); __syncthreads(); continue; }
        f32x4 att[4];
#pragma unroll
        for (int Jb = 0; Jb < 4; ++Jb) {
            att[Jb] = (f32x4){0.f, 0.f, 0.f, 0.f};
            const bool active = dir == 0 ? (Jb <= I) : (Jb >= I);
            if (active) {
                const int s = 16 * Jb + tl; f32x4 a = (f32x4){0.f, 0.f, 0.f, 0.f};
                const int sp = dir == 0 ? s - 1 : s + 1; const bool hasp = dir == 0 ? (s > 0) : (s < 63);
#pragma unroll
                for (int ks = 0; ks < 4; ++ks) { const int dk0 = 32 * ks + 8 * kg;
                    const f32x4 b0 = *(const LAS f32x4*)(bc + s * 128 + dk0), b1 = *(const LAS f32x4*)(bc + s * 128 + dk0 + 4);
                    f32x4 p0 = (f32x4){0.f, 0.f, 0.f, 0.f}, p1 = p0; if (hasp) { p0 = *(const LAS f32x4*)(bc + sp * 128 + dk0); p1 = *(const LAS f32x4*)(bc + sp * 128 + dk0 + 4); }
                    f32x4 e0 = (f32x4){0.f, 0.f, 0.f, 0.f}, e1 = e0; if (hasb) { e0 = *(const LAS f32x4*)(bc + brow * 128 + dk0); e1 = *(const LAS f32x4*)(bc + brow * 128 + dk0 + 4); }
                    float kv[8];
#pragma unroll
                    for (int j = 0; j < 4; ++j) { kv[j] = (1.f - __expf(b0[j] - p0[j])) * __expf(fminf(e0[j] - b0[j], 80.f)); kv[4 + j] = (1.f - __expf(b1[j] - p1[j])) * __expf(fminf(e1[j] - b1[j], 80.f)); }
                    a = MFMA16(pack8(kv[0], kv[1], kv[2], kv[3], kv[4], kv[5], kv[6], kv[7]), qt[ks], a); }
                if (Jb == I) {
#pragma unroll
                    for (int r = 0; r < 4; ++r) { const int sl = 4 * kg + r; const bool keep = dir == 0 ? (sl <= tl) : (sl >= tl); if (!keep) a[r] = 0.f; }
                }
                att[Jb] = a;
            }
        }
        if (probe_mode == 4) { asm volatile("" :: "v"(acc[0]), "v"(acc[7]), "v"(att[0]), "v"(att[1]), "v"(att[2]), "v"(att[3])); __syncthreads(); continue; }
        { const int q4 = tl >> 2, p4 = tl & 3;
#pragma unroll
            for (int pr = 0; pr < 2; ++pr) {
                const bool any = dir == 0 ? (2 * pr <= I) : (2 * pr + 1 >= I);
                if (any) {
                    const f32x4 a0 = att[2 * pr], a1 = att[2 * pr + 1];
                    const bf16x8 ab = pack8(a0[0], a0[1], a0[2], a0[3], a1[0], a1[1], a1[2], a1[3]);
                    const int r0 = 32 * pr + 4 * kg + q4, r1 = r0 + 16;
#pragma unroll
                    for (int eb = 0; eb < 8; ++eb) {
                        const s16x4 lo = tr_read((LAS const char*)(VT + r0 * 256 + ((((eb >> 1) ^ (r0 & 3)) << 6) | ((eb & 1) << 5) | (p4 << 3))));
                        const s16x4 hh = tr_read((LAS const char*)(VT + r1 * 256 + ((((eb >> 1) ^ (r1 & 3)) << 6) | ((eb & 1) << 5) | (p4 << 3))));
                        acc[eb] = MFMA16(cat8(lo, hh), ab, acc[eb]); }
                }
            }
        }
        __syncthreads();
        if (dir == 1) {
#pragma unroll
            for (int eb = 0; eb < 8; ++eb) *(LAS f32x4*)(CB + ((I * 16 + tl) * 128 + 16 * eb + 4 * kg)) = acc[eb];
        }
        __syncthreads();
        if (dir == 0) {
            float ss = 0.f;
#pragma unroll
            for (int eb = 0; eb < 8; ++eb) { acc[eb] = acc[eb] + *(const LAS f32x4*)(CB + ((I * 16 + tl) * 128 + 16 * eb + 4 * kg)); ss += (acc[eb][0] * acc[eb][0] + acc[eb][1] * acc[eb][1]) + (acc[eb][2] * acc[eb][2] + acc[eb][3] * acc[eb][3]); }
            ss += __shfl_xor(ss, 16); ss += __shfl_xor(ss, 32);
            const float rs = rsqrtf(ss * (1.f / 128.f) + RMS_EPS);
#pragma unroll
            for (int eb = 0; eb < 8; ++eb) { const int e0 = 16 * eb + 4 * kg; const f32x4 wv = *(const GAS f32x4*)(hw + e0);
                const u32x2 gw = gwv[eb];
                u32x2 w; w.x = cvtpk(acc[eb][0] * rs * wv[0] * bflo(gw.x), acc[eb][1] * rs * wv[1] * bfhi(gw.x)); w.y = cvtpk(acc[eb][2] * rs * wv[2] * bflo(gw.y), acc[eb][3] * rs * wv[3] * bfhi(gw.y));
                *(GAS u32x2*)(OC + (size_t)(row0 + t) * 1536 + h * 128 + e0) = w; }
        }
        __syncthreads();
    }
}

#define R2_PROBE_NOROUTER 0
DI void ph_r2(LAS unsigned char* lds, const float* xin, const float* cin, float* XA, const float* XA2, bool do_route, const bf16* YO, unsigned char* H, const float* MODl, const float* ng, const float* wr, const float* br,
              unsigned* cnt, int* TOPE, float* GATE, int* RANK, int l, int nrows, int vcu, int G) {
    const int tid = tid_opaque(), lane = tid & 63, wave = __builtin_amdgcn_readfirstlane(tid >> 6);
    for (int i = tid; i < 1024 * 8; i += NTHR) { const int k = i >> 3, ch = i & 7, slot = ((k >> 8) * 4 + (k & 3)) * 64 + ((k >> 2) & 63);
        *(LAS f32x4*)(lds + slot * 128 + ((ch ^ (slot & 7)) << 4)) = *(const GAS f32x4*)(wr + k * 32 + ch * 4); }
    __syncthreads();
    for (int row = vcu * NWAVES + wave; row < nrows; row += G * NWAVES) {
        const int mj = row < NLAT ? row / SEQ : 2; const float* md = MODl + mj * 6144;
        const float* xp = (l == 0) ? (row < NLAT ? xin + (size_t)row * 1024 : cin + (size_t)(row - NLAT) * 1024) : XA2 + (size_t)row * 1024;
        f32x4 x[4], y[4]; row_ld(xp, lane, x); row_ld_bf(YO + (size_t)row * 1024, lane, y);
        const float ry = row_rstd(y);
#pragma unroll
        for (int j = 0; j < 4; ++j) { const f32x4 g1 = ((const GAS f32x4*)(ng + 1024))[lane + 64 * j], m2 = ((const GAS f32x4*)(md + 2048))[lane + 64 * j]; x[j] = x[j] + m2 * (y[j] * ry * g1); }
        row_st(XA + (size_t)row * 1024, lane, x);
        f32x4 h[4]; row_modulate(x, ng + 2048, md + 3 * 1024, md + 4 * 1024, lane, h);
        row_st_f8(H + (size_t)row * 1024, lane, h, F8_ACT);
        if (R2_PROBE_NOROUTER && !do_route) continue;
        float acc[32];
#pragma unroll
        for (int e = 0; e < 32; ++e) acc[e] = 0.f;
        f32x4 wA[8], wB[8];
#define R2_WLD(W, S) do { const int slot_ = (S) * 64 + lane; _Pragma("unroll") for (int ch = 0; ch < 8; ++ch) W[ch] = *(const LAS f32x4*)(lds + slot_ * 128 + ((ch ^ (slot_ & 7)) << 4)); } while (0)
#define R2_FMA(W, HV) do { const float hv_ = (HV); _Pragma("unroll") for (int ch = 0; ch < 8; ++ch) { acc[4 * ch] += hv_ * W[ch][0]; acc[4 * ch + 1] += hv_ * W[ch][1]; acc[4 * ch + 2] += hv_ * W[ch][2]; acc[4 * ch + 3] += hv_ * W[ch][3]; } } while (0)
        R2_WLD(wA, 0);
#pragma unroll
        for (int s2 = 0; s2 < 8; ++s2) {
            R2_WLD(wB, 2 * s2 + 1); R2_FMA(wA, h[(2 * s2) >> 2][(2 * s2) & 3]); __builtin_amdgcn_sched_barrier(0);
            if (s2 < 7) R2_WLD(wA, 2 * s2 + 2); R2_FMA(wB, h[(2 * s2 + 1) >> 2][(2 * s2 + 1) & 3]); __builtin_amdgcn_sched_barrier(0);
        }
#undef R2_WLD
#undef R2_FMA
#define R2_STEP(N, BIT) _Pragma("unroll") for (int i = 0; i < N; ++i) { const float lo = acc[i], hi = acc[i + N]; const bool up = (lane & BIT) != 0; const float keep = up ? hi : lo, send = up ? lo : hi; acc[i] = keep + __shfl_xor(send, BIT); }
        R2_STEP(16, 32) R2_STEP(8, 16) R2_STEP(4, 8) R2_STEP(2, 4) R2_STEP(1, 2)
#undef R2_STEP
        const int me = (lane >> 1) & 31;
        const float lg = acc[0] + __shfl_xor(acc[0], 1) + br[me];
        const unsigned lb_ = __float_as_uint(lg);
        unsigned key = ((lb_ ^ (unsigned)(((int)lb_ >> 31) | 0x80000000)) & ~31u) | (unsigned)(31 - me);
        float tv[4]; int te[4];
#pragma unroll
        for (int k = 0; k < 4; ++k) {
            unsigned r = key;
            r = max(r, (unsigned)__builtin_amdgcn_update_dpp(0, (int)r, 0xB1, 0xF, 0xF, true));
            r = max(r, (unsigned)__builtin_amdgcn_update_dpp(0, (int)r, 0x4E, 0xF, 0xF, true));
            r = max(r, (unsigned)__builtin_amdgcn_update_dpp(0, (int)r, 0x141, 0xF, 0xF, true));
            r = max(r, (unsigned)__builtin_amdgcn_update_dpp(0, (int)r, 0x140, 0xF, 0xF, true));
            const unsigned r0 = (unsigned)__builtin_amdgcn_readlane((int)r, 0), r1 = (unsigned)__builtin_amdgcn_readlane((int)r, 16), r2 = (unsigned)__builtin_amdgcn_readlane((int)r, 32), r3 = (unsigned)__builtin_amdgcn_readlane((int)r, 48);
            const unsigned km = max(max(r0, r1), max(r2, r3));
            const int idx = 31 - (int)(km & 31u);
            te[k] = idx; tv[k] = __uint_as_float((unsigned)__builtin_amdgcn_readlane((int)lb_, 2 * idx));
            if (me == idx) key = 0u;
        }
        const float e1 = __expf(tv[1] - tv[0]), e2 = __expf(tv[2] - tv[0]), e3 = __expf(tv[3] - tv[0]), inv = 1.f / (1.f + e1 + e2 + e3);
        if (do_route && lane < 4) { const int ek = lane == 0 ? te[0] : lane == 1 ? te[1] : lane == 2 ? te[2] : te[3]; const float gk = (lane == 0 ? 1.f : lane == 1 ? e1 : lane == 2 ? e2 : e3) * inv;
            const unsigned rk = atomicAdd(cnt + ek, 1u);
            TOPE[row * 4 + lane] = ek; GATE[row * 4 + lane] = gk; RANK[row * 4 + lane] = (int)rk; }
    }
}
DI void moe_tables(volatile LAS int* tb, const unsigned* cnt) {
    if (tid_opaque() == 0) { int t = 0;
        for (int e = 0; e < 32; ++e) { const int c = (int)__hip_atomic_load(cnt + e, __ATOMIC_RELAXED, __HIP_MEMORY_SCOPE_AGENT); tb[e] = t; tb[40 + e] = t * 256; t += (c + 255) >> 8; }
        tb[32] = t; }
    __syncthreads();
}
DI void ph_r3(volatile LAS int* tb, const unsigned char* H, unsigned char* XG, const int* TOPE, const int* RANK, int* DEST, int nrows, int vcu, int G) {
    const int lane = tid_opaque() & 63, wave = __builtin_amdgcn_readfirstlane(tid_opaque() >> 6);
    for (int row0 = (vcu * NWAVES + wave) * 4; row0 < nrows; row0 += G * NWAVES * 4) {
        v4u h0[4]; int ek[4], rk[4];
#pragma unroll
        for (int q = 0; q < 4; ++q) { h0[q] = ((const GAS v4u*)(H + (size_t)(row0 + q) * 1024))[lane]; ek[q] = TOPE[(row0 + q) * 4 + (lane & 3)]; rk[q] = RANK[(row0 + q) * 4 + (lane & 3)]; }
#pragma unroll
        for (int q = 0; q < 4; ++q) { const int dl = tb[40 + ek[q]] + rk[q];
            if (lane < 4) DEST[(row0 + q) * 4 + lane] = dl;
#pragma unroll
            for (int k = 0; k < 4; ++k) { const int d = __builtin_amdgcn_readlane(dl, k); ((GAS v4u*)(XG + (size_t)d * 1024))[lane] = h0[q]; } }
    }
}
DI void ph_r4(const float* XA, float* XA2, const bf16* YS, const int* DEST, const float* GATE, const float* MODl, const float* ng, float* out, unsigned char* H, bf16* HBn, const float* MODn, const float* ngn, bool last, int nrows, int vcu, int G) {
    const int lane = tid_opaque() & 63, wave = __builtin_amdgcn_readfirstlane(tid_opaque() >> 6);
    for (int row0 = (vcu * NWAVES + wave) * 2; row0 < nrows; row0 += G * NWAVES * 2) {
        f32x4 f[2][4], x[2][4]; float gk[2][4]; int dk[2][4];
#pragma unroll
        for (int q = 0; q < 2; ++q) { const int row = row0 + q;
#pragma unroll
            for (int k = 0; k < 4; ++k) { dk[q][k] = DEST[row * 4 + k]; gk[q][k] = GATE[row * 4 + k]; }
            row_ld(XA + (size_t)row * 1024, lane, x[q]); }
#pragma unroll
        for (int q = 0; q < 2; ++q) {
#pragma unroll
            for (int j = 0; j < 4; ++j) f[q][j] = (f32x4){0.f, 0.f, 0.f, 0.f};
#pragma unroll
            for (int k = 0; k < 4; ++k) { f32x4 y[4]; row_ld_bf(YS + (size_t)dk[q][k] * 1024, lane, y);
#pragma unroll
                for (int j = 0; j < 4; ++j) f[q][j] = f[q][j] + y[j] * gk[q][k]; } }
#pragma unroll
        for (int q = 0; q < 2; ++q) { const int row = row0 + q;
            const int mj = row < NLAT ? row / SEQ : 2; const float* md = MODl + mj * 6144;
            const float rf = row_rstd(f[q]);
#pragma unroll
            for (int j = 0; j < 4; ++j) { const f32x4 g3 = ((const GAS f32x4*)(ng + 3 * 1024))[lane + 64 * j], m5 = ((const GAS f32x4*)(md + 5 * 1024))[lane + 64 * j]; x[q][j] = x[q][j] + m5 * (f[q][j] * rf * g3); }
            if (last) row_st(out + (size_t)row * 1024, lane, x[q]);
            else { row_st(XA2 + (size_t)row * 1024, lane, x[q]);
                f32x4 h[4]; row_modulate(x[q], ngn, MODn + mj * 6144, MODn + mj * 6144 + 1024, lane, h); if (INP_FP8 || INP_L1_FP8) row_st_f8(H + (size_t)row * 1024, lane, h, F8_ACT); if (!INP_FP8) row_st_bf(HBn + (size_t)row * 1024, lane, h); } }
    }
}

#define PROF_MASK 0
#define AB_PROBE -1
#define GEMM_PROBE 0
#define HG3_PROBE 0
#define TS_SEL -1
#define TSB(id) do { if (TS_SEL == (id) && bx == 0 && tid_opaque() == 0) tsum -= (long long)rt(); } while (0)
#define TSE(id) do { if (TS_SEL == (id) && bx == 0 && tid_opaque() == 0) tsum += (long long)rt(); } while (0)
#define REP(bit) for (int rep_ = 0; rep_ < (((PROF_MASK) >> (bit)) & 1 ? 2 : 1); ++rep_)
#ifndef PHM
#define PHM 0x7fff
#endif
struct Args { const float* in[21]; float* out; unsigned char* ws; };
__global__ void __launch_bounds__(NTHR, 2) fwd_mega(Args a) {
    extern __shared__ __attribute__((aligned(16))) unsigned char lds_raw[];
    LAS unsigned char* lds = (LAS unsigned char*)lds_raw;
    volatile LAS unsigned* MISC = (volatile LAS unsigned*)(lds + MISC_OFF);
    volatile LAS int* MTB = (volatile LAS int*)(lds + MISC_OFF + 256);
    const int G = gridDim.x, bx = blockIdx.x, vcu = (G % 8 == 0) ? (bx % 8) * (G / 8) + bx / 8 : bx;
#define AS4 __attribute__((address_space(4)))
#define KARGS() ({ const AS4 char* kp_ = (const AS4 char*)__builtin_amdgcn_kernarg_segment_ptr(); asm volatile("" : "+s"(kp_)); kp_; })
#define IN(i) (*(const float* const AS4*)(KARGS() + 8 * (i)))
#define WSB() (*(unsigned char* const AS4*)(KARGS() + 176))
#define OUTP() (*(float* const AS4*)(KARGS() + 168))
#define ctl ((gu32*)(WSB() + WS_CTL))
#define SM ((float*)(WSB() + WS_SMALL))
#define WIN ((bf16*)(WSB() + WS_WIN))
#define WIN8 ((bf16*)(WSB() + WS_WIN8))
#define WINB ((bf16*)(WSB() + WS_WIN + 16 * MiB))
#define WBR ((bf16*)(WSB() + WS_WBR))
#define WO ((bf16*)(WSB() + WS_WO))
#define WGU ((bf16*)(WSB() + WS_WGU))
#define WDN ((bf16*)(WSB() + WS_WDN))
#define XA ((float*)(WSB() + WS_XA))
#define XA2 ((float*)(WSB() + WS_XA2))
#define H ((unsigned char*)(WSB() + WS_YF))
#define HB ((bf16*)(WSB() + WS_H))
#define P ((bf16*)(WSB() + WS_P))
#define LF ((float*)(WSB() + WS_LF))
#define O3 ((bf16*)(WSB() + WS_O3))
#define HU ((bf16*)(WSB() + WS_HU))
#define HD ((float*)(WSB() + WS_HD))
#define HS ((bf16*)(WSB() + WS_HS))
#define Y ((bf16*)(WSB() + WS_Y))
#define YO ((bf16*)(WSB() + WS_YO))
#define TOPE ((int*)(WSB() + WS_ROUTE))
#define GATE ((float*)(WSB() + WS_ROUTE + 524288 * 1))
#define RANK ((int*)(WSB() + WS_ROUTE + 524288 * 2))
#define DEST ((int*)(WSB() + WS_ROUTE + 524288 * 3))
#define XG ((unsigned char*)(WSB() + WS_XG))
#define ACT ((unsigned char*)(WSB() + WS_ACT))
#define YS ((bf16*)(WSB() + WS_YS))
#define x_in IN(0)
#define c_in IN(1)
#define ctx_in IN(2)
#define cctx_in IN(3)

    for (int u = tid_opaque(); u < (LDS_BYTES - LDSCTL_OFF) / 4; u += NTHR) ((LAS unsigned*)(lds + LDSCTL_OFF))[u] = 0u;
    __syncthreads();
    XcdBarrier bar = xcd_barrier_post((unsigned*)(ctl + CW_BAR), MISC + 8);
long long tsum = 0;
#define GRID_BAR() do { TSB(30); xcd_barrier(bar); TSE(30); } while (0)

    REP(0) if (PHM & 1) ph_mod(lds, c_in, cctx_in, IN(4), IN(5), SM + SM_MOD, vcu, G);
    if (PHM & 1) ph_tables(SM, IN(11), IN(9), vcu, G);
    GRID_BAR();
    REP(1) if (PHM & 2) {
        const int lane = tid_opaque() & 63, wave = __builtin_amdgcn_readfirstlane(tid_opaque() >> 6);
        LAS float* scr = (LAS float*)(lds + wave * 16384);
        const int gw = vcu * NWAVES + wave, NGW = G * NWAVES;
        const TGroup g0{IN(7), WIN, 1024, INW, 2, 0, 1, INP_FP8, 0}, g1{IN(13), WBR, 512, 1024, 6, 0, 3, 0, 0}, g2{IN(14), WO, 1024, 1024, 2, 0, 1, 0, 0}, g3{IN(17), WGU, 1024, 2048, 64, 1, 1, 1, 0}, g4{IN(19), WDN, 1024, 1024, 64, 0, 1, 1, 0}, g5{IN(7), WIN8, 1024, INW, 2, 0, 1, 1, 0};
        const int total = 2 * 16 * 248 + 6 * 8 * 32 + 2 * 16 * 32 + 64 * 16 * 64 + 64 * 16 * 32 + (INP_L1_FP8 ? 2 * 16 * 248 : 0);
        for (int it = gw; it < total; it += NGW) { int r = it;
            if (p0_group(g0, r, scr, lane)) continue; if (p0_group(g1, r, scr, lane)) continue; if (p0_group(g2, r, scr, lane)) continue; if (p0_group(g3, r, scr, lane)) continue; if (p0_group(g4, r, scr, lane)) continue; p0_group(g5, r, scr, lane); }
        const float* ng = IN(6);
        for (int row = gw; row < NTOK; row += NGW) { const int mj = row < NLAT ? row / SEQ : 2; const float* md = SM + SM_MOD + mj * 6144;
            const float* xp = row < NLAT ? x_in + (size_t)row * 1024 : ctx_in + (size_t)(row - NLAT) * 1024;
            f32x4 x[4], h[4]; row_ld(xp, lane, x); row_modulate(x, ng, md, md + 1024, lane, h); if (INP_FP8) row_st_f8(H + (size_t)row * 1024, lane, h, F8_ACT); else row_st_bf(HB + (size_t)row * 1024, lane, h); }
    }
    GRID_BAR();

    for (int l = 0; l < DEPTH; ++l) {
        const bool last = (l == DEPTH - 1);
        const float* MODl = SM + SM_MOD + l * 3 * 6144;
        const float* ng = IN(6) + l * 4096;
        const int nrows = last ? NLAT : NTOK;
#if INP_L1_FP8
        if (l == 1) { pg8::Gemm g{(const bf16*)H, (const bf16*)((const unsigned char*)WIN8 + (size_t)l * INW * 1024), NTOK, INW, 1024}; pg8::StaticOrder S; S.init(NTOK, INW, G, bx);
          EpiIn E{P, LF, SM + SM_TAB, SM + SM_LB + l * 1024, 0, 1.f / (F8_ACT * F8_W)}; pg8::gemm_phase<EpiIn, pg8::StaticOrder, true, true, 1>(lds, g, S, E); } else
#endif
        REP(2) if (PHM & 4) {
          pg8::Gemm g{INP_FP8 ? (const bf16*)H : (const bf16*)HB, INP_FP8 ? (const bf16*)((const unsigned char*)WIN + (size_t)l * INW * 1024) : (const bf16*)(WIN + (size_t)l * INW * 1024), NTOK, INW, 1024};
          pg8::StaticOrder S; S.init(NTOK, INW, G, bx);
          EpiIn E{P, LF, SM + SM_TAB, SM + SM_LB + l * 1024, 0, INP_FP8 ? 1.f / (F8_ACT * F8_W) : 1.f};
          pg8::gemm_phase<EpiIn, pg8::StaticOrder, true, true, INP_FP8 ? 1 : 2>(lds, g, S, E); }
#if GEMM_PROBE == 7 || GEMM_PROBE == 8 || GEMM_PROBE == 9
        { pg8::Gemm g{(const bf16*)HB, (const bf16*)(WIN + (size_t)l * INW * 1024), NTOK, INW, 1024}; pg8::StaticOrder S; S.init(NTOK, INW, G, bx);
          EpiInT<GEMM_PROBE - 7> E{(bf16*)(WSB() + WS_HU), (float*)(WSB() + WS_HU + 256 * MiB), SM + SM_TAB, SM + SM_LB + l * 1024, 0, 1.f};
          pg8::gemm_phase<EpiInT<GEMM_PROBE - 7>, pg8::StaticOrder, true, true, 2>(lds, g, S, E); }
#endif
#if GEMM_PROBE == 1
        { pg8::Gemm g{(const bf16*)HB, (const bf16*)(WIN + (size_t)l * INW * 1024), NTOK, INW, 1024}; pg8::StaticOrder S; S.init(NTOK, INW, G, bx); EpiNull E{(float*)(WSB() + WS_YF)};
          pg8::gemm_phase<EpiNull, pg8::StaticOrder, true, true, 2>(lds, g, S, E); }
#endif
        GRID_BAR();
        REP(3) if (PHM & 8) ph_hg1(lds, P, LF, HU, HD, vcu, G);
        REP(4) if (PHM & 16) ph_attn_a(lds, P, O3, IN(8) + l * 8, !last, vcu, G);
        REP(5) if (PHM & 32) ph_attn_b<0>(lds, P, O3 + 512, IN(10) + l * 128, SM[SM_LAM + l], SM[SM_LAM + 2 + l], !last, vcu, G);
#if AB_PROBE >= 0
        ph_attn_b<AB_PROBE>(lds, P, (bf16*)(WSB() + WS_YF), IN(10) + l * 128, SM[SM_LAM + l], SM[SM_LAM + 2 + l], !last, vcu, G);
#endif
        GRID_BAR();
        REP(6) if (PHM & 64) ph_hg2(HU, HD, HS, vcu, G);
        GRID_BAR();
        REP(7) if (PHM & 128) ph_hg3(lds, P, LF, HS, O3 + 1024, IN(12) + l * 128, !last, vcu, G, (HG3_PROBE && rep_ == 0) ? HG3_PROBE : 0);
        GRID_BAR();
        REP(8) if (PHM & 256) { pg8::Gemm g{O3, WBR + (size_t)l * 3 * 1024 * 512, nrows, 1024, 1536}; pg8::StaticOrder S; S.init(nrows, 1024, G, bx);
          EpiMerge E{P, Y};
          pg8::gemm_phase<EpiMerge, pg8::StaticOrder, true, true>(lds, g, S, E); }
        GRID_BAR();
#if GEMM_PROBE == 10
        { pg8::Gemm g{O3, WBR + (size_t)l * 3 * 1024 * 512, nrows, 1024, 1536}; pg8::StaticOrder S; S.init(nrows, 1024, G, bx); EpiNull E{(float*)(WSB() + WS_YF)};
          pg8::gemm_phase<EpiNull, pg8::StaticOrder, true, true, 2>(lds, g, S, E); }
#endif
        REP(9) if (PHM & 512) { pg8::Gemm g{Y, WO + (size_t)l * 1024 * 1024, nrows, 1024, 1024}; pg8::StaticOrder S; S.init(nrows, 1024, G, bx);
          EpiPlain E{YO, 1024, nullptr, 4, 1.f};
          pg8::gemm_phase<EpiPlain, pg8::StaticOrder, true, true>(lds, g, S, E); }
        GRID_BAR();
        unsigned* cnt = (unsigned*)(ctl + CW_CNT) + l * 32;
        TSB(20); REP(10) if (PHM & 1024) ph_r2(lds, x_in, ctx_in, XA, XA2, rep_ == ((PROF_MASK >> 10) & 1), YO, H, MODl, ng, IN(15) + l * 32768, IN(16) + l * 32, cnt, TOPE, GATE, RANK, l, nrows, vcu, G);
        GRID_BAR(); TSE(20);
        moe_tables(MTB, cnt);
        REP(11) if (PHM & 2048) ph_r3(MTB, H, XG, TOPE, RANK, DEST, nrows, vcu, G);
        GRID_BAR();
        REP(12) if (PHM & 4096) { pg8::Gemm g{(const bf16*)XG, (const bf16*)((const unsigned char*)WGU + (size_t)l * 32 * 2048 * 1024), XG_ROWS, 32 * 2048, 1024}; MoeOrder S{MTB, 8, G, vcu};
          EpiSwiglu E{ACT, IN(18) + (size_t)l * 32 * 2048};
          pg8::gemm_phase<EpiSwiglu, MoeOrder, true, true, 1>(lds, g, S, E); }
#if GEMM_PROBE == 3
        { pg8::Gemm g{(const bf16*)XG, (const bf16*)((const unsigned char*)WGU + (size_t)l * 32 * 2048 * 1024), XG_ROWS, 32 * 2048, 1024}; MoeOrder S{MTB, 8, G, vcu}; EpiNull E{(float*)(WSB() + WS_YO)};
          pg8::gemm_phase<EpiNull, MoeOrder, true, true, 1>(lds, g, S, E); }
#endif
#if GEMM_PROBE == 4 || GEMM_PROBE == 5 || GEMM_PROBE == 6
        { pg8::Gemm g{(const bf16*)XG, (const bf16*)((const unsigned char*)WGU + (size_t)l * 32 * 2048 * 1024), XG_ROWS, 32 * 2048, 1024}; MoeOrder S{MTB, 8, G, vcu};
          EpiSwigluT<GEMM_PROBE - 4> E{(unsigned char*)(WSB() + WS_YS), IN(18) + (size_t)l * 32 * 2048};
          pg8::gemm_phase<EpiSwigluT<GEMM_PROBE - 4>, MoeOrder, true, true, 1>(lds, g, S, E); }
#endif
        GRID_BAR();
        REP(13) if (PHM & 8192) { pg8::Gemm g{(const bf16*)ACT, (const bf16*)((const unsigned char*)WDN + (size_t)l * 32 * 1024 * 1024), XG_ROWS, 32 * 1024, 1024}; MoeOrder S{MTB, 4, G, vcu};
          EpiPlain E{YS, 1024, IN(20) + (size_t)l * 32 * 1024, 4, 1.f / (F8_MID * F8_W)};
          pg8::gemm_phase<EpiPlain, MoeOrder, true, true, 1>(lds, g, S, E); }
        GRID_BAR();
#if GEMM_PROBE == 11
        { pg8::Gemm g{(const bf16*)ACT, (const bf16*)((const unsigned char*)WDN + (size_t)l * 32 * 1024 * 1024), XG_ROWS, 32 * 1024, 1024}; MoeOrder S{MTB, 4, G, vcu}; EpiNull E{(float*)(WSB() + WS_YO)};
          pg8::gemm_phase<EpiNull, MoeOrder, true, true, 1>(lds, g, S, E); }
#endif
        TSB(21); REP(14) if (PHM & 16384) ph_r4(XA, XA2, YS, DEST, GATE, MODl, ng, OUTP(), H, HB, SM + SM_MOD + (l + 1 < DEPTH ? (l + 1) * 3 * 6144 : 0), IN(6) + (l + 1 < DEPTH ? (l + 1) * 4096 : 0), last, nrows, vcu, G);
        if (!last) GRID_BAR();
        TSE(21);
        REP(15) for (int k_ = 0; k_ < (rep_ ? 10 : 0); ++k_) xcd_barrier(bar);
    }
    if (TS_SEL >= 0) {
        if (bx == 0 && tid_opaque() == 0) SM[SM_LAM + 8] = (float)tsum * 0.01f;
        xcd_barrier(bar);
        const float sc = 1.f + sqrtf(SM[SM_LAM + 8] * 1e-4f);
        for (int i = bx * NTHR + tid_opaque(); i < NLAT * DM; i += G * NTHR) OUTP()[i] *= sc;
    }
    if (__hip_atomic_load((gu32*)((unsigned*)(ctl + CW_BAR) + XB_TMO), RLX_AGENT) != 0u) { if (bx == 0) for (int i = tid_opaque(); i < 4096; i += NTHR) OUTP()[i] = __builtin_nanf(""); }
}

#undef ctl
#undef SM
#undef WIN
#undef WIN8
#undef WINB
#undef WBR
#undef WO
#undef WGU
#undef WDN
#undef XA
#undef XA2
#undef H
#undef HB
#undef P
#undef LF
#undef O3
#undef HU
#undef HD
#undef HS
#undef Y
#undef YO
#undef TOPE
#undef GATE
#undef RANK
#undef DEST
#undef XG
#undef ACT
#undef YS
#undef x_in
#undef c_in
#undef ctx_in
#undef cctx_in
extern "C" void kernel_launch(void* const* d_in, const int* in_sizes, int n_in, void* d_out, int out_size, void* d_ws, size_t ws_size, hipStream_t stream) {
    static int grid = 0;
    if (grid == 0) {
        if (n_in != 21 || out_size != NLAT * DM || ws_size < WS_END) { fprintf(stderr, "kernel_launch: unexpected shapes (n_in %d, out %d, ws %zu)\n", n_in, out_size, ws_size); grid = -1; return; }
        int dev = 0, cus = 0, per_cu = 0;
        if (hipGetDevice(&dev) != hipSuccess || hipDeviceGetAttribute(&cus, hipDeviceAttributeMultiprocessorCount, dev) != hipSuccess) { grid = -1; return; }
        if (hipFuncSetAttribute((const void*)fwd_mega, hipFuncAttributeMaxDynamicSharedMemorySize, LDS_BYTES) != hipSuccess) { fprintf(stderr, "kernel_launch: hipFuncSetAttribute failed\n"); grid = -1; return; }
        if (hipOccupancyMaxActiveBlocksPerMultiprocessor(&per_cu, (const void*)fwd_mega, NTHR, LDS_BYTES) != hipSuccess || per_cu < 1) { fprintf(stderr, "kernel_launch: occupancy query reports %d\n", per_cu); per_cu = 1; }
        (void)hipGetLastError();
        grid = cus;
    }
    if (grid < 0) return;
    (void)hipMemsetAsync((char*)d_ws + WS_CTL, 0, CTL_ZERO_BYTES, stream);
    Args a{};
    for (int i = 0; i < 21; ++i) a.in[i] = (const float*)d_in[i];
    a.out = (float*)d_out; a.ws = (unsigned char*)d_ws;
    hipLaunchKernelGGL(fwd_mega, dim3(grid), dim3(NTHR), LDS_BYTES, stream, a);
}
```

```cpp
#include <hip/hip_runtime.h>
#include <cstdio>
#include <cstdint>
namespace pg8 {
#define PG8_LAS __attribute__((address_space(3)))
typedef unsigned short bf16_t;
typedef short bf16x8 __attribute__((ext_vector_type(8)));
typedef float f32x4 __attribute__((ext_vector_type(4)));
typedef unsigned u32x4 __attribute__((ext_vector_type(4)));
constexpr int BM = 256, BK = 64, HALF = 128, HTB = HALF * BK * 2  , STAGE_BYTES = 8 * HTB, NXCD = 8, WGM = 8;

__host__ __device__ __forceinline__ int lds_byte(int r, int c) { const int st = (r >> 4) * 2 + (c >> 5), rr = r & 15, cc = c & 31, ob = rr * 64 + cc * 2; return st * 1024 + (ob ^ (((ob >> 9) & 1) << 5)); }
__host__ __device__ __forceinline__ void stage_rc(int b, int& R, int& C) { const int st = b / 1024, sb = b % 1024, swz = sb ^ (((sb >> 9) & 1) << 5); R = (st >> 1) * 16 + swz / 64; C = (st & 1) * 32 + (swz % 64) / 2; }
__host__ __device__ __forceinline__ int perm32(int rho) { const int n = rho >> 4, i = rho & 15; return 8 * (i >> 2) + 4 * n + (i & 3); }

struct Unit { int pm, pn; };
struct Gemm { const bf16_t* A; const bf16_t* Bt; int M, N, K; };

struct StaticOrder {
    int nM, nN, nwg, G, c;
    __host__ __device__ void init(int M, int N, int G_, int c_) { nM = M / BM; nN = N / BM; nwg = nM * nN; G = G_; c = c_; }
    __host__ __device__ bool next(int i, Unit& u) const {
        const long L = (long)i * G + c; if (L >= nwg) return false;
        int wgid = (int)L; { const int q = nwg / NXCD, r = nwg % NXCD, xcd = wgid % NXCD, off = wgid / NXCD; wgid = (xcd < r ? xcd * (q + 1) : r * (q + 1) + (xcd - r) * q) + off; }
        const int nig = WGM * nN, gid = wgid / nig, fm = gid * WGM, gsz = (nM - fm) < WGM ? (nM - fm) : WGM;
        u.pm = fm + ((wgid % nig) % gsz); u.pn = (wgid % nig) / gsz; return true;
    }
    __device__ __forceinline__ void a_ready(const Unit&) const {}
    __device__ __forceinline__ void done(const Unit&) const {}
};

template <class Epi, class Sched, bool ALIGN_EPI = false, bool SP2 = false, int ES = 2>
__device__ __forceinline__ void gemm_phase(PG8_LAS unsigned char* lds, const Gemm g, const Sched& S, const Epi& E) {
    int tid_ = threadIdx.x; asm volatile("" : "+v"(tid_));
    const int tid = tid_, wid = __builtin_amdgcn_readfirstlane(tid >> 6), lane = tid & 63, wr = wid >> 2, wc = wid & 3, fr = lane & 15, fq = lane >> 4;
    const int K = g.K, nt = K * ES / 128;
    unsigned voffA[2], voffB[2];
#pragma unroll
    for (int i = 0; i < 2; ++i) { int R, C; stage_rc(tid * 16 + i * 8192, R, C); const int Rb = Epi::PERM ? ((R & ~31) + perm32(R & 31)) : R;
        voffA[i] = (unsigned)(R * K * ES + C * 2); voffB[i] = (unsigned)(Rb * K * ES + C * 2); }
    const size_t kstep = (size_t)(BK * 2);
    const size_t hstep = (size_t)HALF * K * ES;
    const size_t tstep = 2 * hstep;
    const unsigned ldsw = (unsigned)wid * 1024u;
    const int aoff = lds_byte(wr * 64 + fr, fq * 8), boff = lds_byte(wc * 32 + fr, fq * 8);
#define PG8_SA(b, h) (((b) * 2 + (h)) * HTB)
#define PG8_SB(b, h) ((4 + (b) * 2 + (h)) * HTB)
#define PG8_STAGE(bufoff, gbase, voff) do { _Pragma("unroll") for (int _i = 0; _i < 2; ++_i) \
        __builtin_amdgcn_global_load_lds((const unsigned*)((const char*)(gbase) + (voff)[_i]), (PG8_LAS unsigned*)(lds + (bufoff) + ldsw + _i * 8192), 16, 0, 0); } while (0)
#define PG8_LDA(dst, b, h) do { _Pragma("unroll") for (int m = 0; m < 4; ++m) _Pragma("unroll") for (int k = 0; k < 2; ++k) dst[m][k] = *(const PG8_LAS bf16x8*)(lds + PG8_SA(b, h) + aoff + m * 2048 + k * 1024); } while (0)
#define PG8_LDB(dst, b, h) do { _Pragma("unroll") for (int n = 0; n < 2; ++n) _Pragma("unroll") for (int k = 0; k < 2; ++k) dst[n][k] = *(const PG8_LAS bf16x8*)(lds + PG8_SB(b, h) + boff + n * 2048 + k * 1024); } while (0)
#define PG8_MMA(ai, bj, At, Bt) do { __builtin_amdgcn_s_setprio(1); _Pragma("unroll") for (int m = 0; m < 4; ++m) _Pragma("unroll") for (int n = 0; n < 2; ++n) _Pragma("unroll") for (int k = 0; k < 2; ++k) \
        acc[ai][bj][m][n] = __builtin_amdgcn_mfma_f32_16x16x32_bf16(Bt[n][k], At[m][k], acc[ai][bj][m][n], 0, 0, 0); __builtin_amdgcn_s_setprio(0); } while (0)
    typedef int v8i_t __attribute__((ext_vector_type(8)));
#define PG8_CAT8(x0, x1) __builtin_shufflevector(__builtin_bit_cast(u32x4, (x0)), __builtin_bit_cast(u32x4, (x1)), 0, 1, 2, 3, 4, 5, 6, 7)
#define PG8_MMA8(ai, bj, At, Bt) do { __builtin_amdgcn_s_setprio(1); _Pragma("unroll") for (int m = 0; m < 4; ++m) _Pragma("unroll") for (int n = 0; n < 2; ++n) { \
        const v8i_t a8_ = __builtin_bit_cast(v8i_t, PG8_CAT8(Bt[n][0], Bt[n][1])), b8_ = __builtin_bit_cast(v8i_t, PG8_CAT8(At[m][0], At[m][1])); \
        asm volatile("v_mfma_scale_f32_16x16x128_f8f6f4 %0, %1, %2, %0, %3, %3 op_sel_hi:[0,0,0]" : "+v"(acc[ai][bj][m][n]) : "v"(a8_), "v"(b8_), "v"(0x7f7f7f7f)); } \
        __builtin_amdgcn_s_setprio(0); } while (0)
#define PG8_MMAX(ai, bj, At, Bt) do { if constexpr (ES == 1) PG8_MMA8(ai, bj, At, Bt); else PG8_MMA(ai, bj, At, Bt); } while (0)
#define PG8_WAIT_V(n) asm volatile("s_waitcnt vmcnt(" #n ")" ::: "memory")
#define PG8_WAIT_L(n) asm volatile("s_waitcnt lgkmcnt(" #n ")" ::: "memory")
#define PG8_BAR __builtin_amdgcn_s_barrier()
#define PG8_SCHED __builtin_amdgcn_sched_barrier(0)
    Unit cur, nxt; int ui = 0;
    if (!S.next(0, cur)) return;
    f32x4 acc[2][2][4][2];
#pragma unroll
    for (int a = 0; a < 2; ++a)
#pragma unroll
        for (int b = 0; b < 2; ++b)
#pragma unroll
            for (int m = 0; m < 4; ++m)
#pragma unroll
                for (int n = 0; n < 2; ++n) acc[a][b][m][n] = (f32x4){0.f, 0.f, 0.f, 0.f};
    bf16x8 At[4][2], B0[2][2], B1[2][2];
    const char* cA = (const char*)g.A + (size_t)cur.pm * tstep; const char* cB = (const char*)g.Bt + (size_t)cur.pn * tstep;
    S.a_ready(cur);
    if constexpr (SP2) {
        PG8_STAGE(PG8_SB(0, 0), cB, voffB); PG8_STAGE(PG8_SB(0, 1), cB + hstep, voffB); PG8_STAGE(PG8_SA(0, 0), cA, voffA); PG8_STAGE(PG8_SA(0, 1), cA + hstep, voffA);
        if (wr == 1) PG8_BAR;
        PG8_WAIT_V(2); PG8_BAR;
        PG8_STAGE(PG8_SB(1, 0), cB + kstep, voffB); PG8_STAGE(PG8_SA(1, 0), cA + kstep, voffA); PG8_STAGE(PG8_SB(1, 1), cB + hstep + kstep, voffB);
        PG8_WAIT_V(6); PG8_BAR;
    } else {
        PG8_STAGE(PG8_SB(0, 0), cB, voffB); PG8_STAGE(PG8_SA(0, 0), cA, voffA); PG8_STAGE(PG8_SB(0, 1), cB + hstep, voffB); PG8_STAGE(PG8_SA(0, 1), cA + hstep, voffA);
        if (wr == 1) PG8_BAR;
        PG8_WAIT_V(4); PG8_BAR;
        PG8_STAGE(PG8_SB(1, 0), cB + kstep, voffB); PG8_STAGE(PG8_SA(1, 0), cA + kstep, voffA); PG8_STAGE(PG8_SB(1, 1), cB + hstep + kstep, voffB);
        PG8_WAIT_V(6); PG8_BAR;
    }
    for (;;) {
        const bool has_next = S.next(ui + 1, nxt);
        const char* nA = has_next ? (const char*)g.A + (size_t)nxt.pm * tstep : cA; const char* nB = has_next ? (const char*)g.Bt + (size_t)nxt.pn * tstep : cB;
        for (int t = 0; t < nt; t += 2) {
            if constexpr (Epi::KHOOK) { if (t == 8 || t == 16) E.khook(acc, cur, t >> 3, wr, wc, fr, fq); }
            const bool last = (t == nt - 2);
            const char* a1 = cA + (size_t)(t + 1) * kstep;
            const char* a2 = last ? nA : cA + (size_t)(t + 2) * kstep; const char* b2 = last ? nB : cB + (size_t)(t + 2) * kstep;
            const char* a3 = a2 + kstep; const char* b3 = b2 + kstep;
            if (last && has_next) S.a_ready(nxt);
            if constexpr (SP2) {
            PG8_LDB(B0, 0, 0); PG8_LDB(B1, 0, 1); PG8_SCHED; PG8_LDA(At, 0, 0); PG8_STAGE(PG8_SA(1, 1), a1 + hstep, voffA);
            PG8_WAIT_V(8); PG8_WAIT_L(0); PG8_BAR; PG8_MMAX(0, 0, At, B0); PG8_MMAX(0, 1, At, B1); PG8_BAR; PG8_SCHED;
            PG8_LDA(At, 0, 1); PG8_STAGE(PG8_SB(0, 0), b2, voffB); PG8_STAGE(PG8_SB(0, 1), b2 + hstep, voffB); PG8_STAGE(PG8_SA(0, 0), a2, voffA);
            PG8_WAIT_V(8); PG8_WAIT_L(0); PG8_BAR; PG8_MMAX(1, 0, At, B0); PG8_MMAX(1, 1, At, B1); PG8_BAR; PG8_SCHED;
            PG8_LDB(B0, 1, 0); PG8_LDB(B1, 1, 1); PG8_SCHED; PG8_LDA(At, 1, 0); PG8_STAGE(PG8_SA(0, 1), a2 + hstep, voffA);
            PG8_WAIT_V(8); PG8_WAIT_L(0); PG8_BAR; PG8_MMAX(0, 0, At, B0); PG8_MMAX(0, 1, At, B1); PG8_BAR; PG8_SCHED;
            PG8_LDA(At, 1, 1); PG8_STAGE(PG8_SB(1, 0), b3, voffB); PG8_STAGE(PG8_SB(1, 1), b3 + hstep, voffB); PG8_STAGE(PG8_SA(1, 0), a3, voffA);
            PG8_WAIT_V(8); PG8_WAIT_L(0); PG8_BAR; PG8_MMAX(1, 0, At, B0); PG8_MMAX(1, 1, At, B1); PG8_BAR; PG8_SCHED;
            } else {
            PG8_LDB(B0, 0, 0); PG8_SCHED; PG8_LDA(At, 0, 0); PG8_STAGE(PG8_SA(1, 1), a1 + hstep, voffA);
            PG8_WAIT_L(8); PG8_BAR; PG8_WAIT_L(0); PG8_MMAX(0, 0, At, B0); PG8_BAR; PG8_SCHED;
            PG8_LDB(B1, 0, 1); PG8_STAGE(PG8_SB(0, 0), b2, voffB);
            PG8_BAR; PG8_WAIT_L(0); PG8_MMAX(0, 1, At, B1); PG8_BAR;
            PG8_LDA(At, 0, 1); PG8_STAGE(PG8_SA(0, 0), a2, voffA);
            PG8_BAR; PG8_WAIT_L(0); PG8_MMAX(1, 0, At, B0); PG8_BAR; PG8_SCHED;
            PG8_STAGE(PG8_SB(0, 1), b2 + hstep, voffB);
            PG8_WAIT_V(6); PG8_BAR; PG8_MMAX(1, 1, At, B1); PG8_BAR;
            PG8_LDB(B0, 1, 0); PG8_SCHED; PG8_LDA(At, 1, 0); PG8_STAGE(PG8_SA(0, 1), a2 + hstep, voffA);
            PG8_WAIT_L(8); PG8_BAR; PG8_WAIT_L(0); PG8_MMAX(0, 0, At, B0); PG8_BAR; PG8_SCHED;
            PG8_LDB(B1, 1, 1); PG8_STAGE(PG8_SB(1, 0), b3, voffB);
            PG8_BAR; PG8_WAIT_L(0); PG8_MMAX(0, 1, At, B1); PG8_BAR;
            PG8_LDA(At, 1, 1); PG8_STAGE(PG8_SA(1, 0), a3, voffA);
            PG8_BAR; PG8_WAIT_L(0); PG8_MMAX(1, 0, At, B0); PG8_BAR; PG8_SCHED;
            PG8_STAGE(PG8_SB(1, 1), b3 + hstep, voffB);
            PG8_WAIT_V(6); PG8_BAR; PG8_MMAX(1, 1, At, B1); PG8_BAR;
            }
        }
        if constexpr (ES == 1) asm volatile("s_nop 15\n\ts_nop 7" ::: "memory");
        if constexpr (ALIGN_EPI) { if (wr == 0) PG8_BAR; }
        if constexpr (!Epi::AFTER_DRAIN) { E(acc, cur, wr, wc, fr, fq); S.done(cur); }
        if (!has_next) break;
#pragma unroll
        for (int a = 0; a < 2; ++a)
#pragma unroll
            for (int b = 0; b < 2; ++b)
#pragma unroll
                for (int m = 0; m < 4; ++m)
#pragma unroll
                    for (int n = 0; n < 2; ++n) acc[a][b][m][n] = (f32x4){0.f, 0.f, 0.f, 0.f};
        cur = nxt; cA = nA; cB = nB; ++ui;
        if constexpr (ALIGN_EPI) { if (wr == 1) PG8_BAR; }
    }
    PG8_WAIT_V(0);
    if constexpr (!ALIGN_EPI) { if (wr == 0) PG8_BAR; }
    PG8_BAR;
    if constexpr (Epi::AFTER_DRAIN) { E.fused(acc, cur, wr, wc, fr, fq, lds, wid, lane); S.done(cur); }
#undef PG8_SA
#undef PG8_SB
#undef PG8_STAGE
#undef PG8_LDA
#undef PG8_LDB
#undef PG8_MMA
#undef PG8_MMA8
#undef PG8_MMAX
#undef PG8_CAT8
#undef PG8_WAIT_V
#undef PG8_WAIT_L
#undef PG8_BAR
#undef PG8_SCHED
}
}
#define GAS __attribute__((address_space(1)))
#define LAS __attribute__((address_space(3)))
typedef unsigned short bf16;
typedef unsigned v4u __attribute__((ext_vector_type(4)));
typedef float f32x4 __attribute__((ext_vector_type(4)));
typedef short bf16x8 __attribute__((ext_vector_type(8)));
typedef GAS unsigned gu32;
typedef GAS unsigned long long gu64;
#define RLX_AGENT __ATOMIC_RELAXED, __HIP_MEMORY_SCOPE_AGENT
#define LDS_WAIT() asm volatile("s_waitcnt lgkmcnt(0)" ::: "memory")
#define VM_WAIT() asm volatile("s_waitcnt vmcnt(0)" ::: "memory")
__device__ __forceinline__ unsigned long long rt() { return __builtin_amdgcn_s_memrealtime(); }
__device__ __forceinline__ unsigned f2bf(float f) { unsigned u = __builtin_bit_cast(unsigned, f); return (u + 0x7fffu + ((u >> 16) & 1u)) >> 16; }
__device__ __forceinline__ unsigned pk2(float lo, float hi) { return f2bf(lo) | (f2bf(hi) << 16); }

#define XB_TMO      128
#define XB_XCNT(j)  (256  + 64 * (j))
#define XB_XSUB(j)  (1280 + 64 * (j))
#define XB_XGEN(j)  (2304 + 64 * (j))
#define XB_TOP      3328
#define XB_TOPGEN   3392
#define XCD_BAR_WORDS 3456
#define XB_SPIN_CAP (1u << 18)

__device__ __forceinline__ unsigned xb_ld(unsigned* p)              { return __hip_atomic_load(p, __ATOMIC_RELAXED, __HIP_MEMORY_SCOPE_AGENT); }
__device__ __forceinline__ unsigned xb_add(unsigned* p, unsigned v) { return __hip_atomic_fetch_add(p, v, __ATOMIC_RELAXED, __HIP_MEMORY_SCOPE_AGENT); }
__device__ __forceinline__ unsigned xb_xcc_id() { return (unsigned)__builtin_amdgcn_s_getreg((3 << 11) | 20) & 0xFu; }
#define XB_SPIN(cond, bar) do { unsigned _sp = 0; while (cond) { __builtin_amdgcn_s_sleep(1); \
    if ((++_sp & 255u) == 0u) { if (xb_ld(&(bar)[XB_TMO])) break; if (_sp > XB_SPIN_CAP) { atomicAdd(&(bar)[XB_TMO], 1u); break; } } } } while (0)

struct XcdBarrier {
    unsigned* bar; unsigned x;
    volatile LAS unsigned* st;
};

__device__ __forceinline__ XcdBarrier xcd_barrier_post(unsigned* bar, volatile LAS unsigned* st) {
    XcdBarrier b; b.bar = bar; b.x = xb_xcc_id(); b.st = st;
    if (threadIdx.x == 0) (void)xb_add(&bar[XB_XCNT(b.x)], 1u);
    return b;
}
__device__ __forceinline__ void xcd_barrier_complete(unsigned* bar, unsigned x, unsigned& nloc, unsigned& nx) {
    const unsigned G = gridDim.x * gridDim.y * gridDim.z;
    unsigned sum, cnt, mine, sp = 0u;
    for (;;) {
        sum = 0u; cnt = 0u; mine = 0u;
#pragma unroll
        for (unsigned j = 0; j < 16; ++j) { const unsigned c = xb_ld(&bar[XB_XCNT(j)]); sum += c; cnt += (c > 0u) ? 1u : 0u; mine = (j == x) ? c : mine; }
        if (sum == G) break;
        __builtin_amdgcn_s_sleep(1);
        if ((++sp & 255u) == 0u) { if (xb_ld(&bar[XB_TMO])) break; if (sp > XB_SPIN_CAP) { atomicAdd(&bar[XB_TMO], 1u); break; } }
    }
    nloc = mine > 0u ? mine : 1u; nx = cnt > 0u ? cnt : 1u;
}

__device__ __forceinline__ void xcd_barrier(const XcdBarrier& b) {
    asm volatile("s_waitcnt vmcnt(0)" ::: "memory");
    __syncthreads();
    if (threadIdx.x == 0) {
        unsigned* bar = b.bar;
        __builtin_amdgcn_s_waitcnt(0);
        unsigned nloc = b.st[0], nx = b.st[1];
        if (nloc == 0u) { xcd_barrier_complete(bar, b.x, nloc, nx); b.st[0] = nloc; b.st[1] = nx; }
        const unsigned old = xb_add(&bar[XB_XSUB(b.x)], 1u);
        const unsigned gen = old / nloc;
        if (old + 1u == (gen + 1u) * nloc) {
            __builtin_amdgcn_fence(__ATOMIC_RELEASE, "agent");
            asm volatile("s_waitcnt vmcnt(0)" ::: "memory");
            const unsigned og = xb_add(&bar[XB_TOP], 1u);
            const unsigned tg = og / nx;
            if (og + 1u == (tg + 1u) * nx) xb_add(&bar[XB_TOPGEN], 1u);
            else XB_SPIN(xb_ld(&bar[XB_TOPGEN]) == tg, bar);
            __builtin_amdgcn_fence(__ATOMIC_ACQUIRE, "agent");
            xb_add(&bar[XB_XGEN(b.x)], 1u);
            asm volatile("s_waitcnt vmcnt(0)" ::: "memory");
        } else {
            XB_SPIN(xb_ld(&bar[XB_XGEN(b.x)]) == gen, bar);
            __builtin_amdgcn_fence(__ATOMIC_ACQUIRE, "agent");
            asm volatile("s_waitcnt vmcnt(0)" ::: "memory");
        }
    }
    __syncthreads();
}

#define DI __device__ __forceinline__
constexpr int DM = 1024, NB = 2, SEQ = 8192, CTXL = 256, DEPTH = 2;
constexpr int NLAT = NB * SEQ, NCTX = NB * CTXL, NTOK = NLAT + NCTX;
constexpr int INW = 7936;
constexpr int C_AQ = 0, C_AK = 512, C_AV = 640, C_BQ = 768, C_BK = 1280, C_BV = 1792, C_CQ = 2304, C_CI = 2816, C_CFF = 3328, C_CFB = 3840, C_CG = 4352, C_GT = 4864;
constexpr int NEXP = 32, EFF = 1024, NCH = 132;
constexpr float RMS_EPS = 1e-6f, LOG2E = 1.4426950408889634f, QSCALE = 0.125f * 1.4426950408889634f;
constexpr int XG_ROWS = 75776;
constexpr int NWAVES = 8, NTHR = 512;

constexpr size_t MiB = 1u << 20;
constexpr size_t WS_CTL = 0, CTL_ZERO_BYTES = 1 * MiB;
constexpr size_t WS_SMALL = 1 * MiB;
constexpr size_t WS_WIN = 2 * MiB, WS_WBR = 33 * MiB, WS_WO = 39 * MiB, WS_WGU = 43 * MiB, WS_WDN = 299 * MiB;
constexpr size_t WS_XA = 427 * MiB, WS_H = 493 * MiB, WS_P = 526 * MiB, WS_LF = 782 * MiB, WS_O3 = 848 * MiB, WS_HU = 898 * MiB, WS_HD = 1030 * MiB, WS_HS = 1032 * MiB;
constexpr size_t WS_YF = 1098 * MiB, WS_Y = 1164 * MiB, WS_YO = 1197 * MiB, WS_ROUTE = 1230 * MiB, WS_XA2 = 1232 * MiB, WS_WIN8 = 1298 * MiB  , WS_END = 1314 * MiB;
constexpr size_t WS_XG = 526 * MiB, WS_ACT = 674 * MiB, WS_YS = 822 * MiB;
static_assert(WS_YS + (size_t)XG_ROWS * 1024 * 2 <= WS_HD, "moe overlay");
static_assert(WS_P + (size_t)NTOK * INW * 2 <= WS_LF && WS_HU + (size_t)2112 * 16384 * 4 <= WS_HD && WS_HS + (size_t)2112 * 16384 * 2 <= WS_YF, "ws map");
constexpr int SM_MOD = 0;
constexpr int SM_LB = 36864;
constexpr int SM_TAB = 38912;
constexpr int SM_LAM = 45056;
constexpr int CW_BAR = 4096;
constexpr int CW_CNT = 16384;

constexpr int RING_BYTES = 147456, LDSCTL_OFF = RING_BYTES, MISC_OFF = LDSCTL_OFF + 320, LDS_BYTES = 163840;

typedef float f32x16 __attribute__((ext_vector_type(16)));
typedef float f32x2 __attribute__((ext_vector_type(2)));
typedef short s16x4 __attribute__((ext_vector_type(4)));
typedef unsigned u32x2 __attribute__((ext_vector_type(2)));
typedef __bf16 bf16x2_t __attribute__((ext_vector_type(2)));
DI unsigned cvtpk(float lo, float hi) { f32x2 v = {lo, hi}; bf16x2_t b = __builtin_convertvector(v, bf16x2_t); return __builtin_bit_cast(unsigned, b); }
DI float bf2f(unsigned short u) { return __uint_as_float(((unsigned)u) << 16); }
DI float bflo(unsigned u) { return __uint_as_float(u << 16); }
DI float bfhi(unsigned u) { return __uint_as_float(u & 0xffff0000u); }
DI float wave_sum(float v) {
#pragma unroll
    for (int o = 1; o < 64; o <<= 1) v += __shfl_xor(v, o);
    return v;
}
constexpr float LOG2E_ = 1.4426950408889634f;
DI float silu_f(float v) { return v * __builtin_amdgcn_rcpf(1.f + __builtin_amdgcn_exp2f(-LOG2E_ * v)); }
DI float sigm_f(float v) { return __builtin_amdgcn_rcpf(1.f + __builtin_amdgcn_exp2f(-LOG2E_ * v)); }
DI bf16x8 pack8(float a0, float a1, float a2, float a3, float a4, float a5, float a6, float a7) {
    v4u p; p.x = cvtpk(a0, a1); p.y = cvtpk(a2, a3); p.z = cvtpk(a4, a5); p.w = cvtpk(a6, a7); return __builtin_bit_cast(bf16x8, p);
}
typedef short v4i16_t __attribute__((ext_vector_type(4)));
DI s16x4 tr_read(LAS const char* p) { return __builtin_bit_cast(s16x4, __builtin_amdgcn_ds_read_tr16_b64_v4i16((LAS v4i16_t*)p)); }
DI bf16x8 cat8(s16x4 lo, s16x4 hi) { return __builtin_shufflevector(lo, hi, 0, 1, 2, 3, 4, 5, 6, 7); }
#define MFMA32(a, b, c) __builtin_amdgcn_mfma_f32_32x32x16_bf16((a), (b), (c), 0, 0, 0)
#define MFMA16(a, b, c) __builtin_amdgcn_mfma_f32_16x16x32_bf16((a), (b), (c), 0, 0, 0)
#ifndef INP_FP8
#define INP_FP8 0
#endif
#define INP_L1_FP8 0
constexpr float F8_ACT = 8.f, F8_W = 256.f, F8_MID = 4.f;
constexpr float INP_OSC = INP_FP8 ? 1.f / (8.f * 256.f) : 1.f;
DI float clamp8(float x) { return fminf(fmaxf(x, -448.f), 448.f); }
DI unsigned f8x4(float a, float b, float c, float d) { int w = __builtin_amdgcn_cvt_pk_fp8_f32(clamp8(a), clamp8(b), 0, false); w = __builtin_amdgcn_cvt_pk_fp8_f32(clamp8(c), clamp8(d), w, true); return (unsigned)w; }
DI int tid_opaque() { int t = threadIdx.x; asm volatile("" : "+v"(t)); return t; }
DI int crow(int r, int hi) { return (r & 3) + 8 * (r >> 2) + 4 * hi; }

DI void ph_mod(LAS unsigned char* lds, const float* c, const float* cctx, const float* wmod, const float* bmod, float* MOD, int vcu, int G) {
    LAS float* red = (LAS float*)lds;
    const int tid = tid_opaque(), col = tid & 31, ks = tid >> 5;
    for (int tile = vcu; tile < 2 * 192; tile += G) {
        const int l = tile / 192, n0 = (tile % 192) * 32;
        const float* W = wmod + (size_t)l * 1024 * 6144 + n0 + col;
        float a0 = 0.f, a1 = 0.f, a2 = 0.f;
#pragma unroll 8
        for (int k = ks * 64; k < ks * 64 + 64; ++k) {
            const float w = W[(size_t)k * 6144];
            a0 += silu_f(c[k]) * w; a1 += silu_f(c[1024 + k]) * w; a2 += silu_f(cctx[k]) * w;
        }
        red[(ks * 3 + 0) * 32 + col] = a0; red[(ks * 3 + 1) * 32 + col] = a1; red[(ks * 3 + 2) * 32 + col] = a2;
        __syncthreads();
        if (tid < 96) { const int j = tid >> 5, cc = tid & 31; float s = 0.f;
#pragma unroll
            for (int k2 = 0; k2 < 16; ++k2) s += red[(k2 * 3 + j) * 32 + cc];
            MOD[(l * 3 + j) * 6144 + n0 + cc] = s + bmod[l * 6144 + n0 + cc]; }
        __syncthreads();
    }
}
DI void sincos_tab(double a, float& s, float& c) {
    const double TWO_PI = 6.283185307179586476925;
    const double k = rint(a / TWO_PI), r = a - k * TWO_PI, r2 = r * r;
    double ts = r, ss = r, tc = 1.0, cs = 1.0;
    for (int n = 1; n <= 15; ++n) { ts *= -r2 / (double)((2 * n) * (2 * n + 1)); ss += ts; tc *= -r2 / (double)((2 * n - 1) * (2 * n)); cs += tc; }
    s = (float)ss; c = (float)cs;
}
DI void ph_tables(float* SM, const float* lb_logits, const float* dlam, int vcu, int G) {
    const int gt = vcu * NTHR + tid_opaque(), NT = G * NTHR;
    for (int i = gt; i < 192 * 16; i += NT) {
        const int pos = i >> 4, f = i & 15;
        const float invf = f == 0 ? 1.0f : f == 1 ? 0.5623413324356079f : f == 2 ? 0.3162277638912201f : f == 3 ? 0.17782793939113617f : f == 4 ? 0.10000000149011612f : f == 5 ? 0.05623413249850273f
                         : f == 6 ? 0.03162277489900589f : f == 7 ? 0.017782794311642647f : f == 8 ? 0.009999999776482582f : f == 9 ? 0.005623413249850273f : f == 10 ? 0.003162277629598975f
                         : f == 11 ? 0.0017782794311642647f : f == 12 ? 0.0010000000474974513f : f == 13 ? 0.000562341301701963f : f == 14 ? 0.0003162277571391314f : 0.00017782794020604342f;
        const int p = pos < 128 ? pos : pos - 128;
        const float ang = (float)p * invf;
        float s, c; sincos_tab((double)ang, s, c);
        if (pos < 128) { SM[SM_TAB + p * 16 + f] = c; SM[SM_TAB + 2048 + p * 16 + f] = s; }
        else { SM[SM_TAB + 4096 + p * 16 + f] = c; SM[SM_TAB + 4096 + 1024 + p * 16 + f] = s; }
    }
    for (int i = gt; i < 1024; i += NT) {
        const float l0 = lb_logits[i], l1 = lb_logits[1024 + i];
        SM[SM_LB + i] = 0.f; SM[SM_LB + 1024 + i] = 1.f / (1.f + expf(l0 - l1));
    }
    if (gt < 2) { const float* lp = dlam + gt * 256; float s0 = 0.f, s1 = 0.f;
        for (int d = 0; d < 64; ++d) { s0 += lp[d] * lp[64 + d]; s1 += lp[128 + d] * lp[192 + d]; }
        const float li = 0.8f - 0.6f * expf(-0.3f * (float)gt);
        SM[SM_LAM + gt] = expf(s0) - expf(s1) + li; SM[SM_LAM + 2 + gt] = li; }
}
DI void p0_transpose_item(const float* W, int K, int N, int spitch, bf16* WT, int dpitch, int gu, int f8, LAS float* scr, int item, int lane) {
    const int nblk = N / 32, kb = item / nblk, nb = item % nblk, k0 = 64 * kb, n0 = 32 * nb;
    float wv[32];
#pragma unroll
    for (int i = 0; i < 32; ++i) wv[i] = __builtin_nontemporal_load(W + (size_t)(k0 + 2 * i + (lane >> 5)) * spitch + n0 + (lane & 31));
#pragma unroll
    for (int i = 0; i < 32; ++i) scr[(2 * i + (lane >> 5)) * 33 + (lane & 31)] = wv[i];
    LDS_WAIT(); asm volatile("" ::: "memory");
    const int c = lane & 7;
    const int r0 = gu ? (256 * ((n0 & 1023) >> 7) + 128 * (n0 >> 10) + (n0 & 127)) : n0;
#pragma unroll
    for (int j = 0; j < 4; ++j) { const int n = (lane >> 3) + 8 * j; const LAS float* s = scr + (8 * c) * 33 + n;
        if (f8) { u32x2 o8; o8.x = f8x4(s[0 * 33] * F8_W, s[1 * 33] * F8_W, s[2 * 33] * F8_W, s[3 * 33] * F8_W); o8.y = f8x4(s[4 * 33] * F8_W, s[5 * 33] * F8_W, s[6 * 33] * F8_W, s[7 * 33] * F8_W);
            *(GAS u32x2*)((unsigned char*)WT + (size_t)(r0 + n) * dpitch + k0 + 8 * c) = o8; }
        else { v4u o; o.x = pk2(s[0 * 33], s[1 * 33]); o.y = pk2(s[2 * 33], s[3 * 33]); o.z = pk2(s[4 * 33], s[5 * 33]); o.w = pk2(s[6 * 33], s[7 * 33]);
            *(GAS v4u*)(WT + (size_t)(r0 + n) * dpitch + k0 + 8 * c) = o; } }
    LDS_WAIT(); asm volatile("" ::: "memory");
}
struct TGroup { const float* src; bf16* dst; int K, N, nmat, gu, sub, f8, spitch; };
DI bool p0_group(const TGroup& g, int& r, LAS float* scr, int lane) {
    const int per = (g.K / 64) * (g.N / 32), cnt = per * g.nmat;
    if (r >= cnt) { r -= cnt; return false; }
    const int m = r / per, it = r % per;
    p0_transpose_item(g.src + (size_t)m * g.K * g.N, g.K, g.N, g.spitch ? g.spitch : g.N, g.f8 ? (bf16*)((unsigned char*)g.dst + (size_t)m * g.K * g.N) : g.dst + (size_t)(m / g.sub) * g.sub * g.K * g.N + (size_t)(m % g.sub) * g.K, g.sub * g.K, g.gu, g.f8, scr, it, lane);
    return true;
}
struct TItem { const float* sp; unsigned char* dp; int spitch, dpitch, f8; };
DI bool p0_decode(const TGroup& g, int& r, TItem& t) {
    const int per = (g.K / 64) * (g.N / 32), cnt = per * g.nmat;
    if (r >= cnt) { r -= cnt; return false; }
    const int m = r / per, it = r % per, nblk = g.N / 32, k0 = 64 * (it / nblk), n0 = 32 * (it % nblk);
    const int r0 = g.gu ? (256 * ((n0 & 1023) >> 7) + 128 * (n0 >> 10) + (n0 & 127)) : n0;
    t.spitch = g.spitch ? g.spitch : g.N; t.dpitch = g.sub * g.K; t.f8 = g.f8;
    t.sp = g.src + (size_t)m * g.K * g.N + (size_t)k0 * t.spitch + n0;
    t.dp = g.f8 ? (unsigned char*)g.dst + (size_t)m * g.K * g.N + (size_t)r0 * t.dpitch + k0
                : (unsigned char*)(g.dst + (size_t)(m / g.sub) * g.sub * g.K * g.N + (size_t)(m % g.sub) * g.K + (size_t)r0 * t.dpitch + k0);
    return true;
}
DI void p0_item_load(const TItem& t, int lane, float (&wv)[32]) {
#pragma unroll
    for (int i = 0; i < 32; ++i) wv[i] = __builtin_nontemporal_load(t.sp + (size_t)(2 * i + (lane >> 5)) * t.spitch + (lane & 31));
}
DI void p0_item_to_lds(LAS float* scr, int lane, const float (&wv)[32]) {
#pragma unroll
    for (int i = 0; i < 32; ++i) scr[(2 * i + (lane >> 5)) * 33 + (lane & 31)] = wv[i];
}
DI void p0_item_store(const TItem& t, LAS float* scr, int lane) {
    const int c = lane & 7;
#pragma unroll
    for (int j = 0; j < 4; ++j) { const int n = (lane >> 3) + 8 * j; const LAS float* s = scr + (8 * c) * 33 + n;
        if (t.f8) { u32x2 o8; o8.x = f8x4(s[0 * 33] * F8_W, s[1 * 33] * F8_W, s[2 * 33] * F8_W, s[3 * 33] * F8_W); o8.y = f8x4(s[4 * 33] * F8_W, s[5 * 33] * F8_W, s[6 * 33] * F8_W, s[7 * 33] * F8_W);
            *(GAS u32x2*)(t.dp + (size_t)n * t.dpitch + 8 * c) = o8; }
        else { v4u o; o.x = pk2(s[0 * 33], s[1 * 33]); o.y = pk2(s[2 * 33], s[3 * 33]); o.z = pk2(s[4 * 33], s[5 * 33]); o.w = pk2(s[6 * 33], s[7 * 33]);
            *(GAS v4u*)(t.dp + ((size_t)n * t.dpitch + 8 * c) * 2) = o; } }
}
DI void row_ld(const float* p, int lane, f32x4 (&v)[4]) {
#pragma unroll
    for (int j = 0; j < 4; ++j) v[j] = ((const GAS f32x4*)p)[lane + 64 * j];
}
DI void row_ld_bf(const bf16* p, int lane, f32x4 (&v)[4]) {
#pragma unroll
    for (int j = 0; j < 4; ++j) { const u32x2 w = ((const GAS u32x2*)p)[lane + 64 * j]; v[j] = (f32x4){bflo(w.x), bfhi(w.x), bflo(w.y), bfhi(w.y)}; }
}
DI void row_st(float* p, int lane, const f32x4 (&v)[4]) {
#pragma unroll
    for (int j = 0; j < 4; ++j) ((GAS f32x4*)p)[lane + 64 * j] = v[j];
}
DI void row_st_bf(bf16* p, int lane, const f32x4 (&v)[4]) {
#pragma unroll
    for (int j = 0; j < 4; ++j) { u32x2 w; w.x = cvtpk(v[j].x, v[j].y); w.y = cvtpk(v[j].z, v[j].w); ((GAS u32x2*)p)[lane + 64 * j] = w; }
}
DI void row_st_f8(unsigned char* p, int lane, const f32x4 (&v)[4], float s) {
#pragma unroll
    for (int j = 0; j < 4; ++j) ((GAS unsigned*)p)[lane + 64 * j] = f8x4(v[j].x * s, v[j].y * s, v[j].z * s, v[j].w * s);
}
DI float row_rstd(const f32x4 (&v)[4]) {
    float s = 0.f;
#pragma unroll
    for (int j = 0; j < 4; ++j) s += (v[j].x * v[j].x + v[j].y * v[j].y) + (v[j].z * v[j].z + v[j].w * v[j].w);
    return rsqrtf(wave_sum(s) * (1.f / 1024.f) + RMS_EPS);
}
DI void row_modulate(const f32x4 (&x)[4], const float* g, const float* shift, const float* scale, int lane, f32x4 (&h)[4]) {
    const float r = row_rstd(x);
#pragma unroll
    for (int j = 0; j < 4; ++j) { const f32x4 gg = ((const GAS f32x4*)g)[lane + 64 * j], sh = ((const GAS f32x4*)shift)[lane + 64 * j], sc = ((const GAS f32x4*)scale)[lane + 64 * j];
        h[j] = x[j] * r * gg * (sc + 1.f) + sh; }
}

DI v4u pack8u(const f32x4& a, const f32x4& b) { v4u w; w.x = cvtpk(a[0], a[1]); w.y = cvtpk(a[2], a[3]); w.z = cvtpk(b[0], b[1]); w.w = cvtpk(b[2], b[3]); return w; }
template <int MODE> struct EpiInT {
    static constexpr bool PERM = true, AFTER_DRAIN = false, KHOOK = false;
    bf16* P; float* LF; const float* tab; const float* lb; int pn_off; float osc;
    DI void operator()(const pg8::f32x4 (&acc)[2][2][4][2], const pg8::Unit& u, int wr, int wc, int fr_, int fq_) const {
        const int lane_ = tid_opaque() & 63, fr = lane_ & 15, fq = lane_ >> 4;
        const int pn = u.pn + pn_off; const bool lat = u.pm < 64;
#pragma unroll
        for (int bj = 0; bj < 2; ++bj) {
            int mode;
            float sc = 1.f;
            if (pn <= 1 || pn == 3 || pn == 4) { mode = 1; sc = QSCALE; }
            else if (pn == 2) mode = (bj == 0) ? 1 : 0;
            else if (pn == 5 || pn == 6) mode = 1;
            else if (pn == 9 || pn == 10 || pn == 17 || pn == 18) mode = 2;
            else if (pn >= 13 && pn <= 16) mode = 3;
            else if (pn >= 19) mode = 4;
            else mode = 0;
            if (mode == 1 && !lat) mode = 0;
            if (MODE == 2) mode = (mode == 3) ? 5 : 0;
            unsigned keep_ = 0u;
            const int cu = pn * 256 + bj * 128 + wc * 32;
            if (mode == 3 || mode == 5) {
                const int dir = (pn >= 15) ? 1 : 0; const int ch = (pn - 13 - 2 * dir) * 256 + bj * 128 + wc * 32 + 8 * fq;
                const f32x4 l0 = *(const GAS f32x4*)(lb + dir * 512 + ch), l1 = *(const GAS f32x4*)(lb + dir * 512 + ch + 4);
#pragma unroll
                for (int ai = 0; ai < 2; ++ai)
#pragma unroll
                    for (int m = 0; m < 4; ++m) {
                        const int rowu = u.pm * 256 + ai * 128 + wr * 64 + m * 16;
                        f32x4 v0 = acc[ai][bj][m][0] * osc, v1 = acc[ai][bj][m][1] * osc;
                        if (mode == 3) {
#pragma unroll
                            for (int j = 0; j < 4; ++j) { v0[j] = fmaxf(__logf(l0[j] + (1.f - l0[j]) * sigm_f(v0[j])), -60.f); v1[j] = fmaxf(__logf(l1[j] + (1.f - l1[j]) * sigm_f(v1[j])), -60.f); } }
                        float* lp = LF + (size_t)rowu * 1024 + dir * 512 + (pn - 13 - 2 * dir) * 256 + bj * 128 + wc * 32;
                        if (MODE != 1) { *(GAS f32x4*)(lp + fr * 1024 + 8 * fq) = v0; *(GAS f32x4*)(lp + fr * 1024 + 8 * fq + 4) = v1; } else keep_ ^= __float_as_uint(v0[0] + v0[1] + v0[2] + v0[3] + v1[0] + v1[1] + v1[2] + v1[3]);
                        if (MODE == 1 && ai == 1 && m == 3) *(GAS unsigned*)(lp + fr * 1024 + 8 * fq) = keep_;
                    }
                continue;
            }
            v4u wout[2][4];
#pragma unroll
            for (int ai = 0; ai < 2; ++ai)
#pragma unroll
                for (int m = 0; m < 4; ++m) {
                    const int rowu = u.pm * 256 + ai * 128 + wr * 64 + m * 16, row = rowu + fr;
                    f32x4 v0 = acc[ai][bj][m][0] * osc, v1 = acc[ai][bj][m][1] * osc;
                    if (mode == 1) {
                        const int s = row & (SEQ - 1); const int half = wc & 1; const int pos = half ? (s & 63) : (s >> 6);
                        const float* tb = tab + (half ? 4096 : 0) + pos * 16 + 8 * (fq & 1); const int so = half ? 1024 : 2048;
                        const f32x4 c0 = *(const GAS f32x4*)tb, c1 = *(const GAS f32x4*)(tb + 4), s0 = *(const GAS f32x4*)(tb + so), s1 = *(const GAS f32x4*)(tb + so + 4);
                        const float sg = (fq < 2) ? -sc : sc;
                        f32x4 p0, p1;
#pragma unroll
                        for (int j = 0; j < 4; ++j) { p0[j] = __shfl_xor(v0[j], 32); p1[j] = __shfl_xor(v1[j], 32); }
                        v0 = v0 * c0 * sc + p0 * s0 * sg; v1 = v1 * c1 * sc + p1 * s1 * sg;
                    } else if (mode == 0) { v0 = v0 * sc; v1 = v1 * sc; }
                    else if (mode == 2) {
#pragma unroll
                        for (int j = 0; j < 4; ++j) { v0[j] = silu_f(v0[j]); v1[j] = silu_f(v1[j]); }
                    } else {
#pragma unroll
                        for (int j = 0; j < 4; ++j) { v0[j] = sigm_f(v0[j]); v1[j] = sigm_f(v1[j]); }
                    }
                    wout[ai][m] = pack8u(v0, v1);
                }
#pragma unroll
            for (int ai = 0; ai < 2; ++ai)
#pragma unroll
                for (int m = 0; m < 4; ++m) {
                    bf16* op = P + (size_t)(u.pm * 256 + ai * 128 + wr * 64 + m * 16) * INW + cu;
                    if (MODE != 1) *(GAS v4u*)(op + fr * INW + 8 * fq) = wout[ai][m]; else { const v4u pw = wout[ai][m]; keep_ ^= pw.x ^ pw.y ^ pw.z ^ pw.w; if (ai == 1 && m == 3) *(GAS unsigned*)(op + fr * INW + 8 * fq) = keep_; }
                }
        }
    }
};
typedef EpiInT<0> EpiIn;
struct EpiMerge {
    static constexpr bool PERM = true, AFTER_DRAIN = false, KHOOK = true;
    const bf16* P; bf16* Y;
    DI void khook(pg8::f32x4 (&acc)[2][2][4][2], const pg8::Unit& u, int seam, int wr, int wc, int fr_, int fq_) const {
        const int lane_ = tid_opaque() & 63, fr = lane_ & 15, fq = lane_ >> 4;
        const int loff = fr * INW + 8 * fq;
#pragma unroll
        for (int ai = 0; ai < 2; ++ai)
#pragma unroll
            for (int m = 0; m < 4; ++m) {
                const bf16* gb = P + (size_t)(u.pm * 256 + ai * 128 + wr * 64 + m * 16) * INW + C_GT + (seam - 1) * 1024 + u.pn * 256 + wc * 32;
#pragma unroll
                for (int bj = 0; bj < 2; ++bj) {
                    const bf16* gp = gb + bj * 128 + loff;
                    const v4u ga = *(const GAS v4u*)gp, gn = *(const GAS v4u*)(gp + 1024);
                    const f32x4 r0 = (f32x4){bflo(ga.x) * __builtin_amdgcn_rcpf(bflo(gn.x)), bfhi(ga.x) * __builtin_amdgcn_rcpf(bfhi(gn.x)), bflo(ga.y) * __builtin_amdgcn_rcpf(bflo(gn.y)), bfhi(ga.y) * __builtin_amdgcn_rcpf(bfhi(gn.y))};
                    const f32x4 r1 = (f32x4){bflo(ga.z) * __builtin_amdgcn_rcpf(bflo(gn.z)), bfhi(ga.z) * __builtin_amdgcn_rcpf(bfhi(gn.z)), bflo(ga.w) * __builtin_amdgcn_rcpf(bflo(gn.w)), bfhi(ga.w) * __builtin_amdgcn_rcpf(bfhi(gn.w))};
                    acc[ai][bj][m][0] = acc[ai][bj][m][0] * r0; acc[ai][bj][m][1] = acc[ai][bj][m][1] * r1;
                }
                { asm volatile("" ::: "memory");
                    __builtin_amdgcn_sched_barrier(0); }
            }
    }
    DI void operator()(const pg8::f32x4 (&acc)[2][2][4][2], const pg8::Unit& u, int wr, int wc, int fr_, int fq_) const {
        const int lane_ = tid_opaque() & 63, fr = lane_ & 15, fq = lane_ >> 4;
        const int loff = fr * INW + 8 * fq, yoff = fr * 1024 + 8 * fq;
#pragma unroll
        for (int ai = 0; ai < 2; ++ai)
#pragma unroll
            for (int m = 0; m < 4; ++m) {
                const int rowu = u.pm * 256 + ai * 128 + wr * 64 + m * 16, colu = u.pn * 256 + wc * 32;
                const bf16* gb = P + (size_t)rowu * INW + C_GT + 2 * 1024 + colu; bf16* yb = Y + (size_t)rowu * 1024 + colu;
#pragma unroll
                for (int bj = 0; bj < 2; ++bj) {
                    const v4u gw = *(const GAS v4u*)(gb + bj * 128 + loff);
                    const f32x4 v0 = acc[ai][bj][m][0] * (f32x4){bflo(gw.x), bfhi(gw.x), bflo(gw.y), bfhi(gw.y)}, v1 = acc[ai][bj][m][1] * (f32x4){bflo(gw.z), bfhi(gw.z), bflo(gw.w), bfhi(gw.w)};
                    *(GAS v4u*)(yb + bj * 128 + yoff) = pack8u(v0, v1);
                }
                asm volatile("" ::: "memory");
            }
    }
};
struct EpiNull {
    static constexpr bool PERM = true, AFTER_DRAIN = false, KHOOK = false;
    float* O;
    DI void operator()(const pg8::f32x4 (&acc)[2][2][4][2], const pg8::Unit& u, int wr, int wc, int fr_, int fq_) const {
        float s = 0.f;
#pragma unroll
        for (int ai = 0; ai < 2; ++ai)
#pragma unroll
            for (int bj = 0; bj < 2; ++bj)
#pragma unroll
                for (int m = 0; m < 4; ++m)
#pragma unroll
                    for (int n = 0; n < 2; ++n) s += (acc[ai][bj][m][n][0] + acc[ai][bj][m][n][1]) + (acc[ai][bj][m][n][2] + acc[ai][bj][m][n][3]);
        O[(size_t)(u.pm * 31 + (u.pn % 31)) * 512 + tid_opaque()] = s;
    }
};
struct EpiPlain {
    static constexpr bool PERM = true, AFTER_DRAIN = false, KHOOK = false;
    bf16* O; int ldc; const float* bias; int npn; float osc;
    DI void operator()(const pg8::f32x4 (&acc)[2][2][4][2], const pg8::Unit& u, int wr, int wc, int fr_, int fq_) const {
        const int lane_ = tid_opaque() & 63, fr = lane_ & 15, fq = lane_ >> 4;
        const int e = u.pn / npn, pn = u.pn % npn;
#pragma unroll
        for (int bj = 0; bj < 2; ++bj) {
            const int colu = pn * 256 + bj * 128 + wc * 32;
            f32x4 b0 = (f32x4){0.f, 0.f, 0.f, 0.f}, b1 = b0;
            if (bias) { const float* bp = bias + (size_t)e * npn * 256 + colu + 8 * fq; b0 = *(const GAS f32x4*)bp; b1 = *(const GAS f32x4*)(bp + 4); }
#pragma unroll
            for (int ai = 0; ai < 2; ++ai)
#pragma unroll
                for (int m = 0; m < 4; ++m) {
                    bf16* ob = O + (size_t)(u.pm * 256 + ai * 128 + wr * 64 + m * 16) * ldc + colu;
                    *(GAS v4u*)(ob + fr * ldc + 8 * fq) = pack8u(acc[ai][bj][m][0] * osc + b0, acc[ai][bj][m][1] * osc + b1);
                }
        }
    }
};
template <int MODE> struct EpiSwigluT {
    static constexpr bool PERM = true, AFTER_DRAIN = false, KHOOK = false;
    unsigned char* O; const float* bias;
    DI void operator()(const pg8::f32x4 (&acc)[2][2][4][2], const pg8::Unit& u, int wr, int wc, int fr_, int fq_) const {
        const int lane_ = tid_opaque() & 63, fr = lane_ & 15, fq = lane_ >> 4;
        const int e = u.pn >> 3, nt = u.pn & 7;
        const int colu = nt * 128 + wc * 32;
        const float* bp = bias + (size_t)e * 2048 + colu + 8 * fq;
        const f32x4 bg0 = *(const GAS f32x4*)bp, bg1 = *(const GAS f32x4*)(bp + 4), bu0 = *(const GAS f32x4*)(bp + 1024), bu1 = *(const GAS f32x4*)(bp + 1028);
        unsigned keep_ = 0u;
#pragma unroll
        for (int ai = 0; ai < 2; ++ai)
#pragma unroll
            for (int m = 0; m < 4; ++m) {
                f32x4 v[2];
#pragma unroll
                for (int n = 0; n < 2; ++n) { const f32x4 g = acc[ai][0][m][n] * (1.f / (F8_ACT * F8_W)) + (n ? bg1 : bg0), uu = acc[ai][1][m][n] * (1.f / (F8_ACT * F8_W)) + (n ? bu1 : bu0);
#pragma unroll
                    for (int j = 0; j < 4; ++j) { if (MODE == 2) v[n][j] = g[j] + uu[j]; else { const float gc = fminf(g[j], 7.f), uc = fminf(fmaxf(uu[j], -7.f), 7.f); v[n][j] = (uc + 1.f) * (gc * sigm_f(1.702f * gc)); } } }
                unsigned char* ob = O + (size_t)(u.pm * 256 + ai * 128 + wr * 64 + m * 16) * 1024 + colu;
                u32x2 w8; w8.x = f8x4(v[0][0] * F8_MID, v[0][1] * F8_MID, v[0][2] * F8_MID, v[0][3] * F8_MID); w8.y = f8x4(v[1][0] * F8_MID, v[1][1] * F8_MID, v[1][2] * F8_MID, v[1][3] * F8_MID);
                if (MODE != 1) *(GAS u32x2*)(ob + fr * 1024 + 8 * fq) = w8; else if (ai == 1 && m == 3) *(GAS unsigned*)(ob + fr * 1024 + 8 * fq) = w8.x ^ w8.y ^ keep_; else keep_ ^= w8.x + w8.y;
            }
    }
};
typedef EpiSwigluT<0> EpiSwiglu;
struct SubOrder {
    pg8::StaticOrder base; int skip_from, skip_n;
    DI bool next(int i, pg8::Unit& u) const { if (!base.next(i, u)) return false; if (u.pn >= skip_from) u.pn += skip_n; return true; }
    DI void a_ready(const pg8::Unit&) const {}
    DI void done(const pg8::Unit&) const {}
};
struct MoeOrder {
    const volatile LAS int* tpre; int NT, G, c;
    DI bool next(int i, pg8::Unit& u) const {
        const int L = i * G + c, total = __builtin_amdgcn_readfirstlane(tpre[32]) * NT; if (L >= total) return false;
        const int mt = L / NT, nt = L % NT; int e = 0;
        for (int k = 1; k < 32; ++k) e += (tpre[k] <= mt) ? 1 : 0;
        u.pm = mt; u.pn = __builtin_amdgcn_readfirstlane(e) * NT + nt; return true;
    }
    DI void a_ready(const pg8::Unit&) const {}
    DI void done(const pg8::Unit&) const {}
};

template <int KW> DI int swzK(int row) { return KW == 128 ? (row & 15) : ((row >> 1) & 7); }
template <int VD> DI int swzV(int row) { return VD == 128 ? (row & 3) : ((row >> 1) & 1); }
struct AttnJob {
    int qrow;
    int qcol;
    int kcolT, vcolT, kc8;
    int seg0_row, n0, seg0_kpos0;
    int seg1_row, n1;
    int qpos0;
};
template <int KW, int VD, bool WINDOW>
DI void attn_run(LAS unsigned char* lds, const bf16* P, const AttnJob& J, f32x16 (&O)[VD / 32], float& m_out, float& l_out) {
    const int tid = tid_opaque(), lane = tid & 63, r32 = lane & 31, hi = lane >> 5;
    constexpr int KCH = KW / 8, VCH = VD / 8, NKR = KW / 64, NVR = VD / 64;
    bf16x8 qf[4];
#pragma unroll
    for (int d0 = 0; d0 < 4; ++d0) qf[d0] = *(const GAS bf16x8*)(P + (size_t)(J.qrow + r32) * INW + J.qcol + d0 * 16 + hi * 8);
#pragma unroll
    for (int d = 0; d < VD / 32; ++d) O[d] = (f32x16){0.f, 0.f, 0.f, 0.f, 0.f, 0.f, 0.f, 0.f, 0.f, 0.f, 0.f, 0.f, 0.f, 0.f, 0.f, 0.f};
    float m = -1e30f, l = 0.f;
    const int nt = J.n0 + J.n1;
    v4u kr[NKR], vr[NVR];
#define ATT_TROW(t) ((t) < J.n0 ? J.seg0_row + 64 * (t) : J.seg1_row + 64 * ((t) - J.n0))
#define ATT_LOAD(t) do { const int rs_ = ATT_TROW(t); \
        _Pragma("unroll") for (int i = 0; i < NKR; ++i) { const int ci = tid + NTHR * i, row = ci / KCH, cc = ci % KCH; kr[i] = *(const GAS v4u*)(P + (size_t)(rs_ + row) * INW + J.kcolT + cc * 8); } \
        _Pragma("unroll") for (int i = 0; i < NVR; ++i) { const int ci = tid + NTHR * i, row = ci / VCH, cc = ci % VCH; vr[i] = *(const GAS v4u*)(P + (size_t)(rs_ + row) * INW + J.vcolT + cc * 8); } } while (0)
#define ATT_STORE(buf) do { \
        _Pragma("unroll") for (int i = 0; i < NKR; ++i) { const int ci = tid + NTHR * i, row = ci / KCH, cc = ci % KCH; *(LAS v4u*)(lds + (buf) * 16384 + row * (KW * 2) + ((cc ^ swzK<KW>(row)) << 4)) = kr[i]; } \
        _Pragma("unroll") for (int i = 0; i < NVR; ++i) { const int ci = tid + NTHR * i, row = ci / VCH, cc = ci % VCH; *(LAS v4u*)(lds + 32768 + (buf) * 16384 + row * (VD * 2) + ((((cc >> 2) ^ swzV<VD>(row)) << 6) | ((cc & 3) << 4))) = vr[i]; } } while (0)
    if (nt > 0) { ATT_LOAD(0); ATT_STORE(0); }
    __syncthreads();
    for (int t = 0; t < nt; ++t) {
        const int cur = t & 1;
        if (t + 1 < nt) ATT_LOAD(t + 1);
        const LAS unsigned char* kb = lds + cur * 16384; const LAS unsigned char* vb = lds + 32768 + cur * 16384;
        f32x16 st[2];
#pragma unroll
        for (int sub = 0; sub < 2; ++sub) {
            f32x16 a = (f32x16){0.f, 0.f, 0.f, 0.f, 0.f, 0.f, 0.f, 0.f, 0.f, 0.f, 0.f, 0.f, 0.f, 0.f, 0.f, 0.f};
            const int row = 32 * sub + r32;
#pragma unroll
            for (int d0 = 0; d0 < 4; ++d0) { const int ch = J.kc8 + 2 * d0 + hi;
                const bf16x8 kf = *(const LAS bf16x8*)(kb + row * (KW * 2) + ((ch ^ swzK<KW>(row)) << 4));
                a = MFMA32(kf, qf[d0], a); }
            st[sub] = a;
        }
        if (WINDOW && t < J.n0) {
            const int kp0 = J.seg0_kpos0 + 64 * t - (J.qpos0 + r32);
#pragma unroll
            for (int sub = 0; sub < 2; ++sub)
#pragma unroll
                for (int r = 0; r < 16; ++r) { const int rel = kp0 + 32 * sub + crow(r, hi); if (rel > 128 || rel < -128) st[sub][r] = -INFINITY; }
        }
        float tm = st[0][0];
#pragma unroll
        for (int r = 1; r < 16; ++r) tm = fmaxf(tm, st[0][r]);
#pragma unroll
        for (int r = 0; r < 16; ++r) tm = fmaxf(tm, st[1][r]);
        tm = fmaxf(tm, __shfl_xor(tm, 32));
        const float mn = fmaxf(m, tm), alpha = __builtin_amdgcn_exp2f(m - mn); m = mn;
        float ls = 0.f;
#pragma unroll
        for (int sub = 0; sub < 2; ++sub)
#pragma unroll
            for (int r = 0; r < 16; ++r) { const float p = __builtin_amdgcn_exp2f(st[sub][r] - mn); st[sub][r] = p; ls += p; }
        l = l * alpha + ls;
#pragma unroll
        for (int d = 0; d < VD / 32; ++d) O[d] = O[d] * alpha;
        bf16x8 pb[2][2];
#pragma unroll
        for (int sub = 0; sub < 2; ++sub)
#pragma unroll
            for (int s = 0; s < 2; ++s) pb[sub][s] = pack8(st[sub][8 * s], st[sub][8 * s + 1], st[sub][8 * s + 2], st[sub][8 * s + 3], st[sub][8 * s + 4], st[sub][8 * s + 5], st[sub][8 * s + 6], st[sub][8 * s + 7]);
        const int q4 = (lane & 15) >> 2, p4 = lane & 3, blk = (lane >> 4) & 1;
#pragma unroll
        for (int d = 0; d < VD / 32; ++d)
#pragma unroll
            for (int sub = 0; sub < 2; ++sub)
#pragma unroll
                for (int s = 0; s < 2; ++s) {
                    const int r0 = 32 * sub + 16 * s + 4 * hi + q4, r1 = r0 + 8;
                    const s16x4 lo = tr_read((LAS const char*)(vb + r0 * (VD * 2) + (((d ^ swzV<VD>(r0)) << 6) | (blk << 5) | (p4 << 3))));
                    const s16x4 hh = tr_read((LAS const char*)(vb + r1 * (VD * 2) + (((d ^ swzV<VD>(r1)) << 6) | (blk << 5) | (p4 << 3))));
                    O[d] = MFMA32(cat8(lo, hh), pb[sub][s], O[d]);
                }
        if (t + 1 < nt) ATT_STORE(cur ^ 1);
        __syncthreads();
    }
#undef ATT_TROW
#undef ATT_LOAD
#undef ATT_STORE
    l += __shfl_xor(l, 32);
    m_out = m; l_out = l;
}

DI void ph_attn_a(LAS unsigned char* lds, const bf16* P, bf16* OA, const float* sink, bool with_ctx, int vcu, int G) {
    const int lane = tid_opaque() & 63, wave = __builtin_amdgcn_readfirstlane(tid_opaque() >> 6), r32 = lane & 31, hi = lane >> 5;
    const int nun = 512 + (with_ctx ? 16 : 0);
    for (int u = vcu; u < nun; u += G) {
        AttnJob J; int b, kvh, q0; const bool cq = u >= 512;
        if (!cq) { b = u >> 8; kvh = (u >> 7) & 1; q0 = (u & 127) * 64;
            int jlo = 0, jhi = 4; if (q0 == 0) jlo = 2; else if (q0 == 64) jlo = 1; if (q0 == SEQ - 64) jhi = 2; else if (q0 == SEQ - 128) jhi = 3;
            J.seg0_kpos0 = q0 - 128 + 64 * jlo; J.seg0_row = b * SEQ + J.seg0_kpos0; J.n0 = jhi - jlo + 1; J.qrow = b * SEQ + q0 + 32 * (wave & 1); J.qpos0 = q0 + 32 * (wave & 1); }
        else { const int v = u - 512; b = v >> 3; kvh = (v >> 2) & 1; q0 = (v & 3) * 64; J.seg0_kpos0 = 0; J.seg0_row = 0; J.n0 = 0; J.qrow = NLAT + b * CTXL + q0 + 32 * (wave & 1); J.qpos0 = 0; }
        const int head = kvh * 4 + (wave >> 1);
        J.qcol = C_AQ + head * 64; J.kcolT = C_AK + kvh * 64; J.vcolT = C_AV + kvh * 64; J.kc8 = 0; J.seg1_row = NLAT + b * CTXL; J.n1 = 4;
        f32x16 O[2]; float m, l;
        attn_run<64, 64, true>(lds, P, J, O, m, l);
        l += __builtin_amdgcn_exp2f(sink[head] * LOG2E - m);
        const float inv = 1.f / l;
        bf16* op = OA + (size_t)(J.qrow + r32) * 1536 + head * 64;
#pragma unroll
        for (int d = 0; d < 2; ++d)
#pragma unroll
            for (int rg = 0; rg < 4; ++rg) { u32x2 w; w.x = cvtpk(O[d][4 * rg] * inv, O[d][4 * rg + 1] * inv); w.y = cvtpk(O[d][4 * rg + 2] * inv, O[d][4 * rg + 3] * inv);
                *(GAS u32x2*)(op + 32 * d + 8 * rg + 4 * hi) = w; }
    }
}
#ifndef AB_WIDE
#define AB_WIDE 1
#endif
#define SPLAT16(x) ((f32x16){(x), (x), (x), (x), (x), (x), (x), (x), (x), (x), (x), (x), (x), (x), (x), (x)})
DI float max3_asm(float a, float b, float c) { float r; asm("v_max3_f32 %0, %1, %2, %3" : "=v"(r) : "v"(a), "v"(b), "v"(c)); return r; }
DI float rowmax32(const f32x16& a, const f32x16& b) {
    float x = max3_asm(a[0], a[1], b[0]), y = max3_asm(a[2], a[3], b[1]);
    x = max3_asm(x, b[2], b[3]);
#pragma unroll
    for (int r = 4; r < 16; r += 4) { x = max3_asm(x, a[r], a[r + 1]); y = max3_asm(y, a[r + 2], a[r + 3]); x = max3_asm(x, b[r], b[r + 1]); y = max3_asm(y, b[r + 2], b[r + 3]); }
    x = fmaxf(x, y);
    const auto sw = __builtin_amdgcn_permlane32_swap(__float_as_uint(x), __float_as_uint(x), false, false);
    return max3_asm(__uint_as_float(sw[0]), __uint_as_float(sw[1]), x);
}
#define LDSRD128(dst, addr, off) asm volatile("ds_read_b128 %0, %1 offset:%c2" : "=&v"(dst) : "v"(addr), "i"(off) : "memory")
#define LDSTR64(dst, addr, off) asm volatile("ds_read_b64_tr_b16 %0, %1 offset:%c2" : "=&v"(dst) : "v"(addr), "i"(off) : "memory")
#define LGKM_WAIT(n) do { asm volatile("s_waitcnt lgkmcnt(" #n ")" ::: "memory"); __builtin_amdgcn_sched_barrier(0); } while (0)
template <int VAR> DI void attn_b_run(LAS unsigned char* lds, const bf16* P, const AttnJob& J, f32x16 (&O)[4], float& l_out) {
    const int tid = tid_opaque(), lane = tid & 63, r32 = lane & 31, hi = lane >> 5, wave = __builtin_amdgcn_readfirstlane(tid >> 6);
    bf16x8 qf[4];
#pragma unroll
    for (int d0 = 0; d0 < 4; ++d0) qf[d0] = *(const GAS bf16x8*)(P + (size_t)(J.qrow + r32) * INW + J.qcol + d0 * 16 + hi * 8);
#pragma unroll
    for (int d = 0; d < 4; ++d) O[d] = SPLAT16(0.f);
    const int nt = J.n0 + J.n1;
    const unsigned lds0 = (unsigned)(uintptr_t)lds;
    unsigned ka0, va0;
    { const int q4 = (lane & 15) >> 2, p4 = lane & 3, blk = (lane >> 4) & 1;
      ka0 = lds0 + r32 * 256 + (((J.kc8 + hi) ^ (r32 & 15)) << 4);
      va0 = lds0 + 49152 + (4 * hi + q4) * 256 + ((q4 << 6) | (blk << 5) | (p4 << 3)); }
#define ka(i) (ka0 ^ ((i) << 5))
#define va(i) (va0 ^ ((i) << 6))
#define AB_TROW(t) ((t) < J.n0 ? J.seg0_row + 64 * (t) : J.seg1_row + 64 * ((t) - J.n0))
    unsigned dko[2], dvo[2];
#pragma unroll
    for (int i = 0; i < 2; ++i) { const int row_ = 4 * (2 * wave + i) + (lane >> 4), cp_ = lane & 15;
        dko[i] = (unsigned)(row_ * INW + J.kcolT + ((cp_ ^ (row_ & 15)) << 3)) * 2u; dvo[i] = (unsigned)(row_ * INW + J.vcolT + (((((cp_ >> 2) ^ (row_ & 3)) << 2) | (cp_ & 3)) << 3)) * 2u; }
#define AB_DMA(t, st) do { const char* src_ = (const char*)(P + (size_t)AB_TROW(t) * INW); \
        _Pragma("unroll") for (int i = 0; i < 2; ++i) __builtin_amdgcn_global_load_lds((const unsigned*)(src_ + dko[i]), (LAS unsigned*)(lds + (st) * 16384 + (2 * wave + i) * 1024), 16, 0, 0); \
        _Pragma("unroll") for (int i = 0; i < 2; ++i) __builtin_amdgcn_global_load_lds((const unsigned*)(src_ + dvo[i]), (LAS unsigned*)(lds + 49152 + (st) * 16384 + (2 * wave + i) * 1024), 16, 0, 0); } while (0)
#define AB_KREAD(ST) do { \
        LDSRD128(kf[0], ka(0), (ST) * 16384); LDSRD128(kf[1], ka(0), (ST) * 16384 + 8192); LDSRD128(kf[2], ka(1), (ST) * 16384); LDSRD128(kf[3], ka(1), (ST) * 16384 + 8192); \
        LDSRD128(kf[4], ka(2), (ST) * 16384); LDSRD128(kf[5], ka(2), (ST) * 16384 + 8192); LDSRD128(kf[6], ka(3), (ST) * 16384); LDSRD128(kf[7], ka(3), (ST) * 16384 + 8192); } while (0)
#define AB_QKM(S0, S1) do { S0 = MFMA32(kf[0], qf[0], negm); S1 = MFMA32(kf[1], qf[0], negm); S0 = MFMA32(kf[2], qf[1], S0); S1 = MFMA32(kf[3], qf[1], S1); \
        S0 = MFMA32(kf[4], qf[2], S0); S1 = MFMA32(kf[5], qf[2], S1); S0 = MFMA32(kf[6], qf[3], S0); S1 = MFMA32(kf[7], qf[3], S1); } while (0)
#define AB_VREAD(VB, D, ST) do { \
        LDSTR64(VB[0], va(D), (ST) * 16384 + 0 * 4096); LDSTR64(VB[1], va(D), (ST) * 16384 + 0 * 4096 + 2048); LDSTR64(VB[2], va(D), (ST) * 16384 + 1 * 4096); LDSTR64(VB[3], va(D), (ST) * 16384 + 1 * 4096 + 2048); \
        LDSTR64(VB[4], va(D), (ST) * 16384 + 2 * 4096); LDSTR64(VB[5], va(D), (ST) * 16384 + 2 * 4096 + 2048); LDSTR64(VB[6], va(D), (ST) * 16384 + 3 * 4096); LDSTR64(VB[7], va(D), (ST) * 16384 + 3 * 4096 + 2048); } while (0)
#define AB_PVM(VB, D) do { O[D] = MFMA32(cat8(VB[0], VB[1]), pb00, O[D]); O[D] = MFMA32(cat8(VB[2], VB[3]), pb01, O[D]); O[D] = MFMA32(cat8(VB[4], VB[5]), pb10, O[D]); O[D] = MFMA32(cat8(VB[6], VB[7]), pb11, O[D]); } while (0)
    float m = 0.f, l = 0.f;
    f32x16 c0, c1, negm = SPLAT16(0.f);
    bf16x8 kf[8]; s16x4 vA[8], vB[8];
    AB_DMA(0, 0); if (nt > 1) AB_DMA(1, 1);
    if (nt > 1) asm volatile("s_waitcnt vmcnt(4)" ::: "memory"); else asm volatile("s_waitcnt vmcnt(0)" ::: "memory");
    __syncthreads();
#define AB_VREADK(VB, SS, ST) do { \
        LDSTR64(VB[0], va(0), (ST) * 16384 + (SS) * 4096); LDSTR64(VB[1], va(0), (ST) * 16384 + (SS) * 4096 + 2048); LDSTR64(VB[2], va(1), (ST) * 16384 + (SS) * 4096); LDSTR64(VB[3], va(1), (ST) * 16384 + (SS) * 4096 + 2048); \
        LDSTR64(VB[4], va(2), (ST) * 16384 + (SS) * 4096); LDSTR64(VB[5], va(2), (ST) * 16384 + (SS) * 4096 + 2048); LDSTR64(VB[6], va(3), (ST) * 16384 + (SS) * 4096); LDSTR64(VB[7], va(3), (ST) * 16384 + (SS) * 4096 + 2048); } while (0)
#define AB_EX2(C, B) do { C[B] = __builtin_amdgcn_exp2f(C[B]); C[(B) + 1] = __builtin_amdgcn_exp2f(C[(B) + 1]); } while (0)
#define AB_GAP(VB, D, PB, C, B) do { O[D] = MFMA32(cat8(VB[2 * (D)], VB[2 * (D) + 1]), PB, O[D]); AB_EX2(C, B); __builtin_amdgcn_sched_barrier(0); } while (0)
#define AB_GAPN(VB, D, PB) do { O[D] = MFMA32(cat8(VB[2 * (D)], VB[2 * (D) + 1]), PB, O[D]); __builtin_amdgcn_sched_barrier(0); } while (0)
#define AB_PK(C, B) pack8(C[B], C[(B) + 1], C[(B) + 2], C[(B) + 3], C[(B) + 4], C[(B) + 5], C[(B) + 6], C[(B) + 7])
#define AB_STEP(t, ST) do { \
        if ((t) + 2 < nt && (!(VAR & 4) || (t) < 1)) AB_DMA((t) + 2, ((ST) + 2) % 3); \
        if (!(VAR & 16) || wave < 4) { \
        if (!(VAR & 8)) { AB_KREAD(ST); LGKM_WAIT(0); AB_QKM(c0, c1); } else { c0 = negm; c1 = negm; } \
        AB_VREAD(vA, 0, ST); \
        asm volatile("s_nop 15\n\ts_nop 7" : "+v"(c0), "+v"(c1));     \
        { const float tm_ = rowmax32(c0, c1); const float sh_ = ((t) == 0) ? tm_ : (tm_ > 8.f ? tm_ : 0.f); \
          if (__any(sh_ != 0.f)) { _Pragma("unroll") for (int r = 0; r < 16; ++r) { c0[r] -= sh_; c1[r] -= sh_; } m += sh_; negm = SPLAT16(-m); \
              if ((t) > 0) { const float al_ = __builtin_amdgcn_exp2f(-sh_); l *= al_; _Pragma("unroll") for (int d = 0; d < 4; ++d) O[d] = O[d] * al_; } } } \
        float ls_ = 0.f; \
        { \
        if (!(VAR & 1)) { _Pragma("unroll") for (int r = 0; r < 16; ++r) { c0[r] = __builtin_amdgcn_exp2f(c0[r]); c1[r] = __builtin_amdgcn_exp2f(c1[r]); } } \
        { const f32x16 s_ = c0 + c1; const float s0_ = (s_[0] + s_[1]) + (s_[2] + s_[3]), s1_ = (s_[4] + s_[5]) + (s_[6] + s_[7]), s2_ = (s_[8] + s_[9]) + (s_[10] + s_[11]), s3_ = (s_[12] + s_[13]) + (s_[14] + s_[15]); ls_ = (s0_ + s1_) + (s2_ + s3_); } \
        l += ls_; \
        const bf16x8 pb00 = pack8(c0[0], c0[1], c0[2], c0[3], c0[4], c0[5], c0[6], c0[7]), pb01 = pack8(c0[8], c0[9], c0[10], c0[11], c0[12], c0[13], c0[14], c0[15]); \
        const bf16x8 pb10 = pack8(c1[0], c1[1], c1[2], c1[3], c1[4], c1[5], c1[6], c1[7]), pb11 = pack8(c1[8], c1[9], c1[10], c1[11], c1[12], c1[13], c1[14], c1[15]); \
        if (!(VAR & 2)) { AB_VREAD(vB, 1, ST); LGKM_WAIT(8); AB_PVM(vA, 0); \
        AB_VREAD(vA, 2, ST); LGKM_WAIT(8); AB_PVM(vB, 1); \
        AB_VREAD(vB, 3, ST); LGKM_WAIT(8); AB_PVM(vA, 2); \
        LGKM_WAIT(0); AB_PVM(vB, 3); } else { LGKM_WAIT(0); O[0][0] += c0[0] + (float)vA[0][0]; } } } \
        if ((t) + 2 < nt) asm volatile("s_waitcnt vmcnt(4)" ::: "memory"); else asm volatile("s_waitcnt vmcnt(0)" ::: "memory"); \
        if (!(VAR & 32) || (t) < 2 || (t) + 3 >= nt) __syncthreads(); } while (0)
    for (int t = 0; t < nt; t += 3) {
        AB_STEP(t, 0);
        if (t + 1 < nt) AB_STEP(t + 1, 1);
        if (t + 2 < nt) AB_STEP(t + 2, 2);
    }
#undef ka
#undef va
#undef AB_TROW
#undef AB_DMA
#undef AB_KREAD
#undef AB_QKM
#undef AB_VREAD
#undef AB_PVM
#undef AB_STEP
#undef AB_VREADK
#undef AB_EX2
#undef AB_GAP
#undef AB_GAPN
#undef AB_PK
    l += __shfl_xor(l, 32);
    l_out = l;
}
DI void attn_b_run_w(LAS unsigned char* lds, const bf16* P, const AttnJob& J, f32x16 (&O)[4], float& l_out) {
    const int tid = tid_opaque(), lane = tid & 63, r32 = lane & 31, hi = lane >> 5, wave = __builtin_amdgcn_readfirstlane(tid >> 6);
    bf16x8 qf[4];
#pragma unroll
    for (int d0 = 0; d0 < 4; ++d0) qf[d0] = *(const GAS bf16x8*)(P + (size_t)(J.qrow + r32) * INW + J.qcol + d0 * 16 + hi * 8);
#pragma unroll
    for (int d = 0; d < 4; ++d) O[d] = SPLAT16(0.f);
    const int ns = (J.n0 + J.n1) >> 1;
    const unsigned lds0 = (unsigned)(uintptr_t)lds;
    unsigned ka0, va0;
    { const int q4 = (lane & 15) >> 2, p4 = lane & 3, blk = (lane >> 4) & 1;
      ka0 = lds0 + r32 * 256 + (((J.kc8 + hi) ^ (r32 & 15)) << 4);
      va0 = lds0 + 65536 + (4 * hi + q4) * 256 + ((q4 << 6) | (blk << 5) | (p4 << 3)); }
#define ka(i) (ka0 ^ ((i) << 5))
#define va(i) (va0 ^ ((i) << 6))
#define AW_TROW(t) ((t) < J.n0 ? J.seg0_row + 64 * (t) : J.seg1_row + 64 * ((t) - J.n0))
    unsigned dko[2], dvo[2];
#pragma unroll
    for (int i = 0; i < 2; ++i) { const int row_ = 4 * (2 * wave + i) + (lane >> 4), cp_ = lane & 15;
        dko[i] = (unsigned)(row_ * INW + J.kcolT + ((cp_ ^ (row_ & 15)) << 3)) * 2u; dvo[i] = (unsigned)(row_ * INW + J.vcolT + (((((cp_ >> 2) ^ (row_ & 3)) << 2) | (cp_ & 3)) << 3)) * 2u; }
#define AW_DMA1(t, off) do { const char* src_ = (const char*)(P + (size_t)AW_TROW(t) * INW); \
        _Pragma("unroll") for (int i = 0; i < 2; ++i) __builtin_amdgcn_global_load_lds((const unsigned*)(src_ + dko[i]), (LAS unsigned*)(lds + (off) + (2 * wave + i) * 1024), 16, 0, 0); \
        _Pragma("unroll") for (int i = 0; i < 2; ++i) __builtin_amdgcn_global_load_lds((const unsigned*)(src_ + dvo[i]), (LAS unsigned*)(lds + 65536 + (off) + (2 * wave + i) * 1024), 16, 0, 0); } while (0)
#define AW_DMA(j, st) do { AW_DMA1(2 * (j), (st) * 32768); AW_DMA1(2 * (j) + 1, (st) * 32768 + 16384); } while (0)
#define AW_KREAD(OFF, H) do { \
        LDSRD128(kf[0], ka(2 * (H)), (OFF)); LDSRD128(kf[1], ka(2 * (H)), (OFF) + 8192); LDSRD128(kf[2], ka(2 * (H) + 1), (OFF)); LDSRD128(kf[3], ka(2 * (H) + 1), (OFF) + 8192); } while (0)
#define AW_QKM0(S0, S1) do { S0 = MFMA32(kf[0], qf[0], negm); S1 = MFMA32(kf[1], qf[0], negm); S0 = MFMA32(kf[2], qf[1], S0); S1 = MFMA32(kf[3], qf[1], S1); } while (0)
#define AW_QKM1(S0, S1) do { S0 = MFMA32(kf[0], qf[2], S0); S1 = MFMA32(kf[1], qf[2], S1); S0 = MFMA32(kf[2], qf[3], S0); S1 = MFMA32(kf[3], qf[3], S1); } while (0)
#define AW_VREAD(VB, D, OFF) do { \
        LDSTR64(VB[0], va(D), (OFF) + 0 * 4096); LDSTR64(VB[1], va(D), (OFF) + 0 * 4096 + 2048); LDSTR64(VB[2], va(D), (OFF) + 1 * 4096); LDSTR64(VB[3], va(D), (OFF) + 1 * 4096 + 2048); \
        LDSTR64(VB[4], va(D), (OFF) + 2 * 4096); LDSTR64(VB[5], va(D), (OFF) + 2 * 4096 + 2048); LDSTR64(VB[6], va(D), (OFF) + 3 * 4096); LDSTR64(VB[7], va(D), (OFF) + 3 * 4096 + 2048); } while (0)
#define AW_PVM(VB, D, PA, PB_, PC, PD) do { O[D] = MFMA32(cat8(VB[0], VB[1]), PA, O[D]); O[D] = MFMA32(cat8(VB[2], VB[3]), PB_, O[D]); O[D] = MFMA32(cat8(VB[4], VB[5]), PC, O[D]); O[D] = MFMA32(cat8(VB[6], VB[7]), PD, O[D]); } while (0)
#define AW_PK(C, B) pack8(C[B], C[(B) + 1], C[(B) + 2], C[(B) + 3], C[(B) + 4], C[(B) + 5], C[(B) + 6], C[(B) + 7])
    float m = 0.f, l = 0.f;
    f32x16 c00, c01, c10, c11;
    bf16x8 kf[4]; s16x4 vA[8], vB[8];
    AW_DMA(0, 0);
    asm volatile("s_waitcnt vmcnt(0)" ::: "memory"); __syncthreads();
#define AW_STEP(j, ST) do { \
        if ((j) + 1 < ns) AW_DMA((j) + 1, 1 - (ST)); \
        const f32x16 negm = SPLAT16(-m); \
        AW_KREAD((ST) * 32768, 0); LGKM_WAIT(0); AW_QKM0(c00, c01); AW_KREAD((ST) * 32768, 1); LGKM_WAIT(0); AW_QKM1(c00, c01); \
        AW_KREAD((ST) * 32768 + 16384, 0); LGKM_WAIT(0); AW_QKM0(c10, c11); AW_KREAD((ST) * 32768 + 16384, 1); LGKM_WAIT(0); AW_QKM1(c10, c11); \
        AW_VREAD(vA, 0, (ST) * 32768); \
        asm volatile("s_nop 15\n\ts_nop 7" : "+v"(c00), "+v"(c01), "+v"(c10), "+v"(c11)); \
        { const float tm_ = fmaxf(rowmax32(c00, c01), rowmax32(c10, c11)); const float sh_ = ((j) == 0) ? tm_ : (tm_ > 8.f ? tm_ : 0.f); \
          if (__any(sh_ != 0.f)) { _Pragma("unroll") for (int r = 0; r < 16; ++r) { c00[r] -= sh_; c01[r] -= sh_; c10[r] -= sh_; c11[r] -= sh_; } m += sh_; \
              if ((j) > 0) { const float al_ = __builtin_amdgcn_exp2f(-sh_); l *= al_; _Pragma("unroll") for (int d = 0; d < 4; ++d) O[d] = O[d] * al_; } } } \
        _Pragma("unroll") for (int r = 0; r < 16; ++r) { c00[r] = __builtin_amdgcn_exp2f(c00[r]); c01[r] = __builtin_amdgcn_exp2f(c01[r]); c10[r] = __builtin_amdgcn_exp2f(c10[r]); c11[r] = __builtin_amdgcn_exp2f(c11[r]); } \
        { const f32x16 s_ = (c00 + c01) + (c10 + c11); const float s0_ = (s_[0] + s_[1]) + (s_[2] + s_[3]), s1_ = (s_[4] + s_[5]) + (s_[6] + s_[7]), s2_ = (s_[8] + s_[9]) + (s_[10] + s_[11]), s3_ = (s_[12] + s_[13]) + (s_[14] + s_[15]); l += (s0_ + s1_) + (s2_ + s3_); } \
        const bf16x8 pa0 = AW_PK(c00, 0), pa1 = AW_PK(c00, 8), pa2 = AW_PK(c01, 0), pa3 = AW_PK(c01, 8); \
        AW_VREAD(vB, 1, (ST) * 32768); LGKM_WAIT(8); AW_PVM(vA, 0, pa0, pa1, pa2, pa3); \
        AW_VREAD(vA, 2, (ST) * 32768); LGKM_WAIT(8); AW_PVM(vB, 1, pa0, pa1, pa2, pa3); \
        AW_VREAD(vB, 3, (ST) * 32768); LGKM_WAIT(8); AW_PVM(vA, 2, pa0, pa1, pa2, pa3); \
        AW_VREAD(vA, 0, (ST) * 32768 + 16384); LGKM_WAIT(8); AW_PVM(vB, 3, pa0, pa1, pa2, pa3); \
        const bf16x8 pb0 = AW_PK(c10, 0), pb1 = AW_PK(c10, 8), pb2 = AW_PK(c11, 0), pb3 = AW_PK(c11, 8); \
        AW_VREAD(vB, 1, (ST) * 32768 + 16384); LGKM_WAIT(8); AW_PVM(vA, 0, pb0, pb1, pb2, pb3); \
        AW_VREAD(vA, 2, (ST) * 32768 + 16384); LGKM_WAIT(8); AW_PVM(vB, 1, pb0, pb1, pb2, pb3); \
        AW_VREAD(vB, 3, (ST) * 32768 + 16384); LGKM_WAIT(8); AW_PVM(vA, 2, pb0, pb1, pb2, pb3); \
        LGKM_WAIT(0); AW_PVM(vB, 3, pb0, pb1, pb2, pb3); \
        asm volatile("s_waitcnt vmcnt(0)" ::: "memory"); __syncthreads(); } while (0)
    for (int j = 0; j < ns; j += 2) {
        AW_STEP(j, 0);
        if (j + 1 < ns) AW_STEP(j + 1, 1);
    }
#undef ka
#undef va
#undef AW_TROW
#undef AW_DMA1
#undef AW_DMA
#undef AW_KREAD
#undef AW_QKM0
#undef AW_QKM1
#undef AW_VREAD
#undef AW_PVM
#undef AW_PK
#undef AW_STEP
    l += __shfl_xor(l, 32);
    l_out = l;
}
template <int VAR> DI void ph_attn_b(LAS unsigned char* lds, const bf16* P, bf16* OB, const float* dnw, float lam, float lam_init, bool with_ctx, int vcu, int G) {
    const int lane = tid_opaque() & 63, wave = __builtin_amdgcn_readfirstlane(tid_opaque() >> 6), r32 = lane & 31, hi = lane >> 5;
    const int nun = 512 + (with_ctx ? 16 : 0);
    LAS float* XB = (LAS float*)lds;
    for (int u = vcu; u < nun; u += G) {
        AttnJob J; int b, h, q0; const bool cq = u >= 512; const int qs = wave & 3, comp = wave >> 2;
        if (!cq) { b = u >> 8; h = (u >> 6) & 3; q0 = (u & 63) * 128; J.seg0_row = b * SEQ; J.n0 = 128; J.qrow = b * SEQ + q0 + 32 * qs; }
        else { const int v = u - 512; b = v >> 3; h = (v >> 1) & 3; q0 = (v & 1) * 128; J.seg0_row = 0; J.n0 = 0; J.qrow = NLAT + b * CTXL + q0 + 32 * qs; }
        J.seg0_kpos0 = 0; J.qpos0 = 0;
        J.qcol = C_BQ + h * 128 + comp * 64; J.kcolT = C_BK + h * 128; J.vcolT = C_BV + h * 128; J.kc8 = comp * 8; J.seg1_row = NLAT + b * CTXL; J.n1 = 4;
        f32x16 O[4]; float l;
        if (VAR == 64 || AB_WIDE) attn_b_run_w(lds, P, J, O, l); else attn_b_run<VAR>(lds, P, J, O, l);
        const float inv = 1.f / l;
        if (comp == 1) {
#pragma unroll
            for (int d = 0; d < 4; ++d)
#pragma unroll
                for (int r = 0; r < 16; ++r) XB[(qs * 128 + 32 * d + crow(r, hi)) * 32 + r32] = O[d][r] * inv;
        }
        __syncthreads();
        if (comp == 0) {
            float ss = 0.f;
#pragma unroll
            for (int d = 0; d < 4; ++d)
#pragma unroll
                for (int r = 0; r < 16; ++r) { const float o = O[d][r] * inv - lam * XB[(qs * 128 + 32 * d + crow(r, hi)) * 32 + r32]; O[d][r] = o; ss += o * o; }
            ss += __shfl_xor(ss, 32);
            const float rs = rsqrtf(ss * (1.f / 128.f) + RMS_EPS) * (1.f - lam_init);
            bf16* op = OB + (size_t)(J.qrow + r32) * 1536 + h * 128;
#pragma unroll
            for (int d = 0; d < 4; ++d)
#pragma unroll
                for (int rg = 0; rg < 4; ++rg) { const int e0 = 32 * d + 8 * rg + 4 * hi; const f32x4 wv = *(const GAS f32x4*)(dnw + e0);
                    u32x2 w; w.x = cvtpk(O[d][4 * rg] * rs * wv[0], O[d][4 * rg + 1] * rs * wv[1]); w.y = cvtpk(O[d][4 * rg + 2] * rs * wv[2], O[d][4 * rg + 3] * rs * wv[3]);
                    *(GAS u32x2*)(op + e0) = w; }
        }
        __syncthreads();
    }
}

DI int hg_row0(int b, int dir, int c) {
    if (dir == 0) return c < 4 ? NLAT + b * CTXL + 64 * c : b * SEQ + 64 * (c - 4);
    return c < 4 ? NLAT + b * CTXL + 64 * (3 - c) : b * SEQ + 64 * (131 - c);
}
DI void glds16(const void* src, LAS unsigned char* dst) { __builtin_amdgcn_global_load_lds((const unsigned*)src, (LAS unsigned*)dst, 16, 0, 0); }
DI void ph_hg1(LAS unsigned char* lds, const bf16* P, const float* LF, bf16* HU, float* HD, int vcu, int G) {
    const int tid = tid_opaque(), lane = tid & 63, wave = __builtin_amdgcn_readfirstlane(tid >> 6), r32 = lane & 31, hi = lane >> 5;
    LAS float* LFs = (LAS float*)lds; LAS unsigned char* Vs = lds + 32768; LAS unsigned char* KH = lds + 49152; LAS float* TOT = (LAS float*)(lds + 65536);
    for (int u = vcu; u < NB * 2 * NCH * 4; u += G) {
        const int h = u & 3, c = (u >> 2) % NCH, dir = ((u >> 2) / NCH) & 1, b = (u >> 2) / (2 * NCH), row0 = hg_row0(b, dir, c);
        const int uidx = ((b * 2 + dir) * 4 + h) * NCH + c;
#pragma unroll
        for (int i = 0; i < 4; ++i) { const int slot = 4 * wave + i, row = 2 * slot + (lane >> 5), ch = lane & 31;
            glds16(LF + (size_t)(row0 + row) * 1024 + dir * 512 + h * 128 + ch * 4, lds + slot * 1024); }
#pragma unroll
        for (int i = 0; i < 2; ++i) { const int slot = 2 * wave + i, row = 4 * slot + (lane >> 4), cp = lane & 15, sc = ((((cp >> 2) ^ (row & 3)) << 2) | (cp & 3));
            glds16(P + (size_t)(row0 + row) * INW + C_CI + h * 128 + sc * 8, Vs + slot * 1024); }
        asm volatile("s_waitcnt vmcnt(0)" ::: "memory"); __syncthreads();
        const int d = tid & 127, q = tid >> 7;
        float lf[16]; float sum = 0.f;
#pragma unroll
        for (int j = 0; j < 16; ++j) { lf[j] = LFs[(16 * q + j) * 128 + d]; sum += lf[j]; }
        TOT[q * 128 + d] = sum;
        __syncthreads();
        const float t0 = TOT[d], t1 = TOT[128 + d], t2 = TOT[256 + d], t3 = TOT[384 + d], total = (t0 + t1) + (t2 + t3);
        float pre = (q > 0 ? t0 : 0.f) + (q > 1 ? t1 : 0.f) + (q > 2 ? t2 : 0.f);
        float kv[16];
#pragma unroll
        for (int j = 0; j < 16; ++j) { const float arg = dir == 0 ? (total - pre - lf[j]) : pre; pre += lf[j]; kv[j] = (1.f - __expf(lf[j])) * __expf(arg); }
        *(LAS bf16x8*)(KH + d * 128 + (((2 * q) ^ ((d >> 1) & 7)) << 4)) = pack8(kv[0], kv[1], kv[2], kv[3], kv[4], kv[5], kv[6], kv[7]);
        *(LAS bf16x8*)(KH + d * 128 + (((2 * q + 1) ^ ((d >> 1) & 7)) << 4)) = pack8(kv[8], kv[9], kv[10], kv[11], kv[12], kv[13], kv[14], kv[15]);
        if (q == 0) HD[(size_t)uidx * 128 + d] = __expf(total);
        __syncthreads();
        const int eb = wave & 3, dkb0 = 2 * (wave >> 2), q4 = (lane & 15) >> 2, p4 = lane & 3, blk = (lane >> 4) & 1;
        f32x16 acc[2]; acc[0] = SPLAT16(0.f); acc[1] = SPLAT16(0.f);
#pragma unroll
        for (int ks = 0; ks < 4; ++ks) {
            const int r0 = 16 * ks + 8 * hi + q4, r1 = r0 + 4;
            const s16x4 lo = tr_read((LAS const char*)(Vs + r0 * 256 + (((eb ^ (r0 & 3)) << 6) | (blk << 5) | (p4 << 3))));
            const s16x4 hh = tr_read((LAS const char*)(Vs + r1 * 256 + (((eb ^ (r1 & 3)) << 6) | (blk << 5) | (p4 << 3))));
            const bf16x8 vf = cat8(lo, hh);
#pragma unroll
            for (int j = 0; j < 2; ++j) { const int R = 32 * (dkb0 + j) + r32, ch = 2 * ks + hi;
                const bf16x8 kf = *(const LAS bf16x8*)(KH + R * 128 + ((ch ^ ((R >> 1) & 7)) << 4));
                acc[j] = MFMA32(vf, kf, acc[j]); }
        }
        bf16* hu = HU + (size_t)uidx * 16384;
#pragma unroll
        for (int j = 0; j < 2; ++j)
#pragma unroll
            for (int r = 0; r < 16; ++r) hu[(32 * eb + crow(r, hi)) * 128 + 32 * (dkb0 + j) + r32] = (bf16)(cvtpk(acc[j][r], 0.f) & 0xffffu);
        __syncthreads();
    }
}
DI void ph_hg2(const bf16* HU, const float* HD, bf16* HS, int vcu, int G) {
    const int gt = vcu * NTHR + tid_opaque(), NT = G * NTHR;
    for (int idx = gt; idx < 16 * 8192; idx += NT) {
        const int chain = idx >> 13, pr = idx & 8191, e = pr >> 6, dk = (pr & 63) * 2;
        const bf16* up = HU + (size_t)chain * NCH * 16384 + e * 128 + dk; const float* dp = HD + (size_t)chain * NCH * 128 + dk; bf16* sp = HS + (size_t)chain * NCH * 16384 + e * 128 + dk;
        float s0 = 0.f, s1 = 0.f;
        for (int c0 = 0; c0 < NCH; c0 += 22) {
            unsigned uu[22]; f32x2 dd[22];
#pragma unroll
            for (int j = 0; j < 22; ++j) { uu[j] = *(const GAS unsigned*)(up + (size_t)(c0 + j) * 16384); dd[j] = *(const GAS f32x2*)(dp + (size_t)(c0 + j) * 128); }
#pragma unroll
            for (int j = 0; j < 22; ++j) { *(GAS unsigned*)(sp + (size_t)(c0 + j) * 16384) = cvtpk(s0, s1); s0 = dd[j].x * s0 + bflo(uu[j]); s1 = dd[j].y * s1 + bfhi(uu[j]); }
        }
    }
}
DI void ph_hg3(LAS unsigned char* lds, const bf16* P, const float* LF, const bf16* HS, bf16* OC, const float* hw, bool with_ctx, int vcu, int G, int probe_mode = 0) {
    const int tid = tid_opaque(), lane = tid & 63, wave = __builtin_amdgcn_readfirstlane(tid >> 6), tl = lane & 15, kg = lane >> 4;
    LAS float* BC = (LAS float*)lds; LAS unsigned char* VT = lds + 65536; LAS unsigned char* HSs = lds + 81920; LAS float* CB = (LAS float*)(lds + 81920);
    const int tc_lo = with_ctx ? 0 : 4, ntc = NCH - tc_lo, nun = NB * ntc * 4;
    for (int u = vcu; u < nun; u += G) {
        const int b = u / (ntc * 4), tc = tc_lo + (u / 4) % ntc, h = u & 3;
        const int row0 = tc < 4 ? NLAT + b * CTXL + 64 * tc : b * SEQ + 64 * (tc - 4);
        const int dir = wave >> 2, I = wave & 3, t = 16 * I + tl;
        v4u qw[4];
#pragma unroll
        for (int ks = 0; ks < 4; ++ks) qw[ks] = *(const GAS v4u*)(P + (size_t)(row0 + t) * INW + C_CQ + h * 128 + 32 * ks + 8 * kg);
        u32x2 gwv[8];
#pragma unroll
        for (int eb = 0; eb < 8; ++eb) gwv[eb] = *(const GAS u32x2*)(P + (size_t)(row0 + t) * INW + C_CG + h * 128 + 16 * eb + 4 * kg);
#pragma unroll
        for (int i = 0; i < 8; ++i) { const int slot = 8 * wave + i, dd = slot >> 5, row = 2 * (slot & 31) + (lane >> 5), ch = lane & 31;
            glds16(LF + (size_t)(row0 + row) * 1024 + dd * 512 + h * 128 + ch * 4, lds + slot * 1024); }
#pragma unroll
        for (int i = 0; i < 2; ++i) { const int slot = 2 * wave + i, row = 4 * slot + (lane >> 4), cp = lane & 15, sc = ((((cp >> 2) ^ (row & 3)) << 2) | (cp & 3));
            glds16(P + (size_t)(row0 + row) * INW + C_CI + h * 128 + sc * 8, VT + slot * 1024); }
#pragma unroll
        for (int i = 0; i < 8; ++i) { const int slot = 8 * wave + i, dd = slot >> 5, row = 4 * (slot & 31) + (lane >> 4), cp = lane & 15;
            const int cs = dd == 0 ? tc : (tc < 4 ? 3 - tc : 135 - tc);
            glds16(HS + ((size_t)(((b * 2 + dd) * 4 + h) * NCH + cs) * 128 + row) * 128 + ((cp ^ (row & 15)) << 3), HSs + slot * 1024); }
        asm volatile("s_waitcnt vmcnt(0)" ::: "memory"); __syncthreads();
        if (probe_mode == 1) { asm volatile("" :: "v"(qw[0]), "v"(qw[3])); __syncthreads(); continue; }
        if (tid < 256) { const int dd = tid >> 7, d = tid & 127; LAS float* col = BC + dd * 8192 + d; float v[64];
#pragma unroll
            for (int j = 0; j < 64; ++j) v[j] = col[j * 128];
            float a = 0.f;
            if (dd == 0) {
#pragma unroll
                for (int j = 0; j < 64; ++j) { a += v[j]; col[j * 128] = a; }
            } else {
#pragma unroll
                for (int j = 63; j >= 0; --j) { a += v[j]; col[j * 128] = a; }
            }
        }
        __syncthreads();
        if (probe_mode == 2) { asm volatile("" :: "v"(qw[0]), "v"(qw[3])); continue; }
        const LAS float* bc = BC + dir * 8192;
        const bool hasb = dir == 0 ? (I > 0) : (I < 3); const int brow = dir == 0 ? 16 * I - 1 : 16 * I + 16;
        bf16x8 qh[4], qt[4];
#pragma unroll
        for (int ks = 0; ks < 4; ++ks) { const int dk0 = 32 * ks + 8 * kg;
            const f32x4 b0 = *(const LAS f32x4*)(bc + t * 128 + dk0), b1 = *(const LAS f32x4*)(bc + t * 128 + dk0 + 4);
            f32x4 e0 = (f32x4){0.f, 0.f, 0.f, 0.f}, e1 = e0; if (hasb) { e0 = *(const LAS f32x4*)(bc + brow * 128 + dk0); e1 = *(const LAS f32x4*)(bc + brow * 128 + dk0 + 4); }
            const float q0 = bflo(qw[ks].x), q1 = bfhi(qw[ks].x), q2 = bflo(qw[ks].y), q3 = bfhi(qw[ks].y), q4 = bflo(qw[ks].z), q5 = bfhi(qw[ks].z), q6 = bflo(qw[ks].w), q7 = bfhi(qw[ks].w);
            qh[ks] = pack8(q0 * __expf(b0[0]), q1 * __expf(b0[1]), q2 * __expf(b0[2]), q3 * __expf(b0[3]), q4 * __expf(b1[0]), q5 * __expf(b1[1]), q6 * __expf(b1[2]), q7 * __expf(b1[3]));
            qt[ks] = pack8(q0 * __expf(b0[0] - e0[0]), q1 * __expf(b0[1] - e0[1]), q2 * __expf(b0[2] - e0[2]), q3 * __expf(b0[3] - e0[3]),
                           q4 * __expf(b1[0] - e1[0]), q5 * __expf(b1[1] - e1[1]), q6 * __expf(b1[2] - e1[2]), q7 * __expf(b1[3] - e1[3])); }
        f32x4 acc[8];
#pragma unroll
        for (int eb = 0; eb < 8; ++eb) acc[eb] = (f32x4){0.f, 0.f, 0.f, 0.f};
#pragma unroll
        for (int ks = 0; ks < 4; ++ks)
#pragma unroll
            for (int eb = 0; eb < 8; ++eb) { const int er = 16 * eb + tl;
                const bf16x8 sf = *(const LAS bf16x8*)(HSs + dir * 32768 + er * 256 + (((4 * ks + kg) ^ (er & 15)) << 4)); acc[eb] = MFMA16(sf, qh[ks], acc[eb]); }
        if (probe_mode == 3) { asm volatile("" :: "v"(acc[0]), "v"(acc[7]), "v"(qt[0]), "v"(qt[3])); __syncthreads(); continue; }
        f32x4 att[4];
#pragma unroll
        for (int Jb = 0; Jb < 4; ++Jb) {
            att[Jb] = (f32x4){0.f, 0.f, 0.f, 0.f};
            const bool active = dir == 0 ? (Jb <= I) : (Jb >= I);
            if (active) {
                const int s = 16 * Jb + tl; f32x4 a = (f32x4){0.f, 0.f, 0.f, 0.f};
                const int sp = dir == 0 ? s - 1 : s + 1; const bool hasp = dir == 0 ? (s > 0) : (s < 63);
#pragma unroll
                for (int ks = 0; ks < 4; ++ks) { const int dk0 = 32 * ks + 8 * kg;
                    const f32x4 b0 = *(const LAS f32x4*)(bc + s * 128 + dk0), b1 = *(const LAS f32x4*)(bc + s * 128 + dk0 + 4);
                    f32x4 p0 = (f32x4){0.f, 0.f, 0.f, 0.f}, p1 = p0; if (hasp) { p0 = *(const LAS f32x4*)(bc + sp * 128 + dk0); p1 = *(const LAS f32x4*)(bc + sp * 128 + dk0 + 4); }
                    f32x4 e0 = (f32x4){0.f, 0.f, 0.f, 0.f}, e1 = e0; if (hasb) { e0 = *(const LAS f32x4*)(bc + brow * 128 + dk0); e1 = *(const LAS f32x4*)(bc + brow * 128 + dk0 + 4); }
                    float kv[8];
#pragma unroll
                    for (int j = 0; j < 4; ++j) { kv[j] = (1.f - __expf(b0[j] - p0[j])) * __expf(fminf(e0[j] - b0[j], 80.f)); kv[4 + j] = (1.f - __expf(b1[j] - p1[j])) * __expf(fminf(e1[j] - b1[j], 80.f)); }
                    a = MFMA16(pack8(kv[0], kv[1], kv[2], kv[3], kv[4], kv[5], kv[6], kv[7]), qt[ks], a); }
                if (Jb == I) {
#pragma unroll
                    for (int r = 0; r < 4; ++r) { const int sl = 4 * kg + r; const bool keep = dir == 0 ? (sl <= tl) : (sl >= tl); if (!keep) a[r] = 0.f; }
                }
                att[Jb] = a;
            }
        }
        if (probe_mode == 4) { asm volatile("" :: "v"(acc[0]), "v"(acc[7]), "v"(att[0]), "v"(att[1]), "v"(att[2]), "v"(att[3])); __syncthreads(); continue; }
        { const int q4 = tl >> 2, p4 = tl & 3;
#pragma unroll
            for (int pr = 0; pr < 2; ++pr) {
                const bool any = dir == 0 ? (2 * pr <= I) : (2 * pr + 1 >= I);
                if (any) {
                    const f32x4 a0 = att[2 * pr], a1 = att[2 * pr + 1];
                    const bf16x8 ab = pack8(a0[0], a0[1], a0[2], a0[3], a1[0], a1[1], a1[2], a1[3]);
                    const int r0 = 32 * pr + 4 * kg + q4, r1 = r0 + 16;
#pragma unroll
                    for (int eb = 0; eb < 8; ++eb) {
                        const s16x4 lo = tr_read((LAS const char*)(VT + r0 * 256 + ((((eb >> 1) ^ (r0 & 3)) << 6) | ((eb & 1) << 5) | (p4 << 3))));
                        const s16x4 hh = tr_read((LAS const char*)(VT + r1 * 256 + ((((eb >> 1) ^ (r1 & 3)) << 6) | ((eb & 1) << 5) | (p4 << 3))));
                        acc[eb] = MFMA16(cat8(lo, hh), ab, acc[eb]); }
                }
            }
        }
        __syncthreads();
        if (dir == 1) {
#pragma unroll
            for (int eb = 0; eb < 8; ++eb) *(LAS f32x4*)(CB + ((I * 16 + tl) * 128 + 16 * eb + 4 * kg)) = acc[eb];
        }
        __syncthreads();
        if (dir == 0) {
            float ss = 0.f;
#pragma unroll
            for (int eb = 0; eb < 8; ++eb) { acc[eb] = acc[eb] + *(const LAS f32x4*)(CB + ((I * 16 + tl) * 128 + 16 * eb + 4 * kg)); ss += (acc[eb][0] * acc[eb][0] + acc[eb][1] * acc[eb][1]) + (acc[eb][2] * acc[eb][2] + acc[eb][3] * acc[eb][3]); }
            ss += __shfl_xor(ss, 16); ss += __shfl_xor(ss, 32);
            const float rs = rsqrtf(ss * (1.f / 128.f) + RMS_EPS);
#pragma unroll
            for (int eb = 0; eb < 8; ++eb) { const int e0 = 16 * eb + 4 * kg; const f32x4 wv = *(const GAS f32x4*)(hw + e0);
                const u32x2 gw = gwv[eb];
                u32x2 w; w.x = cvtpk(acc[eb][0] * rs * wv[0] * bflo(gw.x), acc[eb][1] * rs * wv[1] * bfhi(gw.x)); w.y = cvtpk(acc[eb][2] * rs * wv[2] * bflo(gw.y), acc[eb][3] * rs * wv[3] * bfhi(gw.y));
                *(GAS u32x2*)(OC + (size_t)(row0 + t) * 1536 + h * 128 + e0) = w; }
        }
        __syncthreads();
    }
}

#define R2_PROBE_NOROUTER 0
DI void ph_r2(LAS unsigned char* lds, const float* xin, const float* cin, float* XA, const float* XA2, bool do_route, const bf16* YO, unsigned char* H, const float* MODl, const float* ng, const float* wr, const float* br,
              unsigned* cnt, int* TOPE, float* GATE, int* RANK, int l, int nrows, int vcu, int G) {
    const int tid = tid_opaque(), lane = tid & 63, wave = __builtin_amdgcn_readfirstlane(tid >> 6);
    for (int i = tid; i < 1024 * 8; i += NTHR) { const int k = i >> 3, ch = i & 7, slot = ((k >> 8) * 4 + (k & 3)) * 64 + ((k >> 2) & 63);
        *(LAS f32x4*)(lds + slot * 128 + ((ch ^ (slot & 7)) << 4)) = *(const GAS f32x4*)(wr + k * 32 + ch * 4); }
    __syncthreads();
    for (int row = vcu * NWAVES + wave; row < nrows; row += G * NWAVES) {
        const int mj = row < NLAT ? row / SEQ : 2; const float* md = MODl + mj * 6144;
        const float* xp = (l == 0) ? (row < NLAT ? xin + (size_t)row * 1024 : cin + (size_t)(row - NLAT) * 1024) : XA2 + (size_t)row * 1024;
        f32x4 x[4], y[4]; row_ld(xp, lane, x); row_ld_bf(YO + (size_t)row * 1024, lane, y);
        const float ry = row_rstd(y);
#pragma unroll
        for (int j = 0; j < 4; ++j) { const f32x4 g1 = ((const GAS f32x4*)(ng + 1024))[lane + 64 * j], m2 = ((const GAS f32x4*)(md + 2048))[lane + 64 * j]; x[j] = x[j] + m2 * (y[j] * ry * g1); }
        row_st(XA + (size_t)row * 1024, lane, x);
        f32x4 h[4]; row_modulate(x, ng + 2048, md + 3 * 1024, md + 4 * 1024, lane, h);
        row_st_f8(H + (size_t)row * 1024, lane, h, F8_ACT);
        if (R2_PROBE_NOROUTER && !do_route) continue;
        float acc[32];
#pragma unroll
        for (int e = 0; e < 32; ++e) acc[e] = 0.f;
        f32x4 wA[8], wB[8];
#define R2_WLD(W, S) do { const int slot_ = (S) * 64 + lane; _Pragma("unroll") for (int ch = 0; ch < 8; ++ch) W[ch] = *(const LAS f32x4*)(lds + slot_ * 128 + ((ch ^ (slot_ & 7)) << 4)); } while (0)
#define R2_FMA(W, HV) do { const float hv_ = (HV); _Pragma("unroll") for (int ch = 0; ch < 8; ++ch) { acc[4 * ch] += hv_ * W[ch][0]; acc[4 * ch + 1] += hv_ * W[ch][1]; acc[4 * ch + 2] += hv_ * W[ch][2]; acc[4 * ch + 3] += hv_ * W[ch][3]; } } while (0)
        R2_WLD(wA, 0);
#pragma unroll
        for (int s2 = 0; s2 < 8; ++s2) {
            R2_WLD(wB, 2 * s2 + 1); R2_FMA(wA, h[(2 * s2) >> 2][(2 * s2) & 3]); __builtin_amdgcn_sched_barrier(0);
            if (s2 < 7) R2_WLD(wA, 2 * s2 + 2); R2_FMA(wB, h[(2 * s2 + 1) >> 2][(2 * s2 + 1) & 3]); __builtin_amdgcn_sched_barrier(0);
        }
#undef R2_WLD
#undef R2_FMA
#define R2_STEP(N, BIT) _Pragma("unroll") for (int i = 0; i < N; ++i) { const float lo = acc[i], hi = acc[i + N]; const bool up = (lane & BIT) != 0; const float keep = up ? hi : lo, send = up ? lo : hi; acc[i] = keep + __shfl_xor(send, BIT); }
        R2_STEP(16, 32) R2_STEP(8, 16) R2_STEP(4, 8) R2_STEP(2, 4) R2_STEP(1, 2)
#undef R2_STEP
        const int me = (lane >> 1) & 31;
        const float lg = acc[0] + __shfl_xor(acc[0], 1) + br[me];
        const unsigned lb_ = __float_as_uint(lg);
        unsigned key = ((lb_ ^ (unsigned)(((int)lb_ >> 31) | 0x80000000)) & ~31u) | (unsigned)(31 - me);
        float tv[4]; int te[4];
#pragma unroll
        for (int k = 0; k < 4; ++k) {
            unsigned r = key;
            r = max(r, (unsigned)__builtin_amdgcn_update_dpp(0, (int)r, 0xB1, 0xF, 0xF, true));
            r = max(r, (unsigned)__builtin_amdgcn_update_dpp(0, (int)r, 0x4E, 0xF, 0xF, true));
            r = max(r, (unsigned)__builtin_amdgcn_update_dpp(0, (int)r, 0x141, 0xF, 0xF, true));
            r = max(r, (unsigned)__builtin_amdgcn_update_dpp(0, (int)r, 0x140, 0xF, 0xF, true));
            const unsigned r0 = (unsigned)__builtin_amdgcn_readlane((int)r, 0), r1 = (unsigned)__builtin_amdgcn_readlane((int)r, 16), r2 = (unsigned)__builtin_amdgcn_readlane((int)r, 32), r3 = (unsigned)__builtin_amdgcn_readlane((int)r, 48);
            const unsigned km = max(max(r0, r1), max(r2, r3));
            const int idx = 31 - (int)(km & 31u);
            te[k] = idx; tv[k] = __uint_as_float((unsigned)__builtin_amdgcn_readlane((int)lb_, 2 * idx));
            if (me == idx) key = 0u;
        }
        const float e1 = __expf(tv[1] - tv[0]), e2 = __expf(tv[2] - tv[0]), e3 = __expf(tv[3] - tv[0]), inv = 1.f / (1.f + e1 + e2 + e3);
        if (do_route && lane < 4) { const int ek = lane == 0 ? te[0] : lane == 1 ? te[1] : lane == 2 ? te[2] : te[3]; const float gk = (lane == 0 ? 1.f : lane == 1 ? e1 : lane == 2 ? e2 : e3) * inv;
            const unsigned rk = atomicAdd(cnt + ek, 1u);
            TOPE[row * 4 + lane] = ek; GATE[row * 4 + lane] = gk; RANK[row * 4 + lane] = (int)rk; }
    }
}
DI void moe_tables(volatile LAS int* tb, const unsigned* cnt) {
    if (tid_opaque() == 0) { int t = 0;
        for (int e = 0; e < 32; ++e) { const int c = (int)__hip_atomic_load(cnt + e, __ATOMIC_RELAXED, __HIP_MEMORY_SCOPE_AGENT); tb[e] = t; tb[40 + e] = t * 256; t += (c + 255) >> 8; }
        tb[32] = t; }
    __syncthreads();
}
DI void ph_r3(volatile LAS int* tb, const unsigned char* H, unsigned char* XG, const int* TOPE, const int* RANK, int* DEST, int nrows, int vcu, int G) {
    const int lane = tid_opaque() & 63, wave = __builtin_amdgcn_readfirstlane(tid_opaque() >> 6);
    for (int row0 = (vcu * NWAVES + wave) * 4; row0 < nrows; row0 += G * NWAVES * 4) {
        v4u h0[4]; int ek[4], rk[4];
#pragma unroll
        for (int q = 0; q < 4; ++q) { h0[q] = ((const GAS v4u*)(H + (size_t)(row0 + q) * 1024))[lane]; ek[q] = TOPE[(row0 + q) * 4 + (lane & 3)]; rk[q] = RANK[(row0 + q) * 4 + (lane & 3)]; }
#pragma unroll
        for (int q = 0; q < 4; ++q) { const int dl = tb[40 + ek[q]] + rk[q];
            if (lane < 4) DEST[(row0 + q) * 4 + lane] = dl;
#pragma unroll
            for (int k = 0; k < 4; ++k) { const int d = __builtin_amdgcn_readlane(dl, k); ((GAS v4u*)(XG + (size_t)d * 1024))[lane] = h0[q]; } }
    }
}
DI void ph_r4(const float* XA, float* XA2, const bf16* YS, const int* DEST, const float* GATE, const float* MODl, const float* ng, float* out, unsigned char* H, bf16* HBn, const float* MODn, const float* ngn, bool last, int nrows, int vcu, int G) {
    const int lane = tid_opaque() & 63, wave = __builtin_amdgcn_readfirstlane(tid_opaque() >> 6);
    for (int row0 = (vcu * NWAVES + wave) * 2; row0 < nrows; row0 += G * NWAVES * 2) {
        f32x4 f[2][4], x[2][4]; float gk[2][4]; int dk[2][4];
#pragma unroll
        for (int q = 0; q < 2; ++q) { const int row = row0 + q;
#pragma unroll
            for (int k = 0; k < 4; ++k) { dk[q][k] = DEST[row * 4 + k]; gk[q][k] = GATE[row * 4 + k]; }
            row_ld(XA + (size_t)row * 1024, lane, x[q]); }
#pragma unroll
        for (int q = 0; q < 2; ++q) {
#pragma unroll
            for (int j = 0; j < 4; ++j) f[q][j] = (f32x4){0.f, 0.f, 0.f, 0.f};
#pragma unroll
            for (int k = 0; k < 4; ++k) { f32x4 y[4]; row_ld_bf(YS + (size_t)dk[q][k] * 1024, lane, y);
#pragma unroll
                for (int j = 0; j < 4; ++j) f[q][j] = f[q][j] + y[j] * gk[q][k]; } }
#pragma unroll
        for (int q = 0; q < 2; ++q) { const int row = row0 + q;
            const int mj = row < NLAT ? row / SEQ : 2; const float* md = MODl + mj * 6144;
            const float rf = row_rstd(f[q]);
#pragma unroll
            for (int j = 0; j < 4; ++j) { const f32x4 g3 = ((const GAS f32x4*)(ng + 3 * 1024))[lane + 64 * j], m5 = ((const GAS f32x4*)(md + 5 * 1024))[lane + 64 * j]; x[q][j] = x[q][j] + m5 * (f[q][j] * rf * g3); }
            if (last) row_st(out + (size_t)row * 1024, lane, x[q]);
            else { row_st(XA2 + (size_t)row * 1024, lane, x[q]);
                f32x4 h[4]; row_modulate(x[q], ngn, MODn + mj * 6144, MODn + mj * 6144 + 1024, lane, h); if (INP_FP8 || INP_L1_FP8) row_st_f8(H + (size_t)row * 1024, lane, h, F8_ACT); if (!INP_FP8) row_st_bf(HBn + (size_t)row * 1024, lane, h); } }
    }
}

#define PROF_MASK 0
#define AB_PROBE -1
#define GEMM_PROBE 0
#define HG3_PROBE 0
#define TS_SEL -1
#define TSB(id) do { if (TS_SEL == (id) && bx == 0 && tid_opaque() == 0) tsum -= (long long)rt(); } while (0)
#define TSE(id) do { if (TS_SEL == (id) && bx == 0 && tid_opaque() == 0) tsum += (long long)rt(); } while (0)
#define REP(bit) for (int rep_ = 0; rep_ < (((PROF_MASK) >> (bit)) & 1 ? 2 : 1); ++rep_)
#ifndef PHM
#define PHM 0x7fff
#endif
struct Args { const float* in[21]; float* out; unsigned char* ws; };
__global__ void __launch_bounds__(NTHR, 2) fwd_mega(Args a) {
    extern __shared__ __attribute__((aligned(16))) unsigned char lds_raw[];
    LAS unsigned char* lds = (LAS unsigned char*)lds_raw;
    volatile LAS unsigned* MISC = (volatile LAS unsigned*)(lds + MISC_OFF);
    volatile LAS int* MTB = (volatile LAS int*)(lds + MISC_OFF + 256);
    const int G = gridDim.x, bx = blockIdx.x, vcu = (G % 8 == 0) ? (bx % 8) * (G / 8) + bx / 8 : bx;
#define AS4 __attribute__((address_space(4)))
#define KARGS() ({ const AS4 char* kp_ = (const AS4 char*)__builtin_amdgcn_kernarg_segment_ptr(); asm volatile("" : "+s"(kp_)); kp_; })
#define IN(i) (*(const float* const AS4*)(KARGS() + 8 * (i)))
#define WSB() (*(unsigned char* const AS4*)(KARGS() + 176))
#define OUTP() (*(float* const AS4*)(KARGS() + 168))
#define ctl ((gu32*)(WSB() + WS_CTL))
#define SM ((float*)(WSB() + WS_SMALL))
#define WIN ((bf16*)(WSB() + WS_WIN))
#define WIN8 ((bf16*)(WSB() + WS_WIN8))
#define WINB ((bf16*)(WSB() + WS_WIN + 16 * MiB))
#define WBR ((bf16*)(WSB() + WS_WBR))
#define WO ((bf16*)(WSB() + WS_WO))
#define WGU ((bf16*)(WSB() + WS_WGU))
#define WDN ((bf16*)(WSB() + WS_WDN))
#define XA ((float*)(WSB() + WS_XA))
#define XA2 ((float*)(WSB() + WS_XA2))
#define H ((unsigned char*)(WSB() + WS_YF))
#define HB ((bf16*)(WSB() + WS_H))
#define P ((bf16*)(WSB() + WS_P))
#define LF ((float*)(WSB() + WS_LF))
#define O3 ((bf16*)(WSB() + WS_O3))
#define HU ((bf16*)(WSB() + WS_HU))
#define HD ((float*)(WSB() + WS_HD))
#define HS ((bf16*)(WSB() + WS_HS))
#define Y ((bf16*)(WSB() + WS_Y))
#define YO ((bf16*)(WSB() + WS_YO))
#define TOPE ((int*)(WSB() + WS_ROUTE))
#define GATE ((float*)(WSB() + WS_ROUTE + 524288 * 1))
#define RANK ((int*)(WSB() + WS_ROUTE + 524288 * 2))
#define DEST ((int*)(WSB() + WS_ROUTE + 524288 * 3))
#define XG ((unsigned char*)(WSB() + WS_XG))
#define ACT ((unsigned char*)(WSB() + WS_ACT))
#define YS ((bf16*)(WSB() + WS_YS))
#define x_in IN(0)
#define c_in IN(1)
#define ctx_in IN(2)
#define cctx_in IN(3)

    for (int u = tid_opaque(); u < (LDS_BYTES - LDSCTL_OFF) / 4; u += NTHR) ((LAS unsigned*)(lds + LDSCTL_OFF))[u] = 0u;
    __syncthreads();
    XcdBarrier bar = xcd_barrier_post((unsigned*)(ctl + CW_BAR), MISC + 8);
long long tsum = 0;
#define GRID_BAR() do { TSB(30); xcd_barrier(bar); TSE(30); } while (0)

    REP(0) if (PHM & 1) ph_mod(lds, c_in, cctx_in, IN(4), IN(5), SM + SM_MOD, vcu, G);
    if (PHM & 1) ph_tables(SM, IN(11), IN(9), vcu, G);
    GRID_BAR();
    REP(1) if (PHM & 2) {
        const int lane = tid_opaque() & 63, wave = __builtin_amdgcn_readfirstlane(tid_opaque() >> 6);
        LAS float* scr = (LAS float*)(lds + wave * 16384);
        const int gw = vcu * NWAVES + wave, NGW = G * NWAVES;
        const TGroup g0{IN(7), WIN, 1024, INW, 2, 0, 1, INP_FP8, 0}, g1{IN(13), WBR, 512, 1024, 6, 0, 3, 0, 0}, g2{IN(14), WO, 1024, 1024, 2, 0, 1, 0, 0}, g3{IN(17), WGU, 1024, 2048, 64, 1, 1, 1, 0}, g4{IN(19), WDN, 1024, 1024, 64, 0, 1, 1, 0}, g5{IN(7), WIN8, 1024, INW, 2, 0, 1, 1, 0};
        const int total = 2 * 16 * 248 + 6 * 8 * 32 + 2 * 16 * 32 + 64 * 16 * 64 + 64 * 16 * 32 + (INP_L1_FP8 ? 2 * 16 * 248 : 0);
#define P0_DEC(it_, t_) do { int r_ = (it_); if (!p0_decode(g0, r_, t_)) if (!p0_decode(g1, r_, t_)) if (!p0_decode(g2, r_, t_)) if (!p0_decode(g3, r_, t_)) if (!p0_decode(g4, r_, t_)) p0_decode(g5, r_, t_); } while (0)
        {
            float wv[32]; TItem tc, tn;
            int it = gw;
            if (it < total) { P0_DEC(it, tc); p0_item_load(tc, lane, wv); }
            while (it < total) {
                p0_item_to_lds(scr, lane, wv);
                const int itn = it + NGW;
                if (itn < total) { P0_DEC(itn, tn); p0_item_load(tn, lane, wv); }
                LDS_WAIT(); asm volatile("" ::: "memory");
                p0_item_store(tc, scr, lane);
                LDS_WAIT(); asm volatile("" ::: "memory");
                tc = tn; it = itn;
            }
        }
        const float* ng = IN(6);
        for (int row = gw; row < NTOK; row += NGW) { const int mj = row < NLAT ? row / SEQ : 2; const float* md = SM + SM_MOD + mj * 6144;
            const float* xp = row < NLAT ? x_in + (size_t)row * 1024 : ctx_in + (size_t)(row - NLAT) * 1024;
            f32x4 x[4], h[4]; row_ld(xp, lane, x); row_modulate(x, ng, md, md + 1024, lane, h); if (INP_FP8) row_st_f8(H + (size_t)row * 1024, lane, h, F8_ACT); else row_st_bf(HB + (size_t)row * 1024, lane, h); }
    }
    GRID_BAR();

    for (int l = 0; l < DEPTH; ++l) {
        const bool last = (l == DEPTH - 1);
        const float* MODl = SM + SM_MOD + l * 3 * 6144;
        const float* ng = IN(6) + l * 4096;
        const int nrows = last ? NLAT : NTOK;
#if INP_L1_FP8
        if (l == 1) { pg8::Gemm g{(const bf16*)H, (const bf16*)((const unsigned char*)WIN8 + (size_t)l * INW * 1024), NTOK, INW, 1024}; pg8::StaticOrder S; S.init(NTOK, INW, G, bx);
          EpiIn E{P, LF, SM + SM_TAB, SM + SM_LB + l * 1024, 0, 1.f / (F8_ACT * F8_W)}; pg8::gemm_phase<EpiIn, pg8::StaticOrder, true, true, 1>(lds, g, S, E); } else
#endif
        REP(2) if (PHM & 4) {
          pg8::Gemm g{INP_FP8 ? (const bf16*)H : (const bf16*)HB, INP_FP8 ? (const bf16*)((const unsigned char*)WIN + (size_t)l * INW * 1024) : (const bf16*)(WIN + (size_t)l * INW * 1024), NTOK, INW, 1024};
          pg8::StaticOrder S; S.init(NTOK, INW, G, bx);
          EpiIn E{P, LF, SM + SM_TAB, SM + SM_LB + l * 1024, 0, INP_FP8 ? 1.f / (F8_ACT * F8_W) : 1.f};
          pg8::gemm_phase<EpiIn, pg8::StaticOrder, true, true, INP_FP8 ? 1 : 2>(lds, g, S, E); }
#if GEMM_PROBE == 7 || GEMM_PROBE == 8 || GEMM_PROBE == 9
        { pg8::Gemm g{(const bf16*)HB, (const bf16*)(WIN + (size_t)l * INW * 1024), NTOK, INW, 1024}; pg8::StaticOrder S; S.init(NTOK, INW, G, bx);
          EpiInT<GEMM_PROBE - 7> E{(bf16*)(WSB() + WS_HU), (float*)(WSB() + WS_HU + 256 * MiB), SM + SM_TAB, SM + SM_LB + l * 1024, 0, 1.f};
          pg8::gemm_phase<EpiInT<GEMM_PROBE - 7>, pg8::StaticOrder, true, true, 2>(lds, g, S, E); }
#endif
#if GEMM_PROBE == 1
        { pg8::Gemm g{(const bf16*)HB, (const bf16*)(WIN + (size_t)l * INW * 1024), NTOK, INW, 1024}; pg8::StaticOrder S; S.init(NTOK, INW, G, bx); EpiNull E{(float*)(WSB() + WS_YF)};
          pg8::gemm_phase<EpiNull, pg8::StaticOrder, true, true, 2>(lds, g, S, E); }
#endif
        GRID_BAR();
        REP(3) if (PHM & 8) ph_hg1(lds, P, LF, HU, HD, vcu, G);
        REP(4) if (PHM & 16) ph_attn_a(lds, P, O3, IN(8) + l * 8, !last, vcu, G);
        REP(5) if (PHM & 32) ph_attn_b<0>(lds, P, O3 + 512, IN(10) + l * 128, SM[SM_LAM + l], SM[SM_LAM + 2 + l], !last, vcu, G);
#if AB_PROBE >= 0
        ph_attn_b<AB_PROBE>(lds, P, (bf16*)(WSB() + WS_YF), IN(10) + l * 128, SM[SM_LAM + l], SM[SM_LAM + 2 + l], !last, vcu, G);
#endif
        GRID_BAR();
        REP(6) if (PHM & 64) ph_hg2(HU, HD, HS, vcu, G);
        GRID_BAR();
        REP(7) if (PHM & 128) ph_hg3(lds, P, LF, HS, O3 + 1024, IN(12) + l * 128, !last, vcu, G, (HG3_PROBE && rep_ == 0) ? HG3_PROBE : 0);
        GRID_BAR();
        REP(8) if (PHM & 256) { pg8::Gemm g{O3, WBR + (size_t)l * 3 * 1024 * 512, nrows, 1024, 1536}; pg8::StaticOrder S; S.init(nrows, 1024, G, bx);
          EpiMerge E{P, Y};
          pg8::gemm_phase<EpiMerge, pg8::StaticOrder, true, true>(lds, g, S, E); }
        GRID_BAR();
#if GEMM_PROBE == 10
        { pg8::Gemm g{O3, WBR + (size_t)l * 3 * 1024 * 512, nrows, 1024, 1536}; pg8::StaticOrder S; S.init(nrows, 1024, G, bx); EpiNull E{(float*)(WSB() + WS_YF)};
          pg8::gemm_phase<EpiNull, pg8::StaticOrder, true, true, 2>(lds, g, S, E); }
#endif
        REP(9) if (PHM & 512) { pg8::Gemm g{Y, WO + (size_t)l * 1024 * 1024, nrows, 1024, 1024}; pg8::StaticOrder S; S.init(nrows, 1024, G, bx);
          EpiPlain E{YO, 1024, nullptr, 4, 1.f};
          pg8::gemm_phase<EpiPlain, pg8::StaticOrder, true, true>(lds, g, S, E); }
        GRID_BAR();
        unsigned* cnt = (unsigned*)(ctl + CW_CNT) + l * 32;
        TSB(20); REP(10) if (PHM & 1024) ph_r2(lds, x_in, ctx_in, XA, XA2, rep_ == ((PROF_MASK >> 10) & 1), YO, H, MODl, ng, IN(15) + l * 32768, IN(16) + l * 32, cnt, TOPE, GATE, RANK, l, nrows, vcu, G);
        GRID_BAR(); TSE(20);
        moe_tables(MTB, cnt);
        REP(11) if (PHM & 2048) ph_r3(MTB, H, XG, TOPE, RANK, DEST, nrows, vcu, G);
        GRID_BAR();
        REP(12) if (PHM & 4096) { pg8::Gemm g{(const bf16*)XG, (const bf16*)((const unsigned char*)WGU + (size_t)l * 32 * 2048 * 1024), XG_ROWS, 32 * 2048, 1024}; MoeOrder S{MTB, 8, G, vcu};
          EpiSwiglu E{ACT, IN(18) + (size_t)l * 32 * 2048};
          pg8::gemm_phase<EpiSwiglu, MoeOrder, true, true, 1>(lds, g, S, E); }
#if GEMM_PROBE == 3
        { pg8::Gemm g{(const bf16*)XG, (const bf16*)((const unsigned char*)WGU + (size_t)l * 32 * 2048 * 1024), XG_ROWS, 32 * 2048, 1024}; MoeOrder S{MTB, 8, G, vcu}; EpiNull E{(float*)(WSB() + WS_YO)};
          pg8::gemm_phase<EpiNull, MoeOrder, true, true, 1>(lds, g, S, E); }
#endif
#if GEMM_PROBE == 4 || GEMM_PROBE == 5 || GEMM_PROBE == 6
        { pg8::Gemm g{(const bf16*)XG, (const bf16*)((const unsigned char*)WGU + (size_t)l * 32 * 2048 * 1024), XG_ROWS, 32 * 2048, 1024}; MoeOrder S{MTB, 8, G, vcu};
          EpiSwigluT<GEMM_PROBE - 4> E{(unsigned char*)(WSB() + WS_YS), IN(18) + (size_t)l * 32 * 2048};
          pg8::gemm_phase<EpiSwigluT<GEMM_PROBE - 4>, MoeOrder, true, true, 1>(lds, g, S, E); }
#endif
        GRID_BAR();
        REP(13) if (PHM & 8192) { pg8::Gemm g{(const bf16*)ACT, (const bf16*)((const unsigned char*)WDN + (size_t)l * 32 * 1024 * 1024), XG_ROWS, 32 * 1024, 1024}; MoeOrder S{MTB, 4, G, vcu};
          EpiPlain E{YS, 1024, IN(20) + (size_t)l * 32 * 1024, 4, 1.f / (F8_MID * F8_W)};
          pg8::gemm_phase<EpiPlain, MoeOrder, true, true, 1>(lds, g, S, E); }
        GRID_BAR();
#if GEMM_PROBE == 11
        { pg8::Gemm g{(const bf16*)ACT, (const bf16*)((const unsigned char*)WDN + (size_t)l * 32 * 1024 * 1024), XG_ROWS, 32 * 1024, 1024}; MoeOrder S{MTB, 4, G, vcu}; EpiNull E{(float*)(WSB() + WS_YO)};
          pg8::gemm_phase<EpiNull, MoeOrder, true, true, 1>(lds, g, S, E); }
#endif
        TSB(21); REP(14) if (PHM & 16384) ph_r4(XA, XA2, YS, DEST, GATE, MODl, ng, OUTP(), H, HB, SM + SM_MOD + (l + 1 < DEPTH ? (l + 1) * 3 * 6144 : 0), IN(6) + (l + 1 < DEPTH ? (l + 1) * 4096 : 0), last, nrows, vcu, G);
        if (!last) GRID_BAR();
        TSE(21);
        REP(15) for (int k_ = 0; k_ < (rep_ ? 10 : 0); ++k_) xcd_barrier(bar);
    }
    if (TS_SEL >= 0) {
        if (bx == 0 && tid_opaque() == 0) SM[SM_LAM + 8] = (float)tsum * 0.01f;
        xcd_barrier(bar);
        const float sc = 1.f + sqrtf(SM[SM_LAM + 8] * 1e-4f);
        for (int i = bx * NTHR + tid_opaque(); i < NLAT * DM; i += G * NTHR) OUTP()[i] *= sc;
    }
    if (__hip_atomic_load((gu32*)((unsigned*)(ctl + CW_BAR) + XB_TMO), RLX_AGENT) != 0u) { if (bx == 0) for (int i = tid_opaque(); i < 4096; i += NTHR) OUTP()[i] = __builtin_nanf(""); }
}

#undef ctl
#undef SM
#undef WIN
#undef WIN8
#undef WINB
#undef WBR
#undef WO
#undef WGU
#undef WDN
#undef XA
#undef XA2
#undef H
#undef HB
#undef P
#undef LF
#undef O3
#undef HU
#undef HD
#undef HS
#undef Y
#undef YO
#undef TOPE
#undef GATE
#undef RANK
#undef DEST
#undef XG
#undef ACT
#undef YS
#undef x_in
#undef c_in
#undef ctx_in
#undef cctx_in
extern "C" void kernel_launch(void* const* d_in, const int* in_sizes, int n_in, void* d_out, int out_size, void* d_ws, size_t ws_size, hipStream_t stream) {
    static int grid = 0;
    if (grid == 0) {
        if (n_in != 21 || out_size != NLAT * DM || ws_size < WS_END) { fprintf(stderr, "kernel_launch: unexpected shapes (n_in %d, out %d, ws %zu)\n", n_in, out_size, ws_size); grid = -1; return; }
        int dev = 0, cus = 0, per_cu = 0;
        if (hipGetDevice(&dev) != hipSuccess || hipDeviceGetAttribute(&cus, hipDeviceAttributeMultiprocessorCount, dev) != hipSuccess) { grid = -1; return; }
        if (hipFuncSetAttribute((const void*)fwd_mega, hipFuncAttributeMaxDynamicSharedMemorySize, LDS_BYTES) != hipSuccess) { fprintf(stderr, "kernel_launch: hipFuncSetAttribute failed\n"); grid = -1; return; }
        if (hipOccupancyMaxActiveBlocksPerMultiprocessor(&per_cu, (const void*)fwd_mega, NTHR, LDS_BYTES) != hipSuccess || per_cu < 1) { fprintf(stderr, "kernel_launch: occupancy query reports %d\n", per_cu); per_cu = 1; }
        (void)hipGetLastError();
        grid = cus;
    }
    if (grid < 0) return;
    (void)hipMemsetAsync((char*)d_ws + WS_CTL, 0, CTL_ZERO_BYTES, stream);
    Args a{};
    for (int i = 0; i < 21; ++i) a.in[i] = (const float*)d_in[i];
    a.out = (float*)d_out; a.ws = (unsigned char*)d_ws;
    hipLaunchKernelGGL(fwd_mega, dim3(grid), dim3(NTHR), LDS_BYTES, stream, a);
}
```

```cpp
#include <hip/hip_runtime.h>
#include <cstdio>
#include <cstdint>
namespace pg8 {
#define PG8_LAS __attribute__((address_space(3)))
typedef unsigned short bf16_t;
typedef short bf16x8 __attribute__((ext_vector_type(8)));
typedef float f32x4 __attribute__((ext_vector_type(4)));
typedef unsigned u32x4 __attribute__((ext_vector_type(4)));
constexpr int BM = 256, BK = 64, HALF = 128, HTB = HALF * BK * 2  , STAGE_BYTES = 8 * HTB, NXCD = 8, WGM = 8;

__host__ __device__ __forceinline__ int lds_byte(int r, int c) { const int st = (r >> 4) * 2 + (c >> 5), rr = r & 15, cc = c & 31, ob = rr * 64 + cc * 2; return st * 1024 + (ob ^ (((ob >> 9) & 1) << 5)); }
__host__ __device__ __forceinline__ void stage_rc(int b, int& R, int& C) { const int st = b / 1024, sb = b % 1024, swz = sb ^ (((sb >> 9) & 1) << 5); R = (st >> 1) * 16 + swz / 64; C = (st & 1) * 32 + (swz % 64) / 2; }
__host__ __device__ __forceinline__ int perm32(int rho) { const int n = rho >> 4, i = rho & 15; return 8 * (i >> 2) + 4 * n + (i & 3); }

struct Unit { int pm, pn; };
struct Gemm { const bf16_t* A; const bf16_t* Bt; int M, N, K; };

struct StaticOrder {
    int nM, nN, nwg, G, c;
    __host__ __device__ void init(int M, int N, int G_, int c_) { nM = M / BM; nN = N / BM; nwg = nM * nN; G = G_; c = c_; }
    __host__ __device__ bool next(int i, Unit& u) const {
        const long L = (long)i * G + c; if (L >= nwg) return false;
        int wgid = (int)L; { const int q = nwg / NXCD, r = nwg % NXCD, xcd = wgid % NXCD, off = wgid / NXCD; wgid = (xcd < r ? xcd * (q + 1) : r * (q + 1) + (xcd - r) * q) + off; }
        const int nig = WGM * nN, gid = wgid / nig, fm = gid * WGM, gsz = (nM - fm) < WGM ? (nM - fm) : WGM;
        u.pm = fm + ((wgid % nig) % gsz); u.pn = (wgid % nig) / gsz; return true;
    }
    __device__ __forceinline__ void a_ready(const Unit&) const {}
    __device__ __forceinline__ void done(const Unit&) const {}
};

template <class Epi, class Sched, bool ALIGN_EPI = false, bool SP2 = false, int ES = 2>
__device__ __forceinline__ void gemm_phase(PG8_LAS unsigned char* lds, const Gemm g, const Sched& S, const Epi& E) {
    int tid_ = threadIdx.x; asm volatile("" : "+v"(tid_));
    const int tid = tid_, wid = __builtin_amdgcn_readfirstlane(tid >> 6), lane = tid & 63, wr = wid >> 2, wc = wid & 3, fr = lane & 15, fq = lane >> 4;
    const int K = g.K, nt = K * ES / 128;
    unsigned voffA[2], voffB[2];
#pragma unroll
    for (int i = 0; i < 2; ++i) { int R, C; stage_rc(tid * 16 + i * 8192, R, C); const int Rb = Epi::PERM ? ((R & ~31) + perm32(R & 31)) : R;
        voffA[i] = (unsigned)(R * K * ES + C * 2); voffB[i] = (unsigned)(Rb * K * ES + C * 2); }
    const size_t kstep = (size_t)(BK * 2);
    const size_t hstep = (size_t)HALF * K * ES;
    const size_t tstep = 2 * hstep;
    const unsigned ldsw = (unsigned)wid * 1024u;
    const int aoff = lds_byte(wr * 64 + fr, fq * 8), boff = lds_byte(wc * 32 + fr, fq * 8);
#define PG8_SA(b, h) (((b) * 2 + (h)) * HTB)
#define PG8_SB(b, h) ((4 + (b) * 2 + (h)) * HTB)
#define PG8_STAGE(bufoff, gbase, voff) do { _Pragma("unroll") for (int _i = 0; _i < 2; ++_i) \
        __builtin_amdgcn_global_load_lds((const unsigned*)((const char*)(gbase) + (voff)[_i]), (PG8_LAS unsigned*)(lds + (bufoff) + ldsw + _i * 8192), 16, 0, 0); } while (0)
#define PG8_LDA(dst, b, h) do { _Pragma("unroll") for (int m = 0; m < 4; ++m) _Pragma("unroll") for (int k = 0; k < 2; ++k) dst[m][k] = *(const PG8_LAS bf16x8*)(lds + PG8_SA(b, h) + aoff + m * 2048 + k * 1024); } while (0)
#define PG8_LDB(dst, b, h) do { _Pragma("unroll") for (int n = 0; n < 2; ++n) _Pragma("unroll") for (int k = 0; k < 2; ++k) dst[n][k] = *(const PG8_LAS bf16x8*)(lds + PG8_SB(b, h) + boff + n * 2048 + k * 1024); } while (0)
#define PG8_MMA(ai, bj, At, Bt) do { __builtin_amdgcn_s_setprio(1); _Pragma("unroll") for (int m = 0; m < 4; ++m) _Pragma("unroll") for (int n = 0; n < 2; ++n) _Pragma("unroll") for (int k = 0; k < 2; ++k) \
        acc[ai][bj][m][n] = __builtin_amdgcn_mfma_f32_16x16x32_bf16(Bt[n][k], At[m][k], acc[ai][bj][m][n], 0, 0, 0); __builtin_amdgcn_s_setprio(0); } while (0)
    typedef int v8i_t __attribute__((ext_vector_type(8)));
#define PG8_CAT8(x0, x1) __builtin_shufflevector(__builtin_bit_cast(u32x4, (x0)), __builtin_bit_cast(u32x4, (x1)), 0, 1, 2, 3, 4, 5, 6, 7)
#define PG8_MMA8(ai, bj, At, Bt) do { __builtin_amdgcn_s_setprio(1); _Pragma("unroll") for (int m = 0; m < 4; ++m) _Pragma("unroll") for (int n = 0; n < 2; ++n) { \
        const v8i_t a8_ = __builtin_bit_cast(v8i_t, PG8_CAT8(Bt[n][0], Bt[n][1])), b8_ = __builtin_bit_cast(v8i_t, PG8_CAT8(At[m][0], At[m][1])); \
        asm volatile("v_mfma_scale_f32_16x16x128_f8f6f4 %0, %1, %2, %0, %3, %3 op_sel_hi:[0,0,0]" : "+v"(acc[ai][bj][m][n]) : "v"(a8_), "v"(b8_), "v"(0x7f7f7f7f)); } \
        __builtin_amdgcn_s_setprio(0); } while (0)
#define PG8_MMAX(ai, bj, At, Bt) do { if constexpr (ES == 1) PG8_MMA8(ai, bj, At, Bt); else PG8_MMA(ai, bj, At, Bt); } while (0)
#define PG8_WAIT_V(n) asm volatile("s_waitcnt vmcnt(" #n ")" ::: "memory")
#define PG8_WAIT_L(n) asm volatile("s_waitcnt lgkmcnt(" #n ")" ::: "memory")
#define PG8_BAR __builtin_amdgcn_s_barrier()
#define PG8_SCHED __builtin_amdgcn_sched_barrier(0)
    Unit cur, nxt; int ui = 0;
    if (!S.next(0, cur)) return;
    f32x4 acc[2][2][4][2];
#pragma unroll
    for (int a = 0; a < 2; ++a)
#pragma unroll
        for (int b = 0; b < 2; ++b)
#pragma unroll
            for (int m = 0; m < 4; ++m)
#pragma unroll
                for (int n = 0; n < 2; ++n) acc[a][b][m][n] = (f32x4){0.f, 0.f, 0.f, 0.f};
    bf16x8 At[4][2], B0[2][2], B1[2][2];
    const char* cA = (const char*)g.A + (size_t)cur.pm * tstep; const char* cB = (const char*)g.Bt + (size_t)cur.pn * tstep;
    S.a_ready(cur);
    if constexpr (SP2) {
        PG8_STAGE(PG8_SB(0, 0), cB, voffB); PG8_STAGE(PG8_SB(0, 1), cB + hstep, voffB); PG8_STAGE(PG8_SA(0, 0), cA, voffA); PG8_STAGE(PG8_SA(0, 1), cA + hstep, voffA);
        if (wr == 1) PG8_BAR;
        PG8_WAIT_V(2); PG8_BAR;
        PG8_STAGE(PG8_SB(1, 0), cB + kstep, voffB); PG8_STAGE(PG8_SA(1, 0), cA + kstep, voffA); PG8_STAGE(PG8_SB(1, 1), cB + hstep + kstep, voffB);
        PG8_WAIT_V(6); PG8_BAR;
    } else {
        PG8_STAGE(PG8_SB(0, 0), cB, voffB); PG8_STAGE(PG8_SA(0, 0), cA, voffA); PG8_STAGE(PG8_SB(0, 1), cB + hstep, voffB); PG8_STAGE(PG8_SA(0, 1), cA + hstep, voffA);
        if (wr == 1) PG8_BAR;
        PG8_WAIT_V(4); PG8_BAR;
        PG8_STAGE(PG8_SB(1, 0), cB + kstep, voffB); PG8_STAGE(PG8_SA(1, 0), cA + kstep, voffA); PG8_STAGE(PG8_SB(1, 1), cB + hstep + kstep, voffB);
        PG8_WAIT_V(6); PG8_BAR;
    }
    for (;;) {
        const bool has_next = S.next(ui + 1, nxt);
        const char* nA = has_next ? (const char*)g.A + (size_t)nxt.pm * tstep : cA; const char* nB = has_next ? (const char*)g.Bt + (size_t)nxt.pn * tstep : cB;
        for (int t = 0; t < nt; t += 2) {
            if constexpr (Epi::KHOOK) { if (t == 8 || t == 16) E.khook(acc, cur, t >> 3, wr, wc, fr, fq); }
            const bool last = (t == nt - 2);
            const char* a1 = cA + (size_t)(t + 1) * kstep;
            const char* a2 = last ? nA : cA + (size_t)(t + 2) * kstep; const char* b2 = last ? nB : cB + (size_t)(t + 2) * kstep;
            const char* a3 = a2 + kstep; const char* b3 = b2 + kstep;
            if (last && has_next) S.a_ready(nxt);
            if constexpr (SP2) {
            PG8_LDB(B0, 0, 0); PG8_LDB(B1, 0, 1); PG8_SCHED; PG8_LDA(At, 0, 0); PG8_STAGE(PG8_SA(1, 1), a1 + hstep, voffA);
            PG8_WAIT_V(8); PG8_WAIT_L(0); PG8_BAR; PG8_MMAX(0, 0, At, B0); PG8_MMAX(0, 1, At, B1); PG8_BAR; PG8_SCHED;
            PG8_LDA(At, 0, 1); PG8_STAGE(PG8_SB(0, 0), b2, voffB); PG8_STAGE(PG8_SB(0, 1), b2 + hstep, voffB); PG8_STAGE(PG8_SA(0, 0), a2, voffA);
            PG8_WAIT_V(8); PG8_WAIT_L(0); PG8_BAR; PG8_MMAX(1, 0, At, B0); PG8_MMAX(1, 1, At, B1); PG8_BAR; PG8_SCHED;
            PG8_LDB(B0, 1, 0); PG8_LDB(B1, 1, 1); PG8_SCHED; PG8_LDA(At, 1, 0); PG8_STAGE(PG8_SA(0, 1), a2 + hstep, voffA);
            PG8_WAIT_V(8); PG8_WAIT_L(0); PG8_BAR; PG8_MMAX(0, 0, At, B0); PG8_MMAX(0, 1, At, B1); PG8_BAR; PG8_SCHED;
            PG8_LDA(At, 1, 1); PG8_STAGE(PG8_SB(1, 0), b3, voffB); PG8_STAGE(PG8_SB(1, 1), b3 + hstep, voffB); PG8_STAGE(PG8_SA(1, 0), a3, voffA);
            PG8_WAIT_V(8); PG8_WAIT_L(0); PG8_BAR; PG8_MMAX(1, 0, At, B0); PG8_MMAX(1, 1, At, B1); PG8_BAR; PG8_SCHED;
            } else {
            PG8_LDB(B0, 0, 0); PG8_SCHED; PG8_LDA(At, 0, 0); PG8_STAGE(PG8_SA(1, 1), a1 + hstep, voffA);
            PG8_WAIT_L(8); PG8_BAR; PG8_WAIT_L(0); PG8_MMAX(0, 0, At, B0); PG8_BAR; PG8_SCHED;
            PG8_LDB(B1, 0, 1); PG8_STAGE(PG8_SB(0, 0), b2, voffB);
            PG8_BAR; PG8_WAIT_L(0); PG8_MMAX(0, 1, At, B1); PG8_BAR;
            PG8_LDA(At, 0, 1); PG8_STAGE(PG8_SA(0, 0), a2, voffA);
            PG8_BAR; PG8_WAIT_L(0); PG8_MMAX(1, 0, At, B0); PG8_BAR; PG8_SCHED;
            PG8_STAGE(PG8_SB(0, 1), b2 + hstep, voffB);
            PG8_WAIT_V(6); PG8_BAR; PG8_MMAX(1, 1, At, B1); PG8_BAR;
            PG8_LDB(B0, 1, 0); PG8_SCHED; PG8_LDA(At, 1, 0); PG8_STAGE(PG8_SA(0, 1), a2 + hstep, voffA);
            PG8_WAIT_L(8); PG8_BAR; PG8_WAIT_L(0); PG8_MMAX(0, 0, At, B0); PG8_BAR; PG8_SCHED;
            PG8_LDB(B1, 1, 1); PG8_STAGE(PG8_SB(1, 0), b3, voffB);
            PG8_BAR; PG8_WAIT_L(0); PG8_MMAX(0, 1, At, B1); PG8_BAR;
            PG8_LDA(At, 1, 1); PG8_STAGE(PG8_SA(1, 0), a3, voffA);
            PG8_BAR; PG8_WAIT_L(0); PG8_MMAX(1, 0, At, B0); PG8_BAR; PG8_SCHED;
            PG8_STAGE(PG8_SB(1, 1), b3 + hstep, voffB);
            PG8_WAIT_V(6); PG8_BAR; PG8_MMAX(1, 1, At, B1); PG8_BAR;
            }
        }
        if constexpr (ES == 1) asm volatile("s_nop 15\n\ts_nop 7" ::: "memory");
        if constexpr (ALIGN_EPI) { if (wr == 0) PG8_BAR; }
        if constexpr (!Epi::AFTER_DRAIN) { E(acc, cur, wr, wc, fr, fq); S.done(cur); }
        if (!has_next) break;
#pragma unroll
        for (int a = 0; a < 2; ++a)
#pragma unroll
            for (int b = 0; b < 2; ++b)
#pragma unroll
                for (int m = 0; m < 4; ++m)
#pragma unroll
                    for (int n = 0; n < 2; ++n) acc[a][b][m][n] = (f32x4){0.f, 0.f, 0.f, 0.f};
        cur = nxt; cA = nA; cB = nB; ++ui;
        if constexpr (ALIGN_EPI) { if (wr == 1) PG8_BAR; }
    }
    PG8_WAIT_V(0);
    if constexpr (!ALIGN_EPI) { if (wr == 0) PG8_BAR; }
    PG8_BAR;
    if constexpr (Epi::AFTER_DRAIN) { E.fused(acc, cur, wr, wc, fr, fq, lds, wid, lane); S.done(cur); }
#undef PG8_SA
#undef PG8_SB
#undef PG8_STAGE
#undef PG8_LDA
#undef PG8_LDB
#undef PG8_MMA
#undef PG8_MMA8
#undef PG8_MMAX
#undef PG8_CAT8
#undef PG8_WAIT_V
#undef PG8_WAIT_L
#undef PG8_BAR
#undef PG8_SCHED
}
}
#define GAS __attribute__((address_space(1)))
#define LAS __attribute__((address_space(3)))
typedef unsigned short bf16;
typedef unsigned v4u __attribute__((ext_vector_type(4)));
typedef float f32x4 __attribute__((ext_vector_type(4)));
typedef short bf16x8 __attribute__((ext_vector_type(8)));
typedef GAS unsigned gu32;
typedef GAS unsigned long long gu64;
#define RLX_AGENT __ATOMIC_RELAXED, __HIP_MEMORY_SCOPE_AGENT
#define LDS_WAIT() asm volatile("s_waitcnt lgkmcnt(0)" ::: "memory")
#define VM_WAIT() asm volatile("s_waitcnt vmcnt(0)" ::: "memory")
__device__ __forceinline__ unsigned long long rt() { return __builtin_amdgcn_s_memrealtime(); }
__device__ __forceinline__ unsigned f2bf(float f) { unsigned u = __builtin_bit_cast(unsigned, f); return (u + 0x7fffu + ((u >> 16) & 1u)) >> 16; }
__device__ __forceinline__ unsigned pk2(float lo, float hi) { return f2bf(lo) | (f2bf(hi) << 16); }

#define XB_TMO      128
#define XB_XCNT(j)  (256  + 64 * (j))
#define XB_XSUB(j)  (1280 + 64 * (j))
#define XB_XGEN(j)  (2304 + 64 * (j))
#define XB_TOP      3328
#define XB_TOPGEN   3392
#define XCD_BAR_WORDS 3456
#define XB_SPIN_CAP (1u << 18)

__device__ __forceinline__ unsigned xb_ld(unsigned* p)              { return __hip_atomic_load(p, __ATOMIC_RELAXED, __HIP_MEMORY_SCOPE_AGENT); }
__device__ __forceinline__ unsigned xb_add(unsigned* p, unsigned v) { return __hip_atomic_fetch_add(p, v, __ATOMIC_RELAXED, __HIP_MEMORY_SCOPE_AGENT); }
__device__ __forceinline__ unsigned xb_xcc_id() { return (unsigned)__builtin_amdgcn_s_getreg((3 << 11) | 20) & 0xFu; }
#define XB_SPIN(cond, bar) do { unsigned _sp = 0; while (cond) { __builtin_amdgcn_s_sleep(1); \
    if ((++_sp & 255u) == 0u) { if (xb_ld(&(bar)[XB_TMO])) break; if (_sp > XB_SPIN_CAP) { atomicAdd(&(bar)[XB_TMO], 1u); break; } } } } while (0)

struct XcdBarrier {
    unsigned* bar; unsigned x;
    volatile LAS unsigned* st;
};

__device__ __forceinline__ XcdBarrier xcd_barrier_post(unsigned* bar, volatile LAS unsigned* st) {
    XcdBarrier b; b.bar = bar; b.x = xb_xcc_id(); b.st = st;
    if (threadIdx.x == 0) (void)xb_add(&bar[XB_XCNT(b.x)], 1u);
    return b;
}
__device__ __forceinline__ void xcd_barrier_complete(unsigned* bar, unsigned x, unsigned& nloc, unsigned& nx) {
    const unsigned G = gridDim.x * gridDim.y * gridDim.z;
    unsigned sum, cnt, mine, sp = 0u;
    for (;;) {
        sum = 0u; cnt = 0u; mine = 0u;
#pragma unroll
        for (unsigned j = 0; j < 16; ++j) { const unsigned c = xb_ld(&bar[XB_XCNT(j)]); sum += c; cnt += (c > 0u) ? 1u : 0u; mine = (j == x) ? c : mine; }
        if (sum == G) break;
        __builtin_amdgcn_s_sleep(1);
        if ((++sp & 255u) == 0u) { if (xb_ld(&bar[XB_TMO])) break; if (sp > XB_SPIN_CAP) { atomicAdd(&bar[XB_TMO], 1u); break; } }
    }
    nloc = mine > 0u ? mine : 1u; nx = cnt > 0u ? cnt : 1u;
}

__device__ __forceinline__ void xcd_barrier(const XcdBarrier& b) {
    asm volatile("s_waitcnt vmcnt(0)" ::: "memory");
    __syncthreads();
    if (threadIdx.x == 0) {
        unsigned* bar = b.bar;
        __builtin_amdgcn_s_waitcnt(0);
        unsigned nloc = b.st[0], nx = b.st[1];
        if (nloc == 0u) { xcd_barrier_complete(bar, b.x, nloc, nx); b.st[0] = nloc; b.st[1] = nx; }
        const unsigned old = xb_add(&bar[XB_XSUB(b.x)], 1u);
        const unsigned gen = old / nloc;
        if (old + 1u == (gen + 1u) * nloc) {
            __builtin_amdgcn_fence(__ATOMIC_RELEASE, "agent");
            asm volatile("s_waitcnt vmcnt(0)" ::: "memory");
            const unsigned og = xb_add(&bar[XB_TOP], 1u);
            const unsigned tg = og / nx;
            if (og + 1u == (tg + 1u) * nx) xb_add(&bar[XB_TOPGEN], 1u);
            else XB_SPIN(xb_ld(&bar[XB_TOPGEN]) == tg, bar);
            __builtin_amdgcn_fence(__ATOMIC_ACQUIRE, "agent");
            xb_add(&bar[XB_XGEN(b.x)], 1u);
            asm volatile("s_waitcnt vmcnt(0)" ::: "memory");
        } else {
            XB_SPIN(xb_ld(&bar[XB_XGEN(b.x)]) == gen, bar);
            __builtin_amdgcn_fence(__ATOMIC_ACQUIRE, "agent");
            asm volatile("s_waitcnt vmcnt(0)" ::: "memory");
        }
    }
    __syncthreads();
}

#define DI __device__ __forceinline__
constexpr int DM = 1024, NB = 2, SEQ = 8192, CTXL = 256, DEPTH = 2;
constexpr int NLAT = NB * SEQ, NCTX = NB * CTXL, NTOK = NLAT + NCTX;
constexpr int INW = 7936;
constexpr int C_AQ = 0, C_AK = 512, C_AV = 640, C_BQ = 768, C_BK = 1280, C_BV = 1792, C_CQ = 2304, C_CI = 2816, C_CFF = 3328, C_CFB = 3840, C_CG = 4352, C_GT = 4864;
constexpr int NEXP = 32, EFF = 1024, NCH = 132;
constexpr float RMS_EPS = 1e-6f, LOG2E = 1.4426950408889634f, QSCALE = 0.125f * 1.4426950408889634f;
constexpr int XG_ROWS = 75776;
constexpr int NWAVES = 8, NTHR = 512;

constexpr size_t MiB = 1u << 20;
constexpr size_t WS_CTL = 0, CTL_ZERO_BYTES = 1 * MiB;
constexpr size_t WS_SMALL = 1 * MiB;
constexpr size_t WS_WIN = 2 * MiB, WS_WBR = 33 * MiB, WS_WO = 39 * MiB, WS_WGU = 43 * MiB, WS_WDN = 299 * MiB;
constexpr size_t WS_XA = 427 * MiB, WS_H = 493 * MiB, WS_P = 526 * MiB, WS_LF = 782 * MiB, WS_O3 = 848 * MiB, WS_HU = 898 * MiB, WS_HD = 1030 * MiB, WS_HS = 1032 * MiB;
constexpr size_t WS_YF = 1098 * MiB, WS_Y = 1164 * MiB, WS_YO = 1197 * MiB, WS_ROUTE = 1230 * MiB, WS_XA2 = 1232 * MiB, WS_WIN8 = 1298 * MiB  , WS_QK8 = 1314 * MiB  , WS_WIN8L = 1332 * MiB  , WS_END = 1350 * MiB;
constexpr size_t WS_XG = 526 * MiB, WS_ACT = 674 * MiB, WS_YS = 822 * MiB;
static_assert(WS_YS + (size_t)XG_ROWS * 1024 * 2 <= WS_HD, "moe overlay");
static_assert(WS_P + (size_t)NTOK * INW * 2 <= WS_LF && WS_HU + (size_t)2112 * 16384 * 4 <= WS_HD && WS_HS + (size_t)2112 * 16384 * 2 <= WS_YF, "ws map");
constexpr int SM_MOD = 0;
constexpr int SM_LB = 36864;
constexpr int SM_TAB = 38912;
constexpr int SM_LAM = 45056;
constexpr int CW_BAR = 4096;
constexpr int CW_CNT = 16384;

constexpr int RING_BYTES = 147456, LDSCTL_OFF = RING_BYTES, MISC_OFF = LDSCTL_OFF + 320, LDS_BYTES = 163840;

typedef float f32x16 __attribute__((ext_vector_type(16)));
typedef float f32x2 __attribute__((ext_vector_type(2)));
typedef short s16x4 __attribute__((ext_vector_type(4)));
typedef unsigned u32x2 __attribute__((ext_vector_type(2)));
typedef __bf16 bf16x2_t __attribute__((ext_vector_type(2)));
DI unsigned cvtpk(float lo, float hi) { f32x2 v = {lo, hi}; bf16x2_t b = __builtin_convertvector(v, bf16x2_t); return __builtin_bit_cast(unsigned, b); }
DI float bf2f(unsigned short u) { return __uint_as_float(((unsigned)u) << 16); }
DI float bflo(unsigned u) { return __uint_as_float(u << 16); }
DI float bfhi(unsigned u) { return __uint_as_float(u & 0xffff0000u); }
DI float wave_sum(float v) {
#pragma unroll
    for (int o = 1; o < 64; o <<= 1) v += __shfl_xor(v, o);
    return v;
}
constexpr float LOG2E_ = 1.4426950408889634f;
DI float silu_f(float v) { return v * __builtin_amdgcn_rcpf(1.f + __builtin_amdgcn_exp2f(-LOG2E_ * v)); }
DI float sigm_f(float v) { return __builtin_amdgcn_rcpf(1.f + __builtin_amdgcn_exp2f(-LOG2E_ * v)); }
DI bf16x8 pack8(float a0, float a1, float a2, float a3, float a4, float a5, float a6, float a7) {
    v4u p; p.x = cvtpk(a0, a1); p.y = cvtpk(a2, a3); p.z = cvtpk(a4, a5); p.w = cvtpk(a6, a7); return __builtin_bit_cast(bf16x8, p);
}
typedef short v4i16_t __attribute__((ext_vector_type(4)));
DI s16x4 tr_read(LAS const char* p) { return __builtin_bit_cast(s16x4, __builtin_amdgcn_ds_read_tr16_b64_v4i16((LAS v4i16_t*)p)); }
DI bf16x8 cat8(s16x4 lo, s16x4 hi) { return __builtin_shufflevector(lo, hi, 0, 1, 2, 3, 4, 5, 6, 7); }
#define MFMA32(a, b, c) __builtin_amdgcn_mfma_f32_32x32x16_bf16((a), (b), (c), 0, 0, 0)
#define MFMA16(a, b, c) __builtin_amdgcn_mfma_f32_16x16x32_bf16((a), (b), (c), 0, 0, 0)
#ifndef INP_FP8
#define INP_FP8 0
#ifndef TX_INTERLEAVE
#define TX_INTERLEAVE 1
#endif
#ifndef AB_F8QK
#define AB_F8QK 1
#endif
#endif
#ifndef INP_L0_FP8
#define INP_L0_FP8 1
#endif
#define INP_L1_FP8 1
constexpr float F8_ACT = 8.f, F8_W = 256.f, F8_MID = 4.f, F8_V = 8.f;
constexpr float INP_OSC = INP_FP8 ? 1.f / (8.f * 256.f) : 1.f;
DI float clamp8(float x) { return fminf(fmaxf(x, -448.f), 448.f); }
DI unsigned f8x4(float a, float b, float c, float d) { int w = __builtin_amdgcn_cvt_pk_fp8_f32(clamp8(a), clamp8(b), 0, false); w = __builtin_amdgcn_cvt_pk_fp8_f32(clamp8(c), clamp8(d), w, true); return (unsigned)w; }
DI int tid_opaque() { int t = threadIdx.x; asm volatile("" : "+v"(t)); return t; }
DI int crow(int r, int hi) { return (r & 3) + 8 * (r >> 2) + 4 * hi; }

DI void ph_mod(LAS unsigned char* lds, const float* c, const float* cctx, const float* wmod, const float* bmod, float* MOD, int vcu, int G) {
    LAS float* sv = (LAS float*)lds;
    LAS float* red = sv + 3072;
    const int tid = tid_opaque(), col = tid & 31, ks = tid >> 5;
    for (int i = tid; i < 3072; i += NTHR) { const int j = i >> 10, k = i & 1023; sv[i] = silu_f(j < 2 ? c[j * 1024 + k] : cctx[k]); }
    __syncthreads();
    for (int tile = vcu; tile < 2 * 192; tile += G) {
        const int l = tile / 192, n0 = (tile % 192) * 32;
        const float* W = wmod + (size_t)l * 1024 * 6144 + n0 + col + (size_t)(ks * 64) * 6144;
        float w[64];
#pragma unroll
        for (int i = 0; i < 64; ++i) w[i] = W[(size_t)i * 6144];
        float a0 = 0.f, a1 = 0.f, a2 = 0.f;
#pragma unroll
        for (int i = 0; i < 64; ++i) { const int k = ks * 64 + i; a0 += sv[k] * w[i]; a1 += sv[1024 + k] * w[i]; a2 += sv[2048 + k] * w[i]; }
        red[(ks * 3 + 0) * 32 + col] = a0; red[(ks * 3 + 1) * 32 + col] = a1; red[(ks * 3 + 2) * 32 + col] = a2;
        __syncthreads();
        if (tid < 96) { const int j = tid >> 5, cc = tid & 31; float s = 0.f;
#pragma unroll
            for (int k2 = 0; k2 < 16; ++k2) s += red[(k2 * 3 + j) * 32 + cc];
            MOD[(l * 3 + j) * 6144 + n0 + cc] = s + bmod[l * 6144 + n0 + cc]; }
        __syncthreads();
    }
}
DI void sincos_tab(double a, float& s, float& c) {
    const double TWO_PI = 6.283185307179586476925;
    const double k = rint(a / TWO_PI), r = a - k * TWO_PI, r2 = r * r;
    double ts = r, ss = r, tc = 1.0, cs = 1.0;
    for (int n = 1; n <= 15; ++n) { ts *= -r2 / (double)((2 * n) * (2 * n + 1)); ss += ts; tc *= -r2 / (double)((2 * n - 1) * (2 * n)); cs += tc; }
    s = (float)ss; c = (float)cs;
}
DI void ph_tables(float* SM, const float* lb_logits, const float* dlam, int vcu, int G) {
    const int gt = vcu * NTHR + tid_opaque(), NT = G * NTHR;
    for (int i = gt; i < 192 * 16; i += NT) {
        const int pos = i >> 4, f = i & 15;
        const float invf = f == 0 ? 1.0f : f == 1 ? 0.5623413324356079f : f == 2 ? 0.3162277638912201f : f == 3 ? 0.17782793939113617f : f == 4 ? 0.10000000149011612f : f == 5 ? 0.05623413249850273f
                         : f == 6 ? 0.03162277489900589f : f == 7 ? 0.017782794311642647f : f == 8 ? 0.009999999776482582f : f == 9 ? 0.005623413249850273f : f == 10 ? 0.003162277629598975f
                         : f == 11 ? 0.0017782794311642647f : f == 12 ? 0.0010000000474974513f : f == 13 ? 0.000562341301701963f : f == 14 ? 0.0003162277571391314f : 0.00017782794020604342f;
        const int p = pos < 128 ? pos : pos - 128;
        const float ang = (float)p * invf;
        float s, c; sincos_tab((double)ang, s, c);
        if (pos < 128) { SM[SM_TAB + p * 16 + f] = c; SM[SM_TAB + 2048 + p * 16 + f] = s; }
        else { SM[SM_TAB + 4096 + p * 16 + f] = c; SM[SM_TAB + 4096 + 1024 + p * 16 + f] = s; }
    }
    for (int i = gt; i < 1024; i += NT) {
        const float l0 = lb_logits[i], l1 = lb_logits[1024 + i];
        SM[SM_LB + i] = 0.f; SM[SM_LB + 1024 + i] = 1.f / (1.f + expf(l0 - l1));
    }
    if (gt < 2) { const float* lp = dlam + gt * 256; float s0 = 0.f, s1 = 0.f;
        for (int d = 0; d < 64; ++d) { s0 += lp[d] * lp[64 + d]; s1 += lp[128 + d] * lp[192 + d]; }
        const float li = 0.8f - 0.6f * expf(-0.3f * (float)gt);
        SM[SM_LAM + gt] = expf(s0) - expf(s1) + li; SM[SM_LAM + 2 + gt] = li; }
}
DI void p0_transpose_item(const float* W, int K, int N, int spitch, bf16* WT, int dpitch, int gu, int f8, LAS float* scr, int item, int lane) {
    const int nblk = N / 32, kb = item / nblk, nb = item % nblk, k0 = 64 * kb, n0 = 32 * nb;
    float wv[32];
#pragma unroll
    for (int i = 0; i < 32; ++i) wv[i] = __builtin_nontemporal_load(W + (size_t)(k0 + 2 * i + (lane >> 5)) * spitch + n0 + (lane & 31));
#pragma unroll
    for (int i = 0; i < 32; ++i) scr[(2 * i + (lane >> 5)) * 33 + (lane & 31)] = wv[i];
    LDS_WAIT(); asm volatile("" ::: "memory");
    const int c = lane & 7;
    const int r0 = gu ? (256 * ((n0 & 1023) >> 7) + 128 * (n0 >> 10) + (n0 & 127)) : n0;
#pragma unroll
    for (int j = 0; j < 4; ++j) { const int n = (lane >> 3) + 8 * j; const LAS float* s = scr + (8 * c) * 33 + n;
        if (f8) { u32x2 o8; o8.x = f8x4(s[0 * 33] * F8_W, s[1 * 33] * F8_W, s[2 * 33] * F8_W, s[3 * 33] * F8_W); o8.y = f8x4(s[4 * 33] * F8_W, s[5 * 33] * F8_W, s[6 * 33] * F8_W, s[7 * 33] * F8_W);
            *(GAS u32x2*)((unsigned char*)WT + (size_t)(r0 + n) * dpitch + k0 + 8 * c) = o8; }
        else { v4u o; o.x = pk2(s[0 * 33], s[1 * 33]); o.y = pk2(s[2 * 33], s[3 * 33]); o.z = pk2(s[4 * 33], s[5 * 33]); o.w = pk2(s[6 * 33], s[7 * 33]);
            *(GAS v4u*)(WT + (size_t)(r0 + n) * dpitch + k0 + 8 * c) = o; } }
    LDS_WAIT(); asm volatile("" ::: "memory");
}
struct TGroup { const float* src; bf16* dst; int K, N, nmat, gu, sub, f8, spitch; };
DI bool p0_group(const TGroup& g, int& r, LAS float* scr, int lane) {
    const int per = (g.K / 64) * (g.N / 32), cnt = per * g.nmat;
    if (r >= cnt) { r -= cnt; return false; }
    const int m = r / per, it = r % per;
    p0_transpose_item(g.src + (size_t)m * g.K * g.N, g.K, g.N, g.spitch ? g.spitch : g.N, g.f8 ? (bf16*)((unsigned char*)g.dst + (size_t)m * g.K * g.N) : g.dst + (size_t)(m / g.sub) * g.sub * g.K * g.N + (size_t)(m % g.sub) * g.K, g.sub * g.K, g.gu, g.f8, scr, it, lane);
    return true;
}
struct TItem { const float* sp; unsigned char* dp; int spitch, dpitch, f8; };
DI bool p0_decode(const TGroup& g, int& r, TItem& t) {
    const int per = (g.K / 64) * (g.N / 32), cnt = per * g.nmat;
    if (r >= cnt) { r -= cnt; return false; }
    const int m = r / per, it = r % per, nblk = g.N / 32, k0 = 64 * (it / nblk), n0 = 32 * (it % nblk);
    const int r0 = g.gu ? (256 * ((n0 & 1023) >> 7) + 128 * (n0 >> 10) + (n0 & 127)) : n0;
    t.spitch = g.spitch ? g.spitch : g.N; t.dpitch = g.sub * g.K; t.f8 = g.f8;
    t.sp = g.src + (size_t)m * g.K * g.N + (size_t)k0 * t.spitch + n0;
    t.dp = g.f8 ? (unsigned char*)g.dst + (size_t)m * g.K * g.N + (size_t)r0 * t.dpitch + k0
                : (unsigned char*)(g.dst + (size_t)(m / g.sub) * g.sub * g.K * g.N + (size_t)(m % g.sub) * g.K + (size_t)r0 * t.dpitch + k0);
    return true;
}
DI void p0_item_load(const TItem& t, int lane, float (&wv)[32]) {
#pragma unroll
    for (int i = 0; i < 32; ++i) wv[i] = __builtin_nontemporal_load(t.sp + (size_t)(2 * i + (lane >> 5)) * t.spitch + (lane & 31));
}
DI void p0_item_to_lds(LAS float* scr, int lane, const float (&wv)[32]) {
#pragma unroll
    for (int i = 0; i < 32; ++i) scr[(2 * i + (lane >> 5)) * 33 + (lane & 31)] = wv[i];
}
DI void p0_item_store(const TItem& t, LAS float* scr, int lane) {
    const int c = lane & 7;
#pragma unroll
    for (int j = 0; j < 4; ++j) { const int n = (lane >> 3) + 8 * j; const LAS float* s = scr + (8 * c) * 33 + n;
        if (t.f8) { u32x2 o8; o8.x = f8x4(s[0 * 33] * F8_W, s[1 * 33] * F8_W, s[2 * 33] * F8_W, s[3 * 33] * F8_W); o8.y = f8x4(s[4 * 33] * F8_W, s[5 * 33] * F8_W, s[6 * 33] * F8_W, s[7 * 33] * F8_W);
            *(GAS u32x2*)(t.dp + (size_t)n * t.dpitch + 8 * c) = o8; }
        else { v4u o; o.x = pk2(s[0 * 33], s[1 * 33]); o.y = pk2(s[2 * 33], s[3 * 33]); o.z = pk2(s[4 * 33], s[5 * 33]); o.w = pk2(s[6 * 33], s[7 * 33]);
            *(GAS v4u*)(t.dp + ((size_t)n * t.dpitch + 8 * c) * 2) = o; } }
}
DI bool p0_decodeX(const TGroup& g, int& r, TItem& t) {
    const int KI = g.f8 ? 128 : 64, per = (g.K / KI) * (g.N / 32), cnt = per * g.nmat;
    if (r >= cnt) { r -= cnt; return false; }
    const int m = r / per, it = r % per, nblk = g.N / 32, k0 = KI * (it / nblk), n0 = 32 * (it % nblk);
    const int r0 = g.gu ? (256 * ((n0 & 1023) >> 7) + 128 * (n0 >> 10) + (n0 & 127)) : n0;
    t.spitch = g.spitch ? g.spitch : g.N; t.dpitch = g.sub * g.K; t.f8 = g.f8;
    t.sp = g.src + (size_t)m * g.K * g.N + (size_t)k0 * t.spitch + n0;
    t.dp = g.f8 ? (unsigned char*)g.dst + (size_t)m * g.K * g.N + (size_t)r0 * t.dpitch + k0
                : (unsigned char*)(g.dst + (size_t)(m / g.sub) * g.sub * g.K * g.N + (size_t)(m % g.sub) * g.K + (size_t)r0 * t.dpitch + k0);
    return true;
}
DI void p0_item_loadX(const TItem& t, int lane, f32x4 (&wv)[16]) {
#pragma unroll
    for (int i = 0; i < 8; ++i) wv[i] = __builtin_nontemporal_load((const f32x4*)(t.sp + (size_t)(8 * i + (lane >> 3)) * t.spitch + 4 * (lane & 7)));
    if (t.f8) {
#pragma unroll
        for (int i = 8; i < 16; ++i) wv[i] = __builtin_nontemporal_load((const f32x4*)(t.sp + (size_t)(8 * i + (lane >> 3)) * t.spitch + 4 * (lane & 7)));
    }
}
DI void p0_item_to_ldsX(const TItem& t, LAS float* scr, int lane, const f32x4 (&wv)[16]) {
#pragma unroll
    for (int i = 0; i < 8; ++i) { LAS float* d = scr + (8 * i + (lane >> 3)) * 33 + 4 * (lane & 7); d[0] = wv[i][0]; d[1] = wv[i][1]; d[2] = wv[i][2]; d[3] = wv[i][3]; }
    if (t.f8) {
#pragma unroll
        for (int i = 8; i < 16; ++i) { LAS float* d = scr + (8 * i + (lane >> 3)) * 33 + 4 * (lane & 7); d[0] = wv[i][0]; d[1] = wv[i][1]; d[2] = wv[i][2]; d[3] = wv[i][3]; }
    }
}
DI void p0_item_storeX(const TItem& t, LAS float* scr, int lane) {
    const int c = lane & 7;
#pragma unroll
    for (int j = 0; j < 4; ++j) { const int n = (lane >> 3) + 8 * j;
        if (t.f8) { const LAS float* s = scr + (16 * c) * 33 + n; v4u o;
            o.x = f8x4(s[0 * 33] * F8_W, s[1 * 33] * F8_W, s[2 * 33] * F8_W, s[3 * 33] * F8_W); o.y = f8x4(s[4 * 33] * F8_W, s[5 * 33] * F8_W, s[6 * 33] * F8_W, s[7 * 33] * F8_W);
            o.z = f8x4(s[8 * 33] * F8_W, s[9 * 33] * F8_W, s[10 * 33] * F8_W, s[11 * 33] * F8_W); o.w = f8x4(s[12 * 33] * F8_W, s[13 * 33] * F8_W, s[14 * 33] * F8_W, s[15 * 33] * F8_W);
            *(GAS v4u*)(t.dp + (size_t)n * t.dpitch + 16 * c) = o; }
        else { const LAS float* s = scr + (8 * c) * 33 + n; v4u o; o.x = pk2(s[0 * 33], s[1 * 33]); o.y = pk2(s[2 * 33], s[3 * 33]); o.z = pk2(s[4 * 33], s[5 * 33]); o.w = pk2(s[6 * 33], s[7 * 33]);
            *(GAS v4u*)(t.dp + ((size_t)n * t.dpitch + 8 * c) * 2) = o; } }
}
DI void row_ld(const float* p, int lane, f32x4 (&v)[4]) {
#pragma unroll
    for (int j = 0; j < 4; ++j) v[j] = ((const GAS f32x4*)p)[lane + 64 * j];
}
DI void row_ld_bf(const bf16* p, int lane, f32x4 (&v)[4]) {
#pragma unroll
    for (int j = 0; j < 4; ++j) { const u32x2 w = ((const GAS u32x2*)p)[lane + 64 * j]; v[j] = (f32x4){bflo(w.x), bfhi(w.x), bflo(w.y), bfhi(w.y)}; }
}
DI void row_st(float* p, int lane, const f32x4 (&v)[4]) {
#pragma unroll
    for (int j = 0; j < 4; ++j) ((GAS f32x4*)p)[lane + 64 * j] = v[j];
}
DI void row_st_bf(bf16* p, int lane, const f32x4 (&v)[4]) {
#pragma unroll
    for (int j = 0; j < 4; ++j) { u32x2 w; w.x = cvtpk(v[j].x, v[j].y); w.y = cvtpk(v[j].z, v[j].w); ((GAS u32x2*)p)[lane + 64 * j] = w; }
}
DI void row_st_f8(unsigned char* p, int lane, const f32x4 (&v)[4], float s) {
#pragma unroll
    for (int j = 0; j < 4; ++j) ((GAS unsigned*)p)[lane + 64 * j] = f8x4(v[j].x * s, v[j].y * s, v[j].z * s, v[j].w * s);
}
DI float row_rstd(const f32x4 (&v)[4]) {
    float s = 0.f;
#pragma unroll
    for (int j = 0; j < 4; ++j) s += (v[j].x * v[j].x + v[j].y * v[j].y) + (v[j].z * v[j].z + v[j].w * v[j].w);
    return rsqrtf(wave_sum(s) * (1.f / 1024.f) + RMS_EPS);
}
DI void row_modulate(const f32x4 (&x)[4], const float* g, const float* shift, const float* scale, int lane, f32x4 (&h)[4]) {
    const float r = row_rstd(x);
#pragma unroll
    for (int j = 0; j < 4; ++j) { const f32x4 gg = ((const GAS f32x4*)g)[lane + 64 * j], sh = ((const GAS f32x4*)shift)[lane + 64 * j], sc = ((const GAS f32x4*)scale)[lane + 64 * j];
        h[j] = x[j] * r * gg * (sc + 1.f) + sh; }
}

DI v4u pack8u(const f32x4& a, const f32x4& b) { v4u w; w.x = cvtpk(a[0], a[1]); w.y = cvtpk(a[2], a[3]); w.z = cvtpk(b[0], b[1]); w.w = cvtpk(b[2], b[3]); return w; }
template <int MODE> struct EpiInT {
    static constexpr bool PERM = true, AFTER_DRAIN = false, KHOOK = false;
    bf16* P; float* LF; const float* tab; const float* lb; int pn_off; float osc; unsigned char* QK8 = nullptr;
    DI void operator()(const pg8::f32x4 (&acc)[2][2][4][2], const pg8::Unit& u, int wr, int wc, int fr_, int fq_) const {
        const int lane_ = tid_opaque() & 63, fr = lane_ & 15, fq = lane_ >> 4;
        const int pn = u.pn + pn_off; const bool lat = u.pm < 64;
#pragma unroll
        for (int bj = 0; bj < 2; ++bj) {
            int mode;
            float sc = 1.f;
            if (pn <= 1 || pn == 3 || pn == 4) { mode = 1; sc = QSCALE; }
            else if (pn == 2) mode = (bj == 0) ? 1 : 0;
            else if (pn == 5 || pn == 6) mode = 1;
            else if (pn == 9 || pn == 10 || pn == 17 || pn == 18) mode = 2;
            else if (pn >= 13 && pn <= 16) mode = 3;
            else if (pn >= 19) mode = 4;
            else mode = 0;
            if (mode == 1 && !lat) mode = 0;
            if (MODE == 2) mode = (mode == 3) ? 5 : 0;
            unsigned keep_ = 0u;
            const bool f8t = AB_F8QK && MODE == 0 && QK8 != nullptr && pn >= 3 && pn <= 6;
            const int cu = pn * 256 + bj * 128 + wc * 32;
            if (mode == 3 || mode == 5) {
                const int dir = (pn >= 15) ? 1 : 0; const int ch = (pn - 13 - 2 * dir) * 256 + bj * 128 + wc * 32 + 8 * fq;
                const f32x4 l0 = *(const GAS f32x4*)(lb + dir * 512 + ch), l1 = *(const GAS f32x4*)(lb + dir * 512 + ch + 4);
#pragma unroll
                for (int ai = 0; ai < 2; ++ai)
#pragma unroll
                    for (int m = 0; m < 4; ++m) {
                        const int rowu = u.pm * 256 + ai * 128 + wr * 64 + m * 16;
                        f32x4 v0 = acc[ai][bj][m][0] * osc, v1 = acc[ai][bj][m][1] * osc;
                        if (mode == 3) {
#pragma unroll
                            for (int j = 0; j < 4; ++j) { v0[j] = fmaxf(__builtin_amdgcn_logf(l0[j] + (1.f - l0[j]) * sigm_f(v0[j])) * 0.6931471805599453f, -60.f); v1[j] = fmaxf(__builtin_amdgcn_logf(l1[j] + (1.f - l1[j]) * sigm_f(v1[j])) * 0.6931471805599453f, -60.f);     } }
                        float* lp = LF + (size_t)rowu * 1024 + dir * 512 + (pn - 13 - 2 * dir) * 256 + bj * 128 + wc * 32;
                        if (MODE != 1) { *(GAS f32x4*)(lp + fr * 1024 + 8 * fq) = v0; *(GAS f32x4*)(lp + fr * 1024 + 8 * fq + 4) = v1; } else keep_ ^= __float_as_uint(v0[0] + v0[1] + v0[2] + v0[3] + v1[0] + v1[1] + v1[2] + v1[3]);
                        if (MODE == 1 && ai == 1 && m == 3) *(GAS unsigned*)(lp + fr * 1024 + 8 * fq) = keep_;
                    }
                continue;
            }
#pragma unroll
            for (int ai = 0; ai < 2; ++ai) {
            v4u wout[4];
#pragma unroll
                for (int m = 0; m < 4; ++m) {
                    const int rowu = u.pm * 256 + ai * 128 + wr * 64 + m * 16, row = rowu + fr;
                    f32x4 v0 = acc[ai][bj][m][0] * osc, v1 = acc[ai][bj][m][1] * osc;
                    if (mode == 1) {
                        const int s = row & (SEQ - 1); const int half = wc & 1; const int pos = half ? (s & 63) : (s >> 6);
                        const float* tb = tab + (half ? 4096 : 0) + pos * 16 + 8 * (fq & 1); const int so = half ? 1024 : 2048;
                        const f32x4 c0 = *(const GAS f32x4*)tb, c1 = *(const GAS f32x4*)(tb + 4), s0 = *(const GAS f32x4*)(tb + so), s1 = *(const GAS f32x4*)(tb + so + 4);
                        const float sg = (fq < 2) ? -sc : sc;
                        f32x4 p0, p1;
#pragma unroll
                        for (int j = 0; j < 4; ++j) { p0[j] = __shfl_xor(v0[j], 32); p1[j] = __shfl_xor(v1[j], 32); }
                        v0 = v0 * c0 * sc + p0 * s0 * sg; v1 = v1 * c1 * sc + p1 * s1 * sg;
                    } else if (mode == 0) { v0 = v0 * sc; v1 = v1 * sc; }
                    else if (mode == 2) {
#pragma unroll
                        for (int j = 0; j < 4; ++j) { v0[j] = silu_f(v0[j]); v1[j] = silu_f(v1[j]); }
                    } else {
#pragma unroll
                        for (int j = 0; j < 4; ++j) { v0[j] = sigm_f(v0[j]); v1[j] = sigm_f(v1[j]); }
                    }
                    if (f8t) { const float fs = (pn <= 4) ? 16.f : 4.f; wout[m].x = f8x4(v0[0] * fs, v0[1] * fs, v0[2] * fs, v0[3] * fs); wout[m].y = f8x4(v1[0] * fs, v1[1] * fs, v1[2] * fs, v1[3] * fs); wout[m].z = 0u; wout[m].w = 0u; }
                    else wout[m] = pack8u(v0, v1);
                }
#pragma unroll
                for (int m = 0; m < 4; ++m) {
                    bf16* op = P + (size_t)(u.pm * 256 + ai * 128 + wr * 64 + m * 16) * INW + cu;
                    if (f8t) { u32x2 w8; w8.x = wout[m].x; w8.y = wout[m].y; *(GAS u32x2*)(QK8 + (size_t)(u.pm * 256 + ai * 128 + wr * 64 + m * 16 + fr) * 1024 + (cu - C_BQ) + 8 * fq) = w8; }
                    else if (MODE != 1) *(GAS v4u*)(op + fr * INW + 8 * fq) = wout[m]; else { const v4u pw = wout[m]; keep_ ^= pw.x ^ pw.y ^ pw.z ^ pw.w; if (ai == 1 && m == 3) *(GAS unsigned*)(op + fr * INW + 8 * fq) = keep_; }
                }
            }
        }
    }
};
typedef EpiInT<0> EpiIn;
struct EpiMerge {
    static constexpr bool PERM = true, AFTER_DRAIN = false, KHOOK = true;
    const bf16* P; bf16* Y;
    DI void khook(pg8::f32x4 (&acc)[2][2][4][2], const pg8::Unit& u, int seam, int wr, int wc, int fr_, int fq_) const {
        const int lane_ = tid_opaque() & 63, fr = lane_ & 15, fq = lane_ >> 4;
        const int loff = fr * INW + 8 * fq;
        v4u ga[2][2], gn[2][2];
#define MG_LD(g_) do { const bf16* gb_ = P + (size_t)(u.pm * 256 + ((g_) >> 2) * 128 + wr * 64 + ((g_) & 3) * 16) * INW + C_GT + (seam - 1) * 1024 + u.pn * 256 + wc * 32 + loff; \
            ga[(g_) & 1][0] = *(const GAS v4u*)gb_; gn[(g_) & 1][0] = *(const GAS v4u*)(gb_ + 1024); ga[(g_) & 1][1] = *(const GAS v4u*)(gb_ + 128); gn[(g_) & 1][1] = *(const GAS v4u*)(gb_ + 128 + 1024); } while (0)
        MG_LD(0);
#pragma unroll
        for (int g = 0; g < 8; ++g) {
            const int ai = g >> 2, m = g & 3;
            if (g < 7) MG_LD(g + 1);
            { asm volatile("" ::: "memory"); __builtin_amdgcn_sched_barrier(0); }
#pragma unroll
            for (int bj = 0; bj < 2; ++bj) {
                const v4u a_ = ga[g & 1][bj], n_ = gn[g & 1][bj];
                const f32x4 r0 = (f32x4){bflo(a_.x) * __builtin_amdgcn_rcpf(bflo(n_.x)), bfhi(a_.x) * __builtin_amdgcn_rcpf(bfhi(n_.x)), bflo(a_.y) * __builtin_amdgcn_rcpf(bflo(n_.y)), bfhi(a_.y) * __builtin_amdgcn_rcpf(bfhi(n_.y))};
                const f32x4 r1 = (f32x4){bflo(a_.z) * __builtin_amdgcn_rcpf(bflo(n_.z)), bfhi(a_.z) * __builtin_amdgcn_rcpf(bfhi(n_.z)), bflo(a_.w) * __builtin_amdgcn_rcpf(bflo(n_.w)), bfhi(a_.w) * __builtin_amdgcn_rcpf(bfhi(n_.w))};
                acc[ai][bj][m][0] = acc[ai][bj][m][0] * r0; acc[ai][bj][m][1] = acc[ai][bj][m][1] * r1;
            }
            { asm volatile("" ::: "memory"); __builtin_amdgcn_sched_barrier(0); }
        }
#undef MG_LD
    }
    DI void operator()(const pg8::f32x4 (&acc)[2][2][4][2], const pg8::Unit& u, int wr, int wc, int fr_, int fq_) const {
        const int lane_ = tid_opaque() & 63, fr = lane_ & 15, fq = lane_ >> 4;
        const int loff = fr * INW + 8 * fq, yoff = fr * 1024 + 8 * fq;
        v4u gw[2][2];
#define MG_LD(g_) do { const bf16* gb_ = P + (size_t)(u.pm * 256 + ((g_) >> 2) * 128 + wr * 64 + ((g_) & 3) * 16) * INW + C_GT + 2 * 1024 + u.pn * 256 + wc * 32 + loff; \
            gw[(g_) & 1][0] = *(const GAS v4u*)gb_; gw[(g_) & 1][1] = *(const GAS v4u*)(gb_ + 128); } while (0)
        MG_LD(0);
#pragma unroll
        for (int g = 0; g < 8; ++g) {
            const int ai = g >> 2, m = g & 3;
            if (g < 7) MG_LD(g + 1);
            { asm volatile("" ::: "memory"); __builtin_amdgcn_sched_barrier(0); }
            bf16* yb = Y + (size_t)(u.pm * 256 + ai * 128 + wr * 64 + m * 16) * 1024 + u.pn * 256 + wc * 32;
#pragma unroll
            for (int bj = 0; bj < 2; ++bj) {
                const v4u w_ = gw[g & 1][bj];
                const f32x4 v0 = acc[ai][bj][m][0] * (f32x4){bflo(w_.x), bfhi(w_.x), bflo(w_.y), bfhi(w_.y)}, v1 = acc[ai][bj][m][1] * (f32x4){bflo(w_.z), bfhi(w_.z), bflo(w_.w), bfhi(w_.w)};
                *(GAS v4u*)(yb + bj * 128 + yoff) = pack8u(v0, v1);
            }
            { asm volatile("" ::: "memory"); __builtin_amdgcn_sched_barrier(0); }
        }
#undef MG_LD
    }
};
struct EpiVT {
    static constexpr bool PERM = true, AFTER_DRAIN = false, KHOOK = false;
    unsigned char* VT; float sc;
    DI void operator()(const pg8::f32x4 (&acc)[2][2][4][2], const pg8::Unit& u, int wr, int wc, int fr_, int fq_) const {
        const int lane_ = tid_opaque() & 63, fr = lane_ & 15, fq = lane_ >> 4;
#pragma unroll
        for (int ai = 0; ai < 2; ++ai)
#pragma unroll
            for (int bj = 0; bj < 2; ++bj)
#pragma unroll
                for (int m = 0; m < 4; ++m) {
                    const f32x4 v0 = acc[ai][bj][m][0] * sc, v1 = acc[ai][bj][m][1] * sc;
                    u32x2 w8; w8.x = f8x4(v0[0], v0[1], v0[2], v0[3]); w8.y = f8x4(v1[0], v1[1], v1[2], v1[3]);
                    *(GAS u32x2*)(VT + (size_t)(u.pm * 256 + ai * 128 + wr * 64 + m * 16 + fr) * NTOK + u.pn * 256 + bj * 128 + wc * 32 + 8 * fq) = w8;
                }
    }
};
struct EpiNull {
    static constexpr bool PERM = true, AFTER_DRAIN = false, KHOOK = false;
    float* O;
    DI void operator()(const pg8::f32x4 (&acc)[2][2][4][2], const pg8::Unit& u, int wr, int wc, int fr_, int fq_) const {
        float s = 0.f;
#pragma unroll
        for (int ai = 0; ai < 2; ++ai)
#pragma unroll
            for (int bj = 0; bj < 2; ++bj)
#pragma unroll
                for (int m = 0; m < 4; ++m)
#pragma unroll
                    for (int n = 0; n < 2; ++n) s += (acc[ai][bj][m][n][0] + acc[ai][bj][m][n][1]) + (acc[ai][bj][m][n][2] + acc[ai][bj][m][n][3]);
        O[(size_t)(u.pm * 31 + (u.pn % 31)) * 512 + tid_opaque()] = s;
    }
};
struct EpiPlain {
    static constexpr bool PERM = true, AFTER_DRAIN = false, KHOOK = false;
    bf16* O; int ldc; const float* bias; int npn; float osc;
    DI void operator()(const pg8::f32x4 (&acc)[2][2][4][2], const pg8::Unit& u, int wr, int wc, int fr_, int fq_) const {
        const int lane_ = tid_opaque() & 63, fr = lane_ & 15, fq = lane_ >> 4;
        const int e = u.pn / npn, pn = u.pn % npn;
#pragma unroll
        for (int bj = 0; bj < 2; ++bj) {
            const int colu = pn * 256 + bj * 128 + wc * 32;
            f32x4 b0 = (f32x4){0.f, 0.f, 0.f, 0.f}, b1 = b0;
            if (bias) { const float* bp = bias + (size_t)e * npn * 256 + colu + 8 * fq; b0 = *(const GAS f32x4*)bp; b1 = *(const GAS f32x4*)(bp + 4); }
#pragma unroll
            for (int ai = 0; ai < 2; ++ai)
#pragma unroll
                for (int m = 0; m < 4; ++m) {
                    bf16* ob = O + (size_t)(u.pm * 256 + ai * 128 + wr * 64 + m * 16) * ldc + colu;
                    *(GAS v4u*)(ob + fr * ldc + 8 * fq) = pack8u(acc[ai][bj][m][0] * osc + b0, acc[ai][bj][m][1] * osc + b1);
                }
        }
    }
};
typedef short v2s_e __attribute__((ext_vector_type(2)));
DI unsigned f8x4sc(float a, float b, float c, float d) { v2s_e r = {0, 0}; r = __builtin_amdgcn_cvt_scalef32_pk_fp8_f32(r, a, b, 1.f / F8_MID, false); r = __builtin_amdgcn_cvt_scalef32_pk_fp8_f32(r, c, d, 1.f / F8_MID, true); return __builtin_bit_cast(unsigned, r); }
template <int MODE> struct EpiSwigluT {
    static constexpr bool PERM = true, AFTER_DRAIN = false, KHOOK = false;
    unsigned char* O; const float* bias;
    DI void operator()(const pg8::f32x4 (&acc)[2][2][4][2], const pg8::Unit& u, int wr, int wc, int fr_, int fq_) const {
        const int lane_ = tid_opaque() & 63, fr = lane_ & 15, fq = lane_ >> 4;
        const int e = u.pn >> 3, nt = u.pn & 7;
        const int colu = nt * 128 + wc * 32;
        const float* bp = bias + (size_t)e * 2048 + colu + 8 * fq;
        const f32x4 bg0 = *(const GAS f32x4*)bp, bg1 = *(const GAS f32x4*)(bp + 4), bu0 = *(const GAS f32x4*)(bp + 1024), bu1 = *(const GAS f32x4*)(bp + 1028);
        unsigned keep_ = 0u;
#pragma unroll
        for (int ai = 0; ai < 2; ++ai)
#pragma unroll
            for (int m = 0; m < 4; ++m) {
                f32x4 v[2];
#pragma unroll
                for (int n = 0; n < 2; ++n) { const f32x4 g = acc[ai][0][m][n] * (1.f / (F8_ACT * F8_W)) + (n ? bg1 : bg0), uu = acc[ai][1][m][n] * (1.f / (F8_ACT * F8_W)) + (n ? bu1 : bu0);
#pragma unroll
                    for (int j = 0; j < 4; ++j) { if (MODE == 2) v[n][j] = g[j] + uu[j]; else { const float gc = fminf(g[j], 7.f), uc = fminf(fmaxf(uu[j], -7.f), 7.f); v[n][j] = (uc + 1.f) * (gc * sigm_f(1.702f * gc)); } } }
                unsigned char* ob = O + (size_t)(u.pm * 256 + ai * 128 + wr * 64 + m * 16) * 1024 + colu;
                u32x2 w8; w8.x = f8x4sc(v[0][0], v[0][1], v[0][2], v[0][3]); w8.y = f8x4sc(v[1][0], v[1][1], v[1][2], v[1][3]);
                if (MODE != 1) *(GAS u32x2*)(ob + fr * 1024 + 8 * fq) = w8; else if (ai == 1 && m == 3) *(GAS unsigned*)(ob + fr * 1024 + 8 * fq) = w8.x ^ w8.y ^ keep_; else keep_ ^= w8.x + w8.y;
            }
    }
};
typedef EpiSwigluT<0> EpiSwiglu;
struct SubOrder {
    pg8::StaticOrder base; int skip_from, skip_n;
    DI bool next(int i, pg8::Unit& u) const { if (!base.next(i, u)) return false; if (u.pn >= skip_from) u.pn += skip_n; return true; }
    DI void a_ready(const pg8::Unit&) const {}
    DI void done(const pg8::Unit&) const {}
};
struct MoeOrder {
    const volatile LAS int* tpre; int NT, G, c;
    DI bool next(int i, pg8::Unit& u) const {
        const int L = i * G + c, total = __builtin_amdgcn_readfirstlane(tpre[32]) * NT; if (L >= total) return false;
        const int mt = L / NT, nt = L % NT; int e = 0;
        for (int k = 1; k < 32; ++k) e += (tpre[k] <= mt) ? 1 : 0;
        u.pm = mt; u.pn = __builtin_amdgcn_readfirstlane(e) * NT + nt; return true;
    }
    DI void a_ready(const pg8::Unit&) const {}
    DI void done(const pg8::Unit&) const {}
};

template <int KW> DI int swzK(int row) { return KW == 128 ? (row & 15) : ((row >> 1) & 7); }
template <int VD> DI int swzV(int row) { return VD == 128 ? (row & 3) : ((row >> 1) & 1); }
struct AttnJob {
    int qrow;
    int qcol;
    int kcolT, vcolT, kc8;
    int seg0_row, n0, seg0_kpos0;
    int seg1_row, n1;
    int qpos0;
};
template <int KW, int VD, bool WINDOW>
DI void attn_run(LAS unsigned char* lds, const bf16* P, const AttnJob& J, f32x16 (&O)[VD / 32], float& m_out, float& l_out) {
    const int tid = tid_opaque(), lane = tid & 63, r32 = lane & 31, hi = lane >> 5;
    constexpr int KCH = KW / 8, VCH = VD / 8, NKR = KW / 64, NVR = VD / 64;
    bf16x8 qf[4];
#pragma unroll
    for (int d0 = 0; d0 < 4; ++d0) qf[d0] = *(const GAS bf16x8*)(P + (size_t)(J.qrow + r32) * INW + J.qcol + d0 * 16 + hi * 8);
#pragma unroll
    for (int d = 0; d < VD / 32; ++d) O[d] = (f32x16){0.f, 0.f, 0.f, 0.f, 0.f, 0.f, 0.f, 0.f, 0.f, 0.f, 0.f, 0.f, 0.f, 0.f, 0.f, 0.f};
    float m = -1e30f, l = 0.f;
    const int nt = J.n0 + J.n1;
    v4u kr[NKR], vr[NVR];
#define ATT_TROW(t) ((t) < J.n0 ? J.seg0_row + 64 * (t) : J.seg1_row + 64 * ((t) - J.n0))
#define ATT_LOAD(t) do { const int rs_ = ATT_TROW(t); \
        _Pragma("unroll") for (int i = 0; i < NKR; ++i) { const int ci = tid + NTHR * i, row = ci / KCH, cc = ci % KCH; kr[i] = *(const GAS v4u*)(P + (size_t)(rs_ + row) * INW + J.kcolT + cc * 8); } \
        _Pragma("unroll") for (int i = 0; i < NVR; ++i) { const int ci = tid + NTHR * i, row = ci / VCH, cc = ci % VCH; vr[i] = *(const GAS v4u*)(P + (size_t)(rs_ + row) * INW + J.vcolT + cc * 8); } } while (0)
#define ATT_STORE(buf) do { \
        _Pragma("unroll") for (int i = 0; i < NKR; ++i) { const int ci = tid + NTHR * i, row = ci / KCH, cc = ci % KCH; *(LAS v4u*)(lds + (buf) * 16384 + row * (KW * 2) + ((cc ^ swzK<KW>(row)) << 4)) = kr[i]; } \
        _Pragma("unroll") for (int i = 0; i < NVR; ++i) { const int ci = tid + NTHR * i, row = ci / VCH, cc = ci % VCH; *(LAS v4u*)(lds + 32768 + (buf) * 16384 + row * (VD * 2) + ((((cc >> 2) ^ swzV<VD>(row)) << 6) | ((cc & 3) << 4))) = vr[i]; } } while (0)
    if (nt > 0) { ATT_LOAD(0); ATT_STORE(0); }
    __syncthreads();
    for (int t = 0; t < nt; ++t) {
        const int cur = t & 1;
        if (t + 1 < nt) ATT_LOAD(t + 1);
        const LAS unsigned char* kb = lds + cur * 16384; const LAS unsigned char* vb = lds + 32768 + cur * 16384;
        f32x16 st[2];
#pragma unroll
        for (int sub = 0; sub < 2; ++sub) {
            f32x16 a = (f32x16){0.f, 0.f, 0.f, 0.f, 0.f, 0.f, 0.f, 0.f, 0.f, 0.f, 0.f, 0.f, 0.f, 0.f, 0.f, 0.f};
            const int row = 32 * sub + r32;
#pragma unroll
            for (int d0 = 0; d0 < 4; ++d0) { const int ch = J.kc8 + 2 * d0 + hi;
                const bf16x8 kf = *(const LAS bf16x8*)(kb + row * (KW * 2) + ((ch ^ swzK<KW>(row)) << 4));
                a = MFMA32(kf, qf[d0], a); }
            st[sub] = a;
        }
        if (WINDOW && t < J.n0) {
            const int kp0 = J.seg0_kpos0 + 64 * t - (J.qpos0 + r32);
#pragma unroll
            for (int sub = 0; sub < 2; ++sub)
#pragma unroll
                for (int r = 0; r < 16; ++r) { const int rel = kp0 + 32 * sub + crow(r, hi); if (rel > 128 || rel < -128) st[sub][r] = -INFINITY; }
        }
        float tm = st[0][0];
#pragma unroll
        for (int r = 1; r < 16; ++r) tm = fmaxf(tm, st[0][r]);
#pragma unroll
        for (int r = 0; r < 16; ++r) tm = fmaxf(tm, st[1][r]);
        tm = fmaxf(tm, __shfl_xor(tm, 32));
        const float mn = fmaxf(m, tm), alpha = __builtin_amdgcn_exp2f(m - mn); m = mn;
        float ls = 0.f;
#pragma unroll
        for (int sub = 0; sub < 2; ++sub)
#pragma unroll
            for (int r = 0; r < 16; ++r) { const float p = __builtin_amdgcn_exp2f(st[sub][r] - mn); st[sub][r] = p; ls += p; }
        l = l * alpha + ls;
#pragma unroll
        for (int d = 0; d < VD / 32; ++d) O[d] = O[d] * alpha;
        bf16x8 pb[2][2];
#pragma unroll
        for (int sub = 0; sub < 2; ++sub)
#pragma unroll
            for (int s = 0; s < 2; ++s) pb[sub][s] = pack8(st[sub][8 * s], st[sub][8 * s + 1], st[sub][8 * s + 2], st[sub][8 * s + 3], st[sub][8 * s + 4], st[sub][8 * s + 5], st[sub][8 * s + 6], st[sub][8 * s + 7]);
        const int q4 = (lane & 15) >> 2, p4 = lane & 3, blk = (lane >> 4) & 1;
#pragma unroll
        for (int d = 0; d < VD / 32; ++d)
#pragma unroll
            for (int sub = 0; sub < 2; ++sub)
#pragma unroll
                for (int s = 0; s < 2; ++s) {
                    const int r0 = 32 * sub + 16 * s + 4 * hi + q4, r1 = r0 + 8;
                    const s16x4 lo = tr_read((LAS const char*)(vb + r0 * (VD * 2) + (((d ^ swzV<VD>(r0)) << 6) | (blk << 5) | (p4 << 3))));
                    const s16x4 hh = tr_read((LAS const char*)(vb + r1 * (VD * 2) + (((d ^ swzV<VD>(r1)) << 6) | (blk << 5) | (p4 << 3))));
                    O[d] = MFMA32(cat8(lo, hh), pb[sub][s], O[d]);
                }
        if (t + 1 < nt) ATT_STORE(cur ^ 1);
        __syncthreads();
    }
#undef ATT_TROW
#undef ATT_LOAD
#undef ATT_STORE
    l += __shfl_xor(l, 32);
    m_out = m; l_out = l;
}

#define SPLAT16(x) ((f32x16){(x), (x), (x), (x), (x), (x), (x), (x), (x), (x), (x), (x), (x), (x), (x), (x)})
DI float fadd_s(float a, float b) { float r; asm("v_add_f32_e32 %0, %1, %2" : "=v"(r) : "v"(a), "v"(b)); return r; }
DI float max3_asm(float a, float b, float c) { float r; asm("v_max3_f32 %0, %1, %2, %3" : "=v"(r) : "v"(a), "v"(b), "v"(c)); return r; }
DI float rowmax32(const f32x16& a, const f32x16& b) {
    float x = max3_asm(a[0], a[1], b[0]), y = max3_asm(a[2], a[3], b[1]);
    x = max3_asm(x, b[2], b[3]);
#pragma unroll
    for (int r = 4; r < 16; r += 4) { x = max3_asm(x, a[r], a[r + 1]); y = max3_asm(y, a[r + 2], a[r + 3]); x = max3_asm(x, b[r], b[r + 1]); y = max3_asm(y, b[r + 2], b[r + 3]); }
    x = fmaxf(x, y);
    const auto sw = __builtin_amdgcn_permlane32_swap(__float_as_uint(x), __float_as_uint(x), false, false);
    return max3_asm(__uint_as_float(sw[0]), __uint_as_float(sw[1]), x);
}
#define LDSRD128(dst, addr, off) asm volatile("ds_read_b128 %0, %1 offset:%c2" : "=&v"(dst) : "v"(addr), "i"(off) : "memory")
#define LDSTR64(dst, addr, off) asm volatile("ds_read_b64_tr_b16 %0, %1 offset:%c2" : "=&v"(dst) : "v"(addr), "i"(off) : "memory")
#define LGKM_WAIT(n) do { asm volatile("s_waitcnt lgkmcnt(" #n ")" ::: "memory"); __builtin_amdgcn_sched_barrier(0); } while (0)
#define AA_TROW(J_, t) ((t) < (J_).n0 ? (J_).seg0_row + 64 * (t) : (J_).seg1_row + 64 * ((t) - (J_).n0))
DI void attn_a_fetch(const bf16* P, const AttnJob& J, bf16x8 (&qf)[4], v4u (&kr)[9], v4u (&vr)[9]) {
    const int tid = tid_opaque(), lane = tid & 63, r32 = lane & 31, hi = lane >> 5, row = tid >> 3, cc = tid & 7, nt = J.n0 + J.n1;
#pragma unroll
    for (int d0 = 0; d0 < 4; ++d0) qf[d0] = *(const GAS bf16x8*)(P + (size_t)(J.qrow + r32) * INW + J.qcol + d0 * 16 + hi * 8);
#pragma unroll
    for (int t = 0; t < 9; ++t) if (t < nt) { const int rs_ = AA_TROW(J, t);
        kr[t] = *(const GAS v4u*)(P + (size_t)(rs_ + row) * INW + J.kcolT + cc * 8); vr[t] = *(const GAS v4u*)(P + (size_t)(rs_ + row) * INW + J.vcolT + cc * 8); }
}
DI void attn_a_stage(LAS unsigned char* lds, const AttnJob& J, const v4u (&kr)[9], const v4u (&vr)[9]) {
    const int tid = tid_opaque(), row = tid >> 3, cc = tid & 7, nt = J.n0 + J.n1;
#pragma unroll
    for (int t = 0; t < 9; ++t) if (t < nt) {
        *(LAS v4u*)(lds + t * 8192 + row * 128 + ((cc ^ swzK<64>(row)) << 4)) = kr[t];
        *(LAS v4u*)(lds + 73728 + t * 8192 + row * 128 + ((((cc >> 2) ^ swzV<64>(row)) << 6) | ((cc & 3) << 4))) = vr[t]; }
}
template <bool WINDOW>
DI void attn_run_bulk(LAS unsigned char* lds, const AttnJob& J, const bf16x8 (&qf)[4], f32x16 (&O)[2], float& m_out, float& l_out) {
    const int tid = tid_opaque(), lane = tid & 63, r32 = lane & 31, hi = lane >> 5;
    constexpr int KW = 64, VD = 64;
    const int nt = J.n0 + J.n1;
#pragma unroll
    for (int d = 0; d < 2; ++d) O[d] = (f32x16){0.f, 0.f, 0.f, 0.f, 0.f, 0.f, 0.f, 0.f, 0.f, 0.f, 0.f, 0.f, 0.f, 0.f, 0.f, 0.f};
    float m = 0.f, l = 0.f;
    const unsigned lds0 = (unsigned)(uintptr_t)lds;
    const unsigned ka0 = lds0 + r32 * 128 + ((hi ^ ((r32 >> 1) & 7)) << 4);
    unsigned va0; { const int q4 = (lane & 15) >> 2, p4 = lane & 3, blk = (lane >> 4) & 1;
      va0 = lds0 + 73728 + (4 * hi + q4) * 128 + ((((q4 >> 1) & 1) << 6) | (blk << 5) | (p4 << 3)); }
    f32x16 negm = SPLAT16(0.f);
    m = 0.f;
    for (int t = 0; t < nt; ++t) {
        const unsigned kt = ka0 + t * 8192, vt = va0 + t * 8192;
        bf16x8 kf[2][4]; s16x4 vf[2][2][2][2];
#pragma unroll
        for (int sub = 0; sub < 2; ++sub)
#pragma unroll
            for (int d0 = 0; d0 < 4; ++d0) LDSRD128(kf[sub][d0], kt ^ (d0 << 5), sub * 4096);
#define AA_VRD(d) _Pragma("unroll") for (int sub = 0; sub < 2; ++sub) _Pragma("unroll") for (int s = 0; s < 2; ++s) { \
            LDSTR64(vf[d][sub][s][0], vt ^ ((d) << 6), sub * 4096 + s * 2048); LDSTR64(vf[d][sub][s][1], vt ^ ((d) << 6), sub * 4096 + s * 2048 + 1024); }
        LGKM_WAIT(0);
        AA_VRD(0)
        f32x16 st[2]; st[0] = negm; st[1] = negm;
#pragma unroll
        for (int d0 = 0; d0 < 4; ++d0) { st[0] = MFMA32(kf[0][d0], qf[d0], st[0]); st[1] = MFMA32(kf[1][d0], qf[d0], st[1]); __builtin_amdgcn_sched_barrier(0); }
        if (WINDOW && t < J.n0) {
            const int kp0 = J.seg0_kpos0 + 64 * t - J.qpos0;
            if (kp0 - 31 < -128 || kp0 + 63 > 128) {
                const int kpl = kp0 - r32;
#pragma unroll
                for (int sub = 0; sub < 2; ++sub)
#pragma unroll
                    for (int r = 0; r < 16; ++r) { const int rel = kpl + 32 * sub + crow(r, hi); if (rel > 128 || rel < -128) st[sub][r] = -INFINITY; }
            }
        }
        asm volatile("s_nop 15\n\ts_nop 7" : "+v"(st[0]), "+v"(st[1]));
        { const float tm_ = rowmax32(st[0], st[1]); const float sh_ = (t == 0) ? tm_ : (tm_ > 8.f ? tm_ : 0.f);
          if (__any(sh_ != 0.f)) {
#pragma unroll
              for (int r = 0; r < 16; ++r) { st[0][r] -= sh_; st[1][r] -= sh_; }
              m += sh_; negm = SPLAT16(-m);
              if (t > 0) { const float al_ = __builtin_amdgcn_exp2f(-sh_); l *= al_;
#pragma unroll
                  for (int d = 0; d < 2; ++d) O[d] = O[d] * al_; } } }
#pragma unroll
        for (int r = 0; r < 16; ++r) { st[0][r] = __builtin_amdgcn_exp2f(st[0][r]); st[1][r] = __builtin_amdgcn_exp2f(st[1][r]); }
        { float s0_ = st[0][0] + st[1][0], s1_ = st[0][1] + st[1][1];
#pragma unroll
          for (int r = 2; r < 16; r += 2) { s0_ += st[0][r]; s1_ += st[0][r + 1]; s0_ += st[1][r]; s1_ += st[1][r + 1]; }
          l += s0_ + s1_; }
        bf16x8 pb[2][2];
#pragma unroll
        for (int sub = 0; sub < 2; ++sub)
#pragma unroll
            for (int s = 0; s < 2; ++s) pb[sub][s] = pack8(st[sub][8 * s], st[sub][8 * s + 1], st[sub][8 * s + 2], st[sub][8 * s + 3], st[sub][8 * s + 4], st[sub][8 * s + 5], st[sub][8 * s + 6], st[sub][8 * s + 7]);
        AA_VRD(1)
        LGKM_WAIT(0);
#pragma unroll
        for (int sub = 0; sub < 2; ++sub)
#pragma unroll
            for (int s = 0; s < 2; ++s) { O[0] = MFMA32(cat8(vf[0][sub][s][0], vf[0][sub][s][1]), pb[sub][s], O[0]); O[1] = MFMA32(cat8(vf[1][sub][s][0], vf[1][sub][s][1]), pb[sub][s], O[1]); __builtin_amdgcn_sched_barrier(0); }
#undef AA_VRD
    }
    l += __shfl_xor(l, 32);
    m_out = m; l_out = l;
}

DI void attn_a_job(int u, int wave, AttnJob& J, int& head) {
    int b, kvh, q0; const bool cq = u >= 512;
    if (!cq) { b = u >> 8; kvh = (u >> 7) & 1; q0 = (u & 127) * 64;
        int jlo = 0, jhi = 4; if (q0 == 0) jlo = 2; else if (q0 == 64) jlo = 1; if (q0 == SEQ - 64) jhi = 2; else if (q0 == SEQ - 128) jhi = 3;
        J.seg0_kpos0 = q0 - 128 + 64 * jlo; J.seg0_row = b * SEQ + J.seg0_kpos0; J.n0 = jhi - jlo + 1; J.qrow = b * SEQ + q0 + 32 * (wave & 1); J.qpos0 = q0 + 32 * (wave & 1); }
    else { const int v = u - 512; b = v >> 3; kvh = (v >> 2) & 1; q0 = (v & 3) * 64; J.seg0_kpos0 = 0; J.seg0_row = 0; J.n0 = 0; J.qrow = NLAT + b * CTXL + q0 + 32 * (wave & 1); J.qpos0 = 0; }
    head = kvh * 4 + (wave >> 1);
    J.qcol = C_AQ + head * 64; J.kcolT = C_AK + kvh * 64; J.vcolT = C_AV + kvh * 64; J.kc8 = 0; J.seg1_row = NLAT + b * CTXL; J.n1 = 4;
}
DI void ph_attn_a(LAS unsigned char* lds, const bf16* P, bf16* OA, const float* sink, bool with_ctx, int vcu, int G) {
    const int lane = tid_opaque() & 63, wave = __builtin_amdgcn_readfirstlane(tid_opaque() >> 6), r32 = lane & 31, hi = lane >> 5;
    const int nun = 512 + (with_ctx ? 16 : 0);
    AttnJob J, Jn; int head = 0, headn = 0;
    bf16x8 qf[4], qn[4]; v4u kr[9], vr[9];
    if (vcu < nun) { attn_a_job(vcu, wave, J, head); attn_a_fetch(P, J, qn, kr, vr); }
    for (int u = vcu; u < nun; u += G) {
#pragma unroll
        for (int d0 = 0; d0 < 4; ++d0) qf[d0] = qn[d0];
        attn_a_stage(lds, J, kr, vr);
        const float sk = sink[head];
        __syncthreads();
        if (u + G < nun) { attn_a_job(u + G, wave, Jn, headn); attn_a_fetch(P, Jn, qn, kr, vr); }
        f32x16 O[2]; float m, l;
        attn_run_bulk<true>(lds, J, qf, O, m, l);
        l += __builtin_amdgcn_exp2f(sk * LOG2E - m);
        const float inv = 1.f / l;
        bf16* op = OA + (size_t)(J.qrow + r32) * 1536 + head * 64;
#pragma unroll
        for (int d = 0; d < 2; ++d)
#pragma unroll
            for (int rg = 0; rg < 4; ++rg) { u32x2 w; w.x = cvtpk(O[d][4 * rg] * inv, O[d][4 * rg + 1] * inv); w.y = cvtpk(O[d][4 * rg + 2] * inv, O[d][4 * rg + 3] * inv);
                *(GAS u32x2*)(op + 32 * d + 8 * rg + 4 * hi) = w; }
        __syncthreads();
        J = Jn; head = headn;
    }
}
#ifndef AB_WIDE
#define AB_WIDE 1
#endif
#ifndef AB_F8PV
#define AB_F8PV 1
#endif
template <int VAR> DI void attn_b_run(LAS unsigned char* lds, const bf16* P, const AttnJob& J, f32x16 (&O)[4], float& l_out) {
    const int tid = tid_opaque(), lane = tid & 63, r32 = lane & 31, hi = lane >> 5, wave = __builtin_amdgcn_readfirstlane(tid >> 6);
    bf16x8 qf[4];
#pragma unroll
    for (int d0 = 0; d0 < 4; ++d0) qf[d0] = *(const GAS bf16x8*)(P + (size_t)(J.qrow + r32) * INW + J.qcol + d0 * 16 + hi * 8);
#pragma unroll
    for (int d = 0; d < 4; ++d) O[d] = SPLAT16(0.f);
    const int nt = J.n0 + J.n1;
    const unsigned lds0 = (unsigned)(uintptr_t)lds;
    unsigned ka0, va0;
    { const int q4 = (lane & 15) >> 2, p4 = lane & 3, blk = (lane >> 4) & 1;
      ka0 = lds0 + r32 * 256 + (((J.kc8 + hi) ^ (r32 & 15)) << 4);
      va0 = lds0 + 49152 + (4 * hi + q4) * 256 + ((q4 << 6) | (blk << 5) | (p4 << 3)); }
#define ka(i) (ka0 ^ ((i) << 5))
#define va(i) (va0 ^ ((i) << 6))
#define AB_TROW(t) ((t) < J.n0 ? J.seg0_row + 64 * (t) : J.seg1_row + 64 * ((t) - J.n0))
    unsigned dko[2], dvo[2];
#pragma unroll
    for (int i = 0; i < 2; ++i) { const int row_ = 4 * (2 * wave + i) + (lane >> 4), cp_ = lane & 15;
        dko[i] = (unsigned)(row_ * INW + J.kcolT + ((cp_ ^ (row_ & 15)) << 3)) * 2u; dvo[i] = (unsigned)(row_ * INW + J.vcolT + (((((cp_ >> 2) ^ (row_ & 3)) << 2) | (cp_ & 3)) << 3)) * 2u; }
#define AB_DMA(t, st) do { const char* src_ = (const char*)(P + (size_t)AB_TROW(t) * INW); \
        _Pragma("unroll") for (int i = 0; i < 2; ++i) __builtin_amdgcn_global_load_lds((const unsigned*)(src_ + dko[i]), (LAS unsigned*)(lds + (st) * 16384 + (2 * wave + i) * 1024), 16, 0, 0); \
        _Pragma("unroll") for (int i = 0; i < 2; ++i) __builtin_amdgcn_global_load_lds((const unsigned*)(src_ + dvo[i]), (LAS unsigned*)(lds + 49152 + (st) * 16384 + (2 * wave + i) * 1024), 16, 0, 0); } while (0)
#define AB_KREAD(ST) do { \
        LDSRD128(kf[0], ka(0), (ST) * 16384); LDSRD128(kf[1], ka(0), (ST) * 16384 + 8192); LDSRD128(kf[2], ka(1), (ST) * 16384); LDSRD128(kf[3], ka(1), (ST) * 16384 + 8192); \
        LDSRD128(kf[4], ka(2), (ST) * 16384); LDSRD128(kf[5], ka(2), (ST) * 16384 + 8192); LDSRD128(kf[6], ka(3), (ST) * 16384); LDSRD128(kf[7], ka(3), (ST) * 16384 + 8192); } while (0)
#define AB_QKM(S0, S1) do { S0 = MFMA32(kf[0], qf[0], negm); S1 = MFMA32(kf[1], qf[0], negm); S0 = MFMA32(kf[2], qf[1], S0); S1 = MFMA32(kf[3], qf[1], S1); \
        S0 = MFMA32(kf[4], qf[2], S0); S1 = MFMA32(kf[5], qf[2], S1); S0 = MFMA32(kf[6], qf[3], S0); S1 = MFMA32(kf[7], qf[3], S1); } while (0)
#define AB_VREAD(VB, D, ST) do { \
        LDSTR64(VB[0], va(D), (ST) * 16384 + 0 * 4096); LDSTR64(VB[1], va(D), (ST) * 16384 + 0 * 4096 + 2048); LDSTR64(VB[2], va(D), (ST) * 16384 + 1 * 4096); LDSTR64(VB[3], va(D), (ST) * 16384 + 1 * 4096 + 2048); \
        LDSTR64(VB[4], va(D), (ST) * 16384 + 2 * 4096); LDSTR64(VB[5], va(D), (ST) * 16384 + 2 * 4096 + 2048); LDSTR64(VB[6], va(D), (ST) * 16384 + 3 * 4096); LDSTR64(VB[7], va(D), (ST) * 16384 + 3 * 4096 + 2048); } while (0)
#define AB_PVM(VB, D) do { O[D] = MFMA32(cat8(VB[0], VB[1]), pb00, O[D]); O[D] = MFMA32(cat8(VB[2], VB[3]), pb01, O[D]); O[D] = MFMA32(cat8(VB[4], VB[5]), pb10, O[D]); O[D] = MFMA32(cat8(VB[6], VB[7]), pb11, O[D]); } while (0)
    float m = 0.f, l = 0.f;
    f32x16 c0, c1, negm = SPLAT16(0.f);
    bf16x8 kf[8]; s16x4 vA[8], vB[8];
    AB_DMA(0, 0); if (nt > 1) AB_DMA(1, 1);
    if (nt > 1) asm volatile("s_waitcnt vmcnt(4)" ::: "memory"); else asm volatile("s_waitcnt vmcnt(0)" ::: "memory");
    __syncthreads();
#define AB_VREADK(VB, SS, ST) do { \
        LDSTR64(VB[0], va(0), (ST) * 16384 + (SS) * 4096); LDSTR64(VB[1], va(0), (ST) * 16384 + (SS) * 4096 + 2048); LDSTR64(VB[2], va(1), (ST) * 16384 + (SS) * 4096); LDSTR64(VB[3], va(1), (ST) * 16384 + (SS) * 4096 + 2048); \
        LDSTR64(VB[4], va(2), (ST) * 16384 + (SS) * 4096); LDSTR64(VB[5], va(2), (ST) * 16384 + (SS) * 4096 + 2048); LDSTR64(VB[6], va(3), (ST) * 16384 + (SS) * 4096); LDSTR64(VB[7], va(3), (ST) * 16384 + (SS) * 4096 + 2048); } while (0)
#define AB_EX2(C, B) do { C[B] = __builtin_amdgcn_exp2f(C[B]); C[(B) + 1] = __builtin_amdgcn_exp2f(C[(B) + 1]); } while (0)
#define AB_GAP(VB, D, PB, C, B) do { O[D] = MFMA32(cat8(VB[2 * (D)], VB[2 * (D) + 1]), PB, O[D]); AB_EX2(C, B); __builtin_amdgcn_sched_barrier(0); } while (0)
#define AB_GAPN(VB, D, PB) do { O[D] = MFMA32(cat8(VB[2 * (D)], VB[2 * (D) + 1]), PB, O[D]); __builtin_amdgcn_sched_barrier(0); } while (0)
#define AB_PK(C, B) pack8(C[B], C[(B) + 1], C[(B) + 2], C[(B) + 3], C[(B) + 4], C[(B) + 5], C[(B) + 6], C[(B) + 7])
#define AB_STEP(t, ST) do { \
        if ((t) + 2 < nt && (!(VAR & 4) || (t) < 1)) AB_DMA((t) + 2, ((ST) + 2) % 3); \
        if (!(VAR & 16) || wave < 4) { \
        if (!(VAR & 8)) { AB_KREAD(ST); LGKM_WAIT(0); AB_QKM(c0, c1); } else { c0 = negm; c1 = negm; } \
        AB_VREAD(vA, 0, ST); \
        asm volatile("s_nop 15\n\ts_nop 7" : "+v"(c0), "+v"(c1));     \
        { const float tm_ = rowmax32(c0, c1); const float sh_ = ((t) == 0) ? tm_ : (tm_ > 8.f ? tm_ : 0.f); \
          if (__any(sh_ != 0.f)) { _Pragma("unroll") for (int r = 0; r < 16; ++r) { c0[r] -= sh_; c1[r] -= sh_; } m += sh_; negm = SPLAT16(-m); \
              if ((t) > 0) { const float al_ = __builtin_amdgcn_exp2f(-sh_); l *= al_; _Pragma("unroll") for (int d = 0; d < 4; ++d) O[d] = O[d] * al_; } } } \
        float ls_ = 0.f; \
        { \
        if (!(VAR & 1)) { _Pragma("unroll") for (int r = 0; r < 16; ++r) { c0[r] = __builtin_amdgcn_exp2f(c0[r]); c1[r] = __builtin_amdgcn_exp2f(c1[r]); } } \
        { const f32x16 s_ = c0 + c1; const float s0_ = (s_[0] + s_[1]) + (s_[2] + s_[3]), s1_ = (s_[4] + s_[5]) + (s_[6] + s_[7]), s2_ = (s_[8] + s_[9]) + (s_[10] + s_[11]), s3_ = (s_[12] + s_[13]) + (s_[14] + s_[15]); ls_ = (s0_ + s1_) + (s2_ + s3_); } \
        l += ls_; \
        const bf16x8 pb00 = pack8(c0[0], c0[1], c0[2], c0[3], c0[4], c0[5], c0[6], c0[7]), pb01 = pack8(c0[8], c0[9], c0[10], c0[11], c0[12], c0[13], c0[14], c0[15]); \
        const bf16x8 pb10 = pack8(c1[0], c1[1], c1[2], c1[3], c1[4], c1[5], c1[6], c1[7]), pb11 = pack8(c1[8], c1[9], c1[10], c1[11], c1[12], c1[13], c1[14], c1[15]); \
        if (!(VAR & 2)) { AB_VREAD(vB, 1, ST); LGKM_WAIT(8); AB_PVM(vA, 0); \
        AB_VREAD(vA, 2, ST); LGKM_WAIT(8); AB_PVM(vB, 1); \
        AB_VREAD(vB, 3, ST); LGKM_WAIT(8); AB_PVM(vA, 2); \
        LGKM_WAIT(0); AB_PVM(vB, 3); } else { LGKM_WAIT(0); O[0][0] += c0[0] + (float)vA[0][0]; } } } \
        if ((t) + 2 < nt) asm volatile("s_waitcnt vmcnt(4)" ::: "memory"); else asm volatile("s_waitcnt vmcnt(0)" ::: "memory"); \
        if (!(VAR & 32) || (t) < 2 || (t) + 3 >= nt) __syncthreads(); } while (0)
    for (int t = 0; t < nt; t += 3) {
        AB_STEP(t, 0);
        if (t + 1 < nt) AB_STEP(t + 1, 1);
        if (t + 2 < nt) AB_STEP(t + 2, 2);
    }
#undef ka
#undef va
#undef AB_TROW
#undef AB_DMA
#undef AB_KREAD
#undef AB_QKM
#undef AB_VREAD
#undef AB_PVM
#undef AB_STEP
#undef AB_VREADK
#undef AB_EX2
#undef AB_GAP
#undef AB_GAPN
#undef AB_PK
    l += __shfl_xor(l, 32);
    l_out = l;
}
DI void attn_b_run_w(LAS unsigned char* lds, const bf16* P, const AttnJob& J, f32x16 (&O)[4], float& l_out) {
    const int tid = tid_opaque(), lane = tid & 63, r32 = lane & 31, hi = lane >> 5, wave = __builtin_amdgcn_readfirstlane(tid >> 6);
    bf16x8 qf[4];
#pragma unroll
    for (int d0 = 0; d0 < 4; ++d0) qf[d0] = *(const GAS bf16x8*)(P + (size_t)(J.qrow + r32) * INW + J.qcol + d0 * 16 + hi * 8);
#pragma unroll
    for (int d = 0; d < 4; ++d) O[d] = SPLAT16(0.f);
    const int ns = (J.n0 + J.n1) >> 1;
    const unsigned lds0 = (unsigned)(uintptr_t)lds;
    unsigned ka0, va0;
    { const int q4 = (lane & 15) >> 2, p4 = lane & 3, blk = (lane >> 4) & 1;
      ka0 = lds0 + r32 * 256 + (((J.kc8 + hi) ^ (r32 & 15)) << 4);
      va0 = lds0 + 65536 + (4 * hi + q4) * 256 + ((q4 << 6) | (blk << 5) | (p4 << 3)); }
#define ka(i) (ka0 ^ ((i) << 5))
#define va(i) (va0 ^ ((i) << 6))
#define AW_TROW(t) ((t) < J.n0 ? J.seg0_row + 64 * (t) : J.seg1_row + 64 * ((t) - J.n0))
    unsigned dko[2], dvo[2];
#pragma unroll
    for (int i = 0; i < 2; ++i) { const int row_ = 4 * (2 * wave + i) + (lane >> 4), cp_ = lane & 15;
        dko[i] = (unsigned)(row_ * INW + J.kcolT + ((cp_ ^ (row_ & 15)) << 3)) * 2u; dvo[i] = (unsigned)(row_ * INW + J.vcolT + (((((cp_ >> 2) ^ (row_ & 3)) << 2) | (cp_ & 3)) << 3)) * 2u; }
#define AW_DMA1(t, off) do { const char* src_ = (const char*)(P + (size_t)AW_TROW(t) * INW); \
        _Pragma("unroll") for (int i = 0; i < 2; ++i) __builtin_amdgcn_global_load_lds((const unsigned*)(src_ + dko[i]), (LAS unsigned*)(lds + (off) + (2 * wave + i) * 1024), 16, 0, 0); \
        _Pragma("unroll") for (int i = 0; i < 2; ++i) __builtin_amdgcn_global_load_lds((const unsigned*)(src_ + dvo[i]), (LAS unsigned*)(lds + 65536 + (off) + (2 * wave + i) * 1024), 16, 0, 0); } while (0)
#define AW_DMA(j, st) do { AW_DMA1(2 * (j), (st) * 32768); AW_DMA1(2 * (j) + 1, (st) * 32768 + 16384); } while (0)
#define AW_KREAD(OFF, H) do { \
        LDSRD128(kf[0], ka(2 * (H)), (OFF)); LDSRD128(kf[1], ka(2 * (H)), (OFF) + 8192); LDSRD128(kf[2], ka(2 * (H) + 1), (OFF)); LDSRD128(kf[3], ka(2 * (H) + 1), (OFF) + 8192); } while (0)
#define AW_QKM0(S0, S1) do { S0 = MFMA32(kf[0], qf[0], negm); S1 = MFMA32(kf[1], qf[0], negm); S0 = MFMA32(kf[2], qf[1], S0); S1 = MFMA32(kf[3], qf[1], S1); } while (0)
#define AW_QKM1(S0, S1) do { S0 = MFMA32(kf[0], qf[2], S0); S1 = MFMA32(kf[1], qf[2], S1); S0 = MFMA32(kf[2], qf[3], S0); S1 = MFMA32(kf[3], qf[3], S1); } while (0)
#define AW_VREAD(VB, D, OFF) do { \
        LDSTR64(VB[0], va(D), (OFF) + 0 * 4096); LDSTR64(VB[1], va(D), (OFF) + 0 * 4096 + 2048); LDSTR64(VB[2], va(D), (OFF) + 1 * 4096); LDSTR64(VB[3], va(D), (OFF) + 1 * 4096 + 2048); \
        LDSTR64(VB[4], va(D), (OFF) + 2 * 4096); LDSTR64(VB[5], va(D), (OFF) + 2 * 4096 + 2048); LDSTR64(VB[6], va(D), (OFF) + 3 * 4096); LDSTR64(VB[7], va(D), (OFF) + 3 * 4096 + 2048); } while (0)
#define AW_PVM(VB, D, PA, PB_, PC, PD) do { O[D] = MFMA32(cat8(VB[0], VB[1]), PA, O[D]); O[D] = MFMA32(cat8(VB[2], VB[3]), PB_, O[D]); O[D] = MFMA32(cat8(VB[4], VB[5]), PC, O[D]); O[D] = MFMA32(cat8(VB[6], VB[7]), PD, O[D]); } while (0)
#define AW_PK(C, B) pack8(C[B], C[(B) + 1], C[(B) + 2], C[(B) + 3], C[(B) + 4], C[(B) + 5], C[(B) + 6], C[(B) + 7])
    float m = 0.f, l = 0.f;
    f32x16 c00, c01, c10, c11;
    bf16x8 kf[4]; s16x4 vA[8], vB[8];
    AW_DMA(0, 0);
    asm volatile("s_waitcnt vmcnt(0)" ::: "memory"); __syncthreads();
#define AW_STEP(j, ST) do { \
        if ((j) + 1 < ns) AW_DMA((j) + 1, 1 - (ST)); \
        const f32x16 negm = SPLAT16(-m); \
        AW_KREAD((ST) * 32768, 0); LGKM_WAIT(0); AW_QKM0(c00, c01); AW_KREAD((ST) * 32768, 1); LGKM_WAIT(0); AW_QKM1(c00, c01); \
        AW_KREAD((ST) * 32768 + 16384, 0); LGKM_WAIT(0); AW_QKM0(c10, c11); AW_KREAD((ST) * 32768 + 16384, 1); LGKM_WAIT(0); AW_QKM1(c10, c11); \
        AW_VREAD(vA, 0, (ST) * 32768); \
        asm volatile("s_nop 15\n\ts_nop 7" : "+v"(c00), "+v"(c01), "+v"(c10), "+v"(c11)); \
        { const float tm_ = fmaxf(rowmax32(c00, c01), rowmax32(c10, c11)); const float sh_ = ((j) == 0) ? tm_ : (tm_ > 8.f ? tm_ : 0.f); \
          if (__any(sh_ != 0.f)) { _Pragma("unroll") for (int r = 0; r < 16; ++r) { c00[r] -= sh_; c01[r] -= sh_; c10[r] -= sh_; c11[r] -= sh_; } m += sh_; \
              if ((j) > 0) { const float al_ = __builtin_amdgcn_exp2f(-sh_); l *= al_; _Pragma("unroll") for (int d = 0; d < 4; ++d) O[d] = O[d] * al_; } } } \
        _Pragma("unroll") for (int r = 0; r < 16; ++r) { c00[r] = __builtin_amdgcn_exp2f(c00[r]); c01[r] = __builtin_amdgcn_exp2f(c01[r]); c10[r] = __builtin_amdgcn_exp2f(c10[r]); c11[r] = __builtin_amdgcn_exp2f(c11[r]); } \
        { float s0_ = fadd_s(c00[0], c01[0]), s1_ = fadd_s(c00[1], c01[1]), s2_ = fadd_s(c10[0], c11[0]), s3_ = fadd_s(c10[1], c11[1]);     \
          _Pragma("unroll") for (int r = 2; r < 16; r += 2) { s0_ = fadd_s(s0_, c00[r]); s1_ = fadd_s(s1_, c00[r + 1]); s2_ = fadd_s(s2_, c10[r]); s3_ = fadd_s(s3_, c10[r + 1]); \
              s0_ = fadd_s(s0_, c01[r]); s1_ = fadd_s(s1_, c01[r + 1]); s2_ = fadd_s(s2_, c11[r]); s3_ = fadd_s(s3_, c11[r + 1]); } \
          l = fadd_s(l, fadd_s(fadd_s(s0_, s1_), fadd_s(s2_, s3_))); } \
        const bf16x8 pa0 = AW_PK(c00, 0), pa1 = AW_PK(c00, 8), pa2 = AW_PK(c01, 0), pa3 = AW_PK(c01, 8); \
        AW_VREAD(vB, 1, (ST) * 32768); LGKM_WAIT(8); AW_PVM(vA, 0, pa0, pa1, pa2, pa3); \
        AW_VREAD(vA, 2, (ST) * 32768); LGKM_WAIT(8); AW_PVM(vB, 1, pa0, pa1, pa2, pa3); \
        AW_VREAD(vB, 3, (ST) * 32768); LGKM_WAIT(8); AW_PVM(vA, 2, pa0, pa1, pa2, pa3); \
        AW_VREAD(vA, 0, (ST) * 32768 + 16384); LGKM_WAIT(8); AW_PVM(vB, 3, pa0, pa1, pa2, pa3); \
        const bf16x8 pb0 = AW_PK(c10, 0), pb1 = AW_PK(c10, 8), pb2 = AW_PK(c11, 0), pb3 = AW_PK(c11, 8); \
        AW_VREAD(vB, 1, (ST) * 32768 + 16384); LGKM_WAIT(8); AW_PVM(vA, 0, pb0, pb1, pb2, pb3); \
        AW_VREAD(vA, 2, (ST) * 32768 + 16384); LGKM_WAIT(8); AW_PVM(vB, 1, pb0, pb1, pb2, pb3); \
        AW_VREAD(vB, 3, (ST) * 32768 + 16384); LGKM_WAIT(8); AW_PVM(vA, 2, pb0, pb1, pb2, pb3); \
        LGKM_WAIT(0); AW_PVM(vB, 3, pb0, pb1, pb2, pb3); \
        asm volatile("s_waitcnt vmcnt(0)" ::: "memory"); __syncthreads(); } while (0)
    for (int j = 0; j < ns; j += 2) {
        AW_STEP(j, 0);
        if (j + 1 < ns) AW_STEP(j + 1, 1);
    }
#undef ka
#undef va
#undef AW_TROW
#undef AW_DMA1
#undef AW_DMA
#undef AW_KREAD
#undef AW_QKM0
#undef AW_QKM1
#undef AW_VREAD
#undef AW_PVM
#undef AW_PK
#undef AW_STEP
    l += __shfl_xor(l, 32);
    l_out = l;
}
typedef int v8i_a __attribute__((ext_vector_type(8)));
DI unsigned f8x4_nc(float a, float b, float c, float d) { int w = __builtin_amdgcn_cvt_pk_fp8_f32(a, b, 0, false); w = __builtin_amdgcn_cvt_pk_fp8_f32(c, d, w, true); return (unsigned)w; }
DI void p_tile_f8(const f32x16& c, unsigned (&o)[4]) {
    unsigned d0 = f8x4_nc(c[0], c[1], c[2], c[3]), d1 = f8x4_nc(c[4], c[5], c[6], c[7]), d2 = f8x4_nc(c[8], c[9], c[10], c[11]), d3 = f8x4_nc(c[12], c[13], c[14], c[15]);
    const auto s02 = __builtin_amdgcn_permlane32_swap(d0, d2, false, false);
    const auto s13 = __builtin_amdgcn_permlane32_swap(d1, d3, false, false);
    o[0] = s02[0]; o[1] = s02[1]; o[2] = s13[0]; o[3] = s13[1];
}
DI void attn_b_run_w8(LAS unsigned char* lds, const bf16* P, const unsigned char* VT, int vrow0, const AttnJob& J, f32x16 (&O)[4], float& l_out) {
    const int tid = tid_opaque(), lane = tid & 63, r32 = lane & 31, hi = lane >> 5, wave = __builtin_amdgcn_readfirstlane(tid >> 6);
    bf16x8 qf[4];
#pragma unroll
    for (int d0 = 0; d0 < 4; ++d0) qf[d0] = *(const GAS bf16x8*)(P + (size_t)(J.qrow + r32) * INW + J.qcol + d0 * 16 + hi * 8);
#pragma unroll
    for (int d = 0; d < 4; ++d) O[d] = SPLAT16(0.f);
    const int ns = (J.n0 + J.n1) >> 1;
    const unsigned lds0 = (unsigned)(uintptr_t)lds;
    const unsigned ka0 = lds0 + r32 * 256 + (((J.kc8 + hi) ^ (r32 & 15)) << 4);
    const unsigned va0 = lds0 + 65536 + r32 * 128 + ((hi ^ ((r32 >> 1) & 7)) << 4);
#define ka(i) (ka0 ^ ((i) << 5))
#define va(q) (va0 ^ ((q) << 5))
#define AW_TROW(t) ((t) < J.n0 ? J.seg0_row + 64 * (t) : J.seg1_row + 64 * ((t) - J.n0))
    unsigned dko[2], dvo[2];
#pragma unroll
    for (int i = 0; i < 2; ++i) { const int row_ = 4 * (2 * wave + i) + (lane >> 4), cp_ = lane & 15;
        dko[i] = (unsigned)(row_ * INW + J.kcolT + ((cp_ ^ (row_ & 15)) << 3)) * 2u;
        const int m_ = i * 64 + (tid >> 3), pp_ = (tid & 7) ^ ((m_ >> 1) & 7);
        dvo[i] = (unsigned)((vrow0 + m_) * NTOK + 16 * pp_); }
#define AW_DMAK(t, off) do { const char* src_ = (const char*)(P + (size_t)AW_TROW(t) * INW); \
        _Pragma("unroll") for (int i = 0; i < 2; ++i) __builtin_amdgcn_global_load_lds((const unsigned*)(src_ + dko[i]), (LAS unsigned*)(lds + (off) + (2 * wave + i) * 1024), 16, 0, 0); } while (0)
#define AW_DMA(j, st) do { AW_DMAK(2 * (j), (st) * 32768); AW_DMAK(2 * (j) + 1, (st) * 32768 + 16384); \
        { const char* vs_ = (const char*)VT + AW_TROW(2 * (j)); \
          _Pragma("unroll") for (int i = 0; i < 2; ++i) __builtin_amdgcn_global_load_lds((const unsigned*)(vs_ + dvo[i]), (LAS unsigned*)(lds + 65536 + (st) * 16384 + (i * 512 + wave * 64) * 16), 16, 0, 0); } } while (0)
#define AW_KREAD(OFF, H) do { \
        LDSRD128(kf[0], ka(2 * (H)), (OFF)); LDSRD128(kf[1], ka(2 * (H)), (OFF) + 8192); LDSRD128(kf[2], ka(2 * (H) + 1), (OFF)); LDSRD128(kf[3], ka(2 * (H) + 1), (OFF) + 8192); } while (0)
#define AW_QKM0(S0, S1) do { S0 = MFMA32(kf[0], qf[0], negm); S1 = MFMA32(kf[1], qf[0], negm); S0 = MFMA32(kf[2], qf[1], S0); S1 = MFMA32(kf[3], qf[1], S1); } while (0)
#define AW_QKM1(S0, S1) do { S0 = MFMA32(kf[0], qf[2], S0); S1 = MFMA32(kf[1], qf[2], S1); S0 = MFMA32(kf[2], qf[3], S0); S1 = MFMA32(kf[3], qf[3], S1); } while (0)
#define AW_VREAD(VB, D, F, OFF) do { LDSRD128(VB[0], va(2 * (F)), (OFF) + (D) * 4096); LDSRD128(VB[1], va(2 * (F) + 1), (OFF) + (D) * 4096); } while (0)
#define AW_CAT(x0, x1) __builtin_bit_cast(v8i_a, __builtin_shufflevector((x0), (x1), 0, 1, 2, 3, 4, 5, 6, 7))
#define AW_PVM(VB, D, PB) O[D] = __builtin_amdgcn_mfma_scale_f32_32x32x64_f8f6f4(AW_CAT(VB[0], VB[1]), PB, O[D], 0, 0, 0, 0x7f7f7f7f, 0, 0x7f7f7f7f)
    float m = 0.f;
    f32x16 OL = SPLAT16(0.f);
    const v8i_a ones8 = (v8i_a){0x38383838, 0x38383838, 0x38383838, 0x38383838, 0x38383838, 0x38383838, 0x38383838, 0x38383838};
    f32x16 c00, c01, c10, c11;
    bf16x8 kf[4]; v4u vA[2], vB[2];
    AW_DMA(0, 0);
    asm volatile("s_waitcnt vmcnt(0)" ::: "memory"); __syncthreads();
#define AW_STEP(j, ST) do { \
        if ((j) + 1 < ns) AW_DMA((j) + 1, 1 - (ST)); \
        const f32x16 negm = SPLAT16(-m); \
        AW_KREAD((ST) * 32768, 0); LGKM_WAIT(0); AW_QKM0(c00, c01); AW_KREAD((ST) * 32768, 1); LGKM_WAIT(0); AW_QKM1(c00, c01); \
        AW_KREAD((ST) * 32768 + 16384, 0); LGKM_WAIT(0); AW_QKM0(c10, c11); AW_KREAD((ST) * 32768 + 16384, 1); LGKM_WAIT(0); AW_QKM1(c10, c11); \
        AW_VREAD(vA, 0, 0, (ST) * 16384); \
        asm volatile("s_nop 15\n\ts_nop 7" : "+v"(c00), "+v"(c01), "+v"(c10), "+v"(c11)); \
        { const float tm_ = fmaxf(rowmax32(c00, c01), rowmax32(c10, c11)); const float sh_ = ((j) == 0) ? tm_ : (tm_ > 8.f ? tm_ : 0.f); \
          if (__any(sh_ != 0.f)) { _Pragma("unroll") for (int r = 0; r < 16; ++r) { c00[r] -= sh_; c01[r] -= sh_; c10[r] -= sh_; c11[r] -= sh_; } m += sh_; \
              if ((j) > 0) { const float al_ = __builtin_amdgcn_exp2f(-sh_); OL = OL * al_; _Pragma("unroll") for (int d = 0; d < 4; ++d) O[d] = O[d] * al_; } } } \
        _Pragma("unroll") for (int r = 0; r < 16; ++r) { c00[r] = __builtin_amdgcn_exp2f(c00[r]); c01[r] = __builtin_amdgcn_exp2f(c01[r]); c10[r] = __builtin_amdgcn_exp2f(c10[r]); c11[r] = __builtin_amdgcn_exp2f(c11[r]); } \
        unsigned pq0_[4], pq1_[4], pq2_[4], pq3_[4]; \
        p_tile_f8(c00, pq0_); p_tile_f8(c01, pq1_); \
        const v8i_a pb0_ = (v8i_a){(int)pq0_[0], (int)pq0_[1], (int)pq0_[2], (int)pq0_[3], (int)pq1_[0], (int)pq1_[1], (int)pq1_[2], (int)pq1_[3]}; \
        OL = __builtin_amdgcn_mfma_scale_f32_32x32x64_f8f6f4(ones8, pb0_, OL, 0, 0, 0, 0x7f7f7f7f, 0, 0x7f7f7f7f);     \
        AW_VREAD(vB, 1, 0, (ST) * 16384); LGKM_WAIT(2); AW_PVM(vA, 0, pb0_); \
        AW_VREAD(vA, 2, 0, (ST) * 16384); LGKM_WAIT(2); AW_PVM(vB, 1, pb0_); \
        p_tile_f8(c10, pq2_); p_tile_f8(c11, pq3_); \
        const v8i_a pb1_ = (v8i_a){(int)pq2_[0], (int)pq2_[1], (int)pq2_[2], (int)pq2_[3], (int)pq3_[0], (int)pq3_[1], (int)pq3_[2], (int)pq3_[3]}; \
        AW_VREAD(vB, 3, 0, (ST) * 16384); LGKM_WAIT(2); AW_PVM(vA, 2, pb0_); \
        AW_VREAD(vA, 0, 1, (ST) * 16384); LGKM_WAIT(2); AW_PVM(vB, 3, pb0_); \
        OL = __builtin_amdgcn_mfma_scale_f32_32x32x64_f8f6f4(ones8, pb1_, OL, 0, 0, 0, 0x7f7f7f7f, 0, 0x7f7f7f7f); \
        AW_VREAD(vB, 1, 1, (ST) * 16384); LGKM_WAIT(2); AW_PVM(vA, 0, pb1_); \
        AW_VREAD(vA, 2, 1, (ST) * 16384); LGKM_WAIT(2); AW_PVM(vB, 1, pb1_); \
        AW_VREAD(vB, 3, 1, (ST) * 16384); LGKM_WAIT(2); AW_PVM(vA, 2, pb1_); \
        LGKM_WAIT(0); AW_PVM(vB, 3, pb1_); \
        asm volatile("s_waitcnt vmcnt(0)" ::: "memory"); __syncthreads(); } while (0)
    for (int j = 0; j < ns; j += 2) {
        AW_STEP(j, 0);
        if (j + 1 < ns) AW_STEP(j + 1, 1);
    }
#undef ka
#undef va
#undef AW_TROW
#undef AW_DMAK
#undef AW_DMA
#undef AW_KREAD
#undef AW_QKM0
#undef AW_QKM1
#undef AW_VREAD
#undef AW_CAT
#undef AW_PVM
#undef AW_STEP
    l_out = OL[0];
}
#define TXK_() ({ const __attribute__((address_space(4))) char* kp_ = (const __attribute__((address_space(4))) char*)__builtin_amdgcn_kernarg_segment_ptr(); asm volatile("" : "+s"(kp_)); kp_; })
#define TX_IN(i) (*(const float* const __attribute__((address_space(4)))*)(TXK_() + 8 * (i)))
#define TX_WS() (*(unsigned char* const __attribute__((address_space(4)))*)(TXK_() + 176))
constexpr int TX_TOTAL = 64 * 32 * 64 + 64 * 32 * 32 + 6 * 16 * 32 + 2 * 32 * 32;
struct TxCtx { int it, stride, have, seg, lay, gw, fresh; TItem t; float wv[16]; };
constexpr int TX_NSEG = 5;
DI int tx_seg_start(int s, int lay) { return s == 0 ? lay * 65536 : s == 1 ? 131072 + lay * 32768 : s == 2 ? 196608 + lay * 1536 : s == 3 ? 199680 + lay * 1024 : 201728; }
DI int tx_seg_len(int s, int lay) { return s == 0 ? 65536 : s == 1 ? 32768 : s == 2 ? 1536 : s == 3 ? 1024 : (lay == 0 ? 32 * 248 : 0); }
DI bool p0_decode32(const TGroup& g, int& r, TItem& t) {
    const int per = (g.K / 32) * (g.N / 32), cnt = per * g.nmat;
    if (r >= cnt) { r -= cnt; return false; }
    const int m = r / per, it = r % per, nblk = g.N / 32, k0 = 32 * (it / nblk), n0 = 32 * (it % nblk);
    const int r0 = g.gu ? (256 * ((n0 & 1023) >> 7) + 128 * (n0 >> 10) + (n0 & 127)) : n0;
    t.spitch = g.N; t.dpitch = g.sub * g.K; t.f8 = g.f8;
    t.sp = g.src + (size_t)m * g.K * g.N + (size_t)k0 * t.spitch + n0;
    t.dp = g.f8 ? (unsigned char*)g.dst + (size_t)m * g.K * g.N + (size_t)r0 * t.dpitch + k0
                : (unsigned char*)(g.dst + (size_t)(m / g.sub) * g.sub * g.K * g.N + (size_t)(m % g.sub) * g.K + (size_t)r0 * t.dpitch + k0);
    return true;
}
DI void tx_decode(int it, TItem& t) {
    const TGroup g3{TX_IN(17), (bf16*)(TX_WS() + WS_WGU), 1024, 2048, 64, 1, 1, 1, 0}, g4{TX_IN(19), (bf16*)(TX_WS() + WS_WDN), 1024, 1024, 64, 0, 1, 1, 0},
                 g1{TX_IN(13), (bf16*)(TX_WS() + WS_WBR), 512, 1024, 6, 0, 3, 0, 0}, g2{TX_IN(14), (bf16*)(TX_WS() + WS_WO), 1024, 1024, 2, 0, 1, 0, 0};
    const TGroup g5{TX_IN(7) + (size_t)1024 * INW, (bf16*)(TX_WS() + WS_WIN8L + (size_t)INW * 1024), 1024, INW, 1, 0, 1, 1, 0};
    int r = it; if (!p0_decode32(g3, r, t)) if (!p0_decode32(g4, r, t)) if (!p0_decode32(g1, r, t)) if (!p0_decode32(g2, r, t)) p0_decode32(g5, r, t);
}
typedef short v2s_t __attribute__((ext_vector_type(2)));
#ifndef TX_CVT_SCALE
#define TX_CVT_SCALE 0.00390625f
#endif
DI unsigned f8x4s(float a, float b, float c, float d) { v2s_t r = {0, 0}; r = __builtin_amdgcn_cvt_scalef32_pk_fp8_f32(r, a, b, TX_CVT_SCALE, false); r = __builtin_amdgcn_cvt_scalef32_pk_fp8_f32(r, c, d, TX_CVT_SCALE, true); return __builtin_bit_cast(unsigned, r); }
DI void tx_begin_a(TxCtx& tx, int lane) {
    if (tx.have) { tx.have = 0;
        const int n = lane & 31, half = lane >> 5; const float* v = tx.wv;
        if (tx.t.f8) { v4u o;
            o.x = f8x4s(v[0], v[1], v[2], v[3]); o.y = f8x4s(v[4], v[5], v[6], v[7]); o.z = f8x4s(v[8], v[9], v[10], v[11]); o.w = f8x4s(v[12], v[13], v[14], v[15]);
            *(GAS v4u*)(tx.t.dp + (size_t)n * tx.t.dpitch + 16 * half) = o; }
        else { v4u o0, o1;
            o0.x = pk2(v[0], v[1]); o0.y = pk2(v[2], v[3]); o0.z = pk2(v[4], v[5]); o0.w = pk2(v[6], v[7]); o1.x = pk2(v[8], v[9]); o1.y = pk2(v[10], v[11]); o1.z = pk2(v[12], v[13]); o1.w = pk2(v[14], v[15]);
            unsigned char* q = tx.t.dp + ((size_t)n * tx.t.dpitch + 16 * half) * 2; *(GAS v4u*)q = o0; *(GAS v4u*)(q + 16) = o1; }
    }
}
DI void tx_begin_b(TxCtx& tx, int lane) {
    while (tx.seg < TX_NSEG && tx.it >= tx_seg_start(tx.seg, tx.lay) + tx_seg_len(tx.seg, tx.lay)) { ++tx.seg; if (tx.seg < TX_NSEG) tx.it = tx_seg_start(tx.seg, tx.lay) + tx.gw; tx.fresh = 1; }
    if (tx.seg < TX_NSEG) { const int it = tx.it;
        if (tx.stride == 2048 && !tx.fresh && tx.seg == 0) { tx.t.sp += (size_t)1024 * 2048; tx.t.dp += (size_t)1024 * 2048; }
        else if (tx.stride == 2048 && !tx.fresh && tx.seg == 1) { tx.t.sp += (size_t)2 * 1024 * 1024; tx.t.dp += (size_t)2 * 1024 * 1024; }
        else tx_decode(it, tx.t);
        tx.fresh = 0;
        const float* lp = tx.t.sp + (size_t)(16 * (lane >> 5)) * tx.t.spitch + (lane & 31);
#pragma unroll
        for (int e = 0; e < 16; ++e) tx.wv[e] = *(const GAS float*)(lp + (size_t)e * tx.t.spitch);
        tx.have = 1; tx.it += tx.stride; }
    LDS_WAIT();
}
DI void attn_b_run_w88(LAS unsigned char* lds, const unsigned char* QK8, const unsigned char* VT, int h, int comp, const AttnJob& J, f32x16 (&O)[4], float& l_out, TxCtx& tx, bool tx_on) {
    const int tid = tid_opaque(), lane = tid & 63, r32 = lane & 31, hi = lane >> 5, wave = __builtin_amdgcn_readfirstlane(tid >> 6);
    v8i_a qf;
    { const unsigned char* qp = QK8 + (size_t)(J.qrow + r32) * 1024 + h * 128 + comp * 64 + 32 * hi;
      const v4u q0 = *(const GAS v4u*)qp, q1 = *(const GAS v4u*)(qp + 16); qf = __builtin_bit_cast(v8i_a, __builtin_shufflevector(q0, q1, 0, 1, 2, 3, 4, 5, 6, 7)); }
#pragma unroll
    for (int d = 0; d < 4; ++d) O[d] = SPLAT16(0.f);
    const int ns = (J.n0 + J.n1) >> 1;
    const unsigned lds0 = (unsigned)(uintptr_t)lds;
    const unsigned ka0 = lds0 + r32 * 128 + (((comp * 4 + 2 * hi) ^ ((r32 >> 1) & 7)) << 4);
    const unsigned va0 = lds0 + 65536 + r32 * 128 + ((hi ^ ((r32 >> 1) & 7)) << 4);
#define ka(e) (ka0 ^ ((e) << 4))
#define va(q) (va0 ^ ((q) << 5))
#define AW_TROW(t) ((t) < J.n0 ? J.seg0_row + 64 * (t) : J.seg1_row + 64 * ((t) - J.n0))
    unsigned dko, dvo[2];
    { const int row_ = tid >> 3, pp_ = (tid & 7) ^ ((row_ >> 1) & 7); dko = (unsigned)(row_ * 1024 + 512 + h * 128 + 16 * pp_); }
#pragma unroll
    for (int i = 0; i < 2; ++i) { const int m_ = i * 64 + (tid >> 3), pp_ = (tid & 7) ^ ((m_ >> 1) & 7); dvo[i] = (unsigned)((h * 128 + m_) * NTOK + 16 * pp_); }
#define AW_DMAK(t, off) __builtin_amdgcn_global_load_lds((const unsigned*)((const char*)QK8 + (size_t)AW_TROW(t) * 1024 + dko), (LAS unsigned*)(lds + (off) + wave * 1024), 16, 0, 0)
#define AW_DMA(j, st) do { AW_DMAK(2 * (j), (st) * 16384); AW_DMAK(2 * (j) + 1, (st) * 16384 + 8192); \
        { const char* vs_ = (const char*)VT + AW_TROW(2 * (j)); \
          _Pragma("unroll") for (int i = 0; i < 2; ++i) __builtin_amdgcn_global_load_lds((const unsigned*)(vs_ + dvo[i]), (LAS unsigned*)(lds + 65536 + (st) * 16384 + (i * 512 + wave * 64) * 16), 16, 0, 0); } } while (0)
#define AW_KREAD(KF, T, OFF) do { LDSRD128(KF[0], ka(0), (OFF) + ((T) >> 1) * 8192 + ((T) & 1) * 4096); LDSRD128(KF[1], ka(1), (OFF) + ((T) >> 1) * 8192 + ((T) & 1) * 4096); } while (0)
#define AW_CAT(x0, x1) __builtin_bit_cast(v8i_a, __builtin_shufflevector((x0), (x1), 0, 1, 2, 3, 4, 5, 6, 7))
#define AW_QKM(KF) __builtin_amdgcn_mfma_scale_f32_32x32x64_f8f6f4(AW_CAT(KF[0], KF[1]), qf, negm, 0, 0, 0, 0x7d7d7d7d, 0, 0x7b7b7b7b)
#define AW_VREAD(VB, D, F, OFF) do { LDSRD128(VB[0], va(2 * (F)), (OFF) + (D) * 4096); LDSRD128(VB[1], va(2 * (F) + 1), (OFF) + (D) * 4096); } while (0)
#define AW_PVM(VB, D, PB) O[D] = __builtin_amdgcn_mfma_scale_f32_32x32x64_f8f6f4(AW_CAT(VB[0], VB[1]), PB, O[D], 0, 0, 0, 0x7f7f7f7f, 0, 0x7f7f7f7f)
    float m = 0.f;
    f32x16 OL = SPLAT16(0.f);
    const v8i_a ones8 = (v8i_a){0x38383838, 0x38383838, 0x38383838, 0x38383838, 0x38383838, 0x38383838, 0x38383838, 0x38383838};
    f32x16 c00, c01, c10, c11;
    v4u kA[2], kB[2], vA[2], vB[2];
    AW_DMA(0, 0);
    asm volatile("s_waitcnt vmcnt(0)" ::: "memory"); __syncthreads();
#define AW_STEP(j, ST) do { \
        if (tx_on && (ST) == 0) tx_begin_a(tx, lane);     \
        if ((j) + 1 < ns) AW_DMA((j) + 1, 1 - (ST)); \
        if (tx_on && (ST) == 0) tx_begin_b(tx, lane); \
        const f32x16 negm = SPLAT16(-m);        \
        AW_KREAD(kA, 0, (ST) * 16384); AW_KREAD(kB, 1, (ST) * 16384); LGKM_WAIT(2); c00 = AW_QKM(kA); \
        AW_KREAD(kA, 2, (ST) * 16384); LGKM_WAIT(2); c01 = AW_QKM(kB); \
        AW_KREAD(kB, 3, (ST) * 16384); LGKM_WAIT(2); c10 = AW_QKM(kA); \
        AW_VREAD(vA, 0, 0, (ST) * 16384); LGKM_WAIT(2); c11 = AW_QKM(kB); \
        asm volatile("s_nop 15\n\ts_nop 7" : "+v"(c00), "+v"(c01), "+v"(c10), "+v"(c11));     \
        { const float tm_ = fmaxf(rowmax32(c00, c01), rowmax32(c10, c11)); const float sh_ = ((j) == 0) ? tm_ : (tm_ > 8.f ? tm_ : 0.f); \
          if (__any(sh_ != 0.f)) { _Pragma("unroll") for (int r = 0; r < 16; ++r) { c00[r] -= sh_; c01[r] -= sh_; c10[r] -= sh_; c11[r] -= sh_; } m += sh_; \
              if ((j) > 0) { const float al_ = __builtin_amdgcn_exp2f(-sh_); OL = OL * al_; _Pragma("unroll") for (int d = 0; d < 4; ++d) O[d] = O[d] * al_; } } } \
        _Pragma("unroll") for (int r = 0; r < 16; ++r) { c00[r] = __builtin_amdgcn_exp2f(c00[r]); c01[r] = __builtin_amdgcn_exp2f(c01[r]); c10[r] = __builtin_amdgcn_exp2f(c10[r]); c11[r] = __builtin_amdgcn_exp2f(c11[r]); } \
        unsigned pq0_[4], pq1_[4], pq2_[4], pq3_[4]; \
        p_tile_f8(c00, pq0_); p_tile_f8(c01, pq1_); \
        const v8i_a pb0_ = (v8i_a){(int)pq0_[0], (int)pq0_[1], (int)pq0_[2], (int)pq0_[3], (int)pq1_[0], (int)pq1_[1], (int)pq1_[2], (int)pq1_[3]}; \
        OL = __builtin_amdgcn_mfma_scale_f32_32x32x64_f8f6f4(ones8, pb0_, OL, 0, 0, 0, 0x7f7f7f7f, 0, 0x7f7f7f7f); \
        AW_VREAD(vB, 1, 0, (ST) * 16384); LGKM_WAIT(2); AW_PVM(vA, 0, pb0_); \
        AW_VREAD(vA, 2, 0, (ST) * 16384); LGKM_WAIT(2); AW_PVM(vB, 1, pb0_); \
        p_tile_f8(c10, pq2_); p_tile_f8(c11, pq3_); \
        const v8i_a pb1_ = (v8i_a){(int)pq2_[0], (int)pq2_[1], (int)pq2_[2], (int)pq2_[3], (int)pq3_[0], (int)pq3_[1], (int)pq3_[2], (int)pq3_[3]}; \
        AW_VREAD(vB, 3, 0, (ST) * 16384); LGKM_WAIT(2); AW_PVM(vA, 2, pb0_); \
        AW_VREAD(vA, 0, 1, (ST) * 16384); LGKM_WAIT(2); AW_PVM(vB, 3, pb0_); \
        OL = __builtin_amdgcn_mfma_scale_f32_32x32x64_f8f6f4(ones8, pb1_, OL, 0, 0, 0, 0x7f7f7f7f, 0, 0x7f7f7f7f); \
        AW_VREAD(vB, 1, 1, (ST) * 16384); LGKM_WAIT(2); AW_PVM(vA, 0, pb1_); \
        AW_VREAD(vA, 2, 1, (ST) * 16384); LGKM_WAIT(2); AW_PVM(vB, 1, pb1_); \
        AW_VREAD(vB, 3, 1, (ST) * 16384); LGKM_WAIT(2); AW_PVM(vA, 2, pb1_); \
        LGKM_WAIT(0); AW_PVM(vB, 3, pb1_); \
        if (tx_on && (ST) == 0 && tx.have) asm volatile("s_waitcnt vmcnt(16)" ::: "memory");     \
        else asm volatile("s_waitcnt vmcnt(0)" ::: "memory"); \
        LDS_WAIT(); __builtin_amdgcn_s_barrier(); asm volatile("" ::: "memory"); } while (0)
    for (int j = 0; j < ns; j += 2) {
        AW_STEP(j, 0);
        if (j + 1 < ns) AW_STEP(j + 1, 1);
    }
#undef ka
#undef va
#undef AW_TROW
#undef AW_DMAK
#undef AW_DMA
#undef AW_KREAD
#undef AW_CAT
#undef AW_QKM
#undef AW_VREAD
#undef AW_PVM
#undef AW_STEP
    l_out = OL[0];
}
template <int VAR> DI void ph_attn_b(LAS unsigned char* lds, const bf16* P, const unsigned char* VT, const unsigned char* QK8, bf16* OB, const float* dnw, float lam, float lam_init, bool with_ctx, int vcu, int G, bool tx_on = false, int tx_lay = 0) {
    const int lane = tid_opaque() & 63, wave = __builtin_amdgcn_readfirstlane(tid_opaque() >> 6), r32 = lane & 31, hi = lane >> 5;
    TxCtx tx; tx.gw = vcu * NWAVES + wave; tx.lay = tx_lay; tx.seg = 0; tx.fresh = 1; tx.it = tx_seg_start(0, tx_lay) + tx.gw; tx.stride = G * NWAVES; tx.have = 0;
    const int nun = 512 + (with_ctx ? 16 : 0);
    LAS float* XB = (LAS float*)lds;
    for (int u = vcu; u < nun; u += G) {
        AttnJob J; int b, h, q0; const bool cq = u >= 512; const int qs = wave & 3, comp = wave >> 2;
        if (!cq) { b = u >> 8; h = (u >> 6) & 3; q0 = (u & 63) * 128; J.seg0_row = b * SEQ; J.n0 = 128; J.qrow = b * SEQ + q0 + 32 * qs; }
        else { const int v = u - 512; b = v >> 3; h = (v >> 1) & 3; q0 = (v & 1) * 128; J.seg0_row = 0; J.n0 = 0; J.qrow = NLAT + b * CTXL + q0 + 32 * qs; }
        J.seg0_kpos0 = 0; J.qpos0 = 0;
        J.qcol = C_BQ + h * 128 + comp * 64; J.kcolT = C_BK + h * 128; J.vcolT = C_BV + h * 128; J.kc8 = comp * 8; J.seg1_row = NLAT + b * CTXL; J.n1 = 4;
        f32x16 O[4]; float l;
        if (AB_F8PV && AB_F8QK) attn_b_run_w88(lds, QK8, VT, h, comp, J, O, l, tx, tx_on); else if (AB_F8PV) attn_b_run_w8(lds, P, VT, h * 128, J, O, l); else if (VAR == 64 || AB_WIDE) attn_b_run_w(lds, P, J, O, l); else attn_b_run<VAR>(lds, P, J, O, l);
        const float inv = (AB_F8PV ? 1.f / F8_V : 1.f) / l;
        if (comp == 1) {
#pragma unroll
            for (int d = 0; d < 4; ++d)
#pragma unroll
                for (int r = 0; r < 16; ++r) XB[(qs * 128 + 32 * d + crow(r, hi)) * 32 + r32] = O[d][r] * inv;
        }
        __syncthreads();
        if (comp == 0) {
            float ss = 0.f;
#pragma unroll
            for (int d = 0; d < 4; ++d)
#pragma unroll
                for (int r = 0; r < 16; ++r) { const float o = O[d][r] * inv - lam * XB[(qs * 128 + 32 * d + crow(r, hi)) * 32 + r32]; O[d][r] = o; ss += o * o; }
            ss += __shfl_xor(ss, 32);
            const float rs = rsqrtf(ss * (1.f / 128.f) + RMS_EPS) * (1.f - lam_init);
            bf16* op = OB + (size_t)(J.qrow + r32) * 1536 + h * 128;
            f32x4 wvs[4][4];
#pragma unroll
            for (int d = 0; d < 4; ++d)
#pragma unroll
                for (int rg = 0; rg < 4; ++rg) wvs[d][rg] = *(const GAS f32x4*)(dnw + 32 * d + 8 * rg + 4 * hi);
#pragma unroll
            for (int d = 0; d < 4; ++d)
#pragma unroll
                for (int rg = 0; rg < 4; ++rg) { const int e0 = 32 * d + 8 * rg + 4 * hi; const f32x4 wv = wvs[d][rg];
                    u32x2 w; w.x = cvtpk(O[d][4 * rg] * rs * wv[0], O[d][4 * rg + 1] * rs * wv[1]); w.y = cvtpk(O[d][4 * rg + 2] * rs * wv[2], O[d][4 * rg + 3] * rs * wv[3]);
                    *(GAS u32x2*)(op + e0) = w; }
        }
        __syncthreads();
    }
    if (tx_on) { while (tx.have || tx.seg < TX_NSEG) { tx_begin_a(tx, lane); tx_begin_b(tx, lane); } }
}

DI int hg_row0(int b, int dir, int c) {
    if (dir == 0) return c < 4 ? NLAT + b * CTXL + 64 * c : b * SEQ + 64 * (c - 4);
    return c < 4 ? NLAT + b * CTXL + 64 * (3 - c) : b * SEQ + 64 * (131 - c);
}
DI void glds16(const void* src, LAS unsigned char* dst) { __builtin_amdgcn_global_load_lds((const unsigned*)src, (LAS unsigned*)dst, 16, 0, 0); }
DI void ph_hg1(LAS unsigned char* lds, const bf16* P, const float* LF, bf16* HU, float* HD, int vcu, int G) {
    const int tid = tid_opaque(), lane = tid & 63, wave = __builtin_amdgcn_readfirstlane(tid >> 6), r32 = lane & 31, hi = lane >> 5;
    LAS unsigned char* KH = lds + 98304; LAS float* TOT = (LAS float*)(lds + 114688);
#define HG1_DMA(u_, buf_) do { const int h_ = (u_) & 3, c_ = ((u_) >> 2) % NCH, dir_ = (((u_) >> 2) / NCH) & 1, b_ = ((u_) >> 2) / (2 * NCH), row0_ = hg_row0(b_, dir_, c_); \
        _Pragma("unroll") for (int i = 0; i < 4; ++i) { const int slot = 4 * wave + i, row = 2 * slot + (lane >> 5), ch = lane & 31; \
            glds16(LF + (size_t)(row0_ + row) * 1024 + dir_ * 512 + h_ * 128 + ch * 4, lds + (buf_) * 32768 + slot * 1024); } \
        _Pragma("unroll") for (int i = 0; i < 2; ++i) { const int slot = 2 * wave + i, row = 4 * slot + (lane >> 4), cp = lane & 15, sc = ((((cp >> 2) ^ (row & 3)) << 2) | (cp & 3)); \
            glds16(P + (size_t)(row0_ + row) * INW + C_CI + h_ * 128 + sc * 8, lds + 65536 + (buf_) * 16384 + slot * 1024); } } while (0)
    int cur = 0;
    if (vcu < NB * 2 * NCH * 4) HG1_DMA(vcu, 0);
    for (int u = vcu; u < NB * 2 * NCH * 4; u += G) {
        const int h = u & 3, c = (u >> 2) % NCH, dir = ((u >> 2) / NCH) & 1, b = (u >> 2) / (2 * NCH);
        const int uidx = ((b * 2 + dir) * 4 + h) * NCH + c;
        LAS float* LFs = (LAS float*)(lds + cur * 32768); LAS unsigned char* Vs = lds + 65536 + cur * 16384;
        asm volatile("s_waitcnt vmcnt(0)" ::: "memory"); __syncthreads();
        if (u + G < NB * 2 * NCH * 4) HG1_DMA(u + G, cur ^ 1);
        const int d = tid & 127, q = tid >> 7;
        float lf[16]; float sum = 0.f;
#pragma unroll
        for (int j = 0; j < 16; ++j) { lf[j] = LFs[(16 * q + j) * 128 + d]; sum += lf[j]; }
        TOT[q * 128 + d] = sum;
        __syncthreads();
        const float t0 = TOT[d], t1 = TOT[128 + d], t2 = TOT[256 + d], t3 = TOT[384 + d], total = (t0 + t1) + (t2 + t3);
        float pre = (q > 0 ? t0 : 0.f) + (q > 1 ? t1 : 0.f) + (q > 2 ? t2 : 0.f);
        float kv[16];
#pragma unroll
        for (int j = 0; j < 16; ++j) { const float arg = dir == 0 ? (total - pre - lf[j]) : pre; pre += lf[j]; kv[j] = (1.f - __expf(lf[j])) * __expf(arg); }
        *(LAS bf16x8*)(KH + d * 128 + (((2 * q) ^ ((d >> 1) & 7)) << 4)) = pack8(kv[0], kv[1], kv[2], kv[3], kv[4], kv[5], kv[6], kv[7]);
        *(LAS bf16x8*)(KH + d * 128 + (((2 * q + 1) ^ ((d >> 1) & 7)) << 4)) = pack8(kv[8], kv[9], kv[10], kv[11], kv[12], kv[13], kv[14], kv[15]);
        if (q == 0) HD[(size_t)uidx * 128 + d] = __expf(total);
        __syncthreads();
        const int eb = wave & 3, dkb0 = 2 * (wave >> 2), q4 = (lane & 15) >> 2, p4 = lane & 3, blk = (lane >> 4) & 1;
        f32x16 acc[2]; acc[0] = SPLAT16(0.f); acc[1] = SPLAT16(0.f);
#pragma unroll
        for (int ks = 0; ks < 4; ++ks) {
            const int r0 = 16 * ks + 8 * hi + q4, r1 = r0 + 4;
            const s16x4 lo = tr_read((LAS const char*)(Vs + r0 * 256 + (((eb ^ (r0 & 3)) << 6) | (blk << 5) | (p4 << 3))));
            const s16x4 hh = tr_read((LAS const char*)(Vs + r1 * 256 + (((eb ^ (r1 & 3)) << 6) | (blk << 5) | (p4 << 3))));
            const bf16x8 vf = cat8(lo, hh);
#pragma unroll
            for (int j = 0; j < 2; ++j) { const int R = 32 * (dkb0 + j) + r32, ch = 2 * ks + hi;
                const bf16x8 kf = *(const LAS bf16x8*)(KH + R * 128 + ((ch ^ ((R >> 1) & 7)) << 4));
                acc[j] = MFMA32(kf, vf, acc[j]); }
        }
        bf16* hu = HU + (size_t)uidx * 16384 + (32 * eb + r32) * 128 + 32 * dkb0 + 4 * hi;
#pragma unroll
        for (int j = 0; j < 2; ++j)
#pragma unroll
            for (int rg = 0; rg < 4; ++rg) { u32x2 w; w.x = cvtpk(acc[j][4 * rg], acc[j][4 * rg + 1]); w.y = cvtpk(acc[j][4 * rg + 2], acc[j][4 * rg + 3]); *(GAS u32x2*)(hu + 32 * j + 8 * rg) = w; }
        __syncthreads();
        cur ^= 1;
    }
#undef HG1_DMA
}
DI void ph_hg2(const bf16* HU, const float* HD, bf16* HS, int vcu, int G) {
    const int gt = vcu * NTHR + tid_opaque(), NT = G * NTHR;
    for (int idx = gt; idx < 16 * 8192; idx += NT) {
        const int chain = idx >> 13, pr = idx & 8191, e = pr >> 6, dk = (pr & 63) * 2;
        const bf16* up = HU + (size_t)chain * NCH * 16384 + e * 128 + dk; const float* dp = HD + (size_t)chain * NCH * 128 + dk; bf16* sp = HS + (size_t)chain * NCH * 16384 + e * 128 + dk;
        float s0 = 0.f, s1 = 0.f;
        unsigned uA[22], uB[22]; f32x2 dA[22], dB[22];
#define HG2_LD(U, D, C0) _Pragma("unroll") for (int j = 0; j < 22; ++j) { U[j] = *(const GAS unsigned*)(up + (size_t)((C0) + j) * 16384); D[j] = *(const GAS f32x2*)(dp + (size_t)((C0) + j) * 128); }
#define HG2_ST(U, D, C0) _Pragma("unroll") for (int j = 0; j < 22; ++j) { *(GAS unsigned*)(sp + (size_t)((C0) + j) * 16384) = cvtpk(s0, s1); s0 = D[j].x * s0 + bflo(U[j]); s1 = D[j].y * s1 + bfhi(U[j]); }
        HG2_LD(uA, dA, 0);
#pragma unroll
        for (int c0 = 0; c0 < NCH; c0 += 44) {
            HG2_LD(uB, dB, c0 + 22);
            HG2_ST(uA, dA, c0);
            if (c0 + 44 < NCH) { HG2_LD(uA, dA, c0 + 44); }
            HG2_ST(uB, dB, c0 + 22);
        }
#undef HG2_LD
#undef HG2_ST
    }
}
DI void ph_hg3(LAS unsigned char* lds, const bf16* P, const float* LF, const bf16* HS, bf16* OC, const float* hw, bool with_ctx, int vcu, int G, int probe_mode = 0) {
    const int tid = tid_opaque(), lane = tid & 63, wave = __builtin_amdgcn_readfirstlane(tid >> 6), tl = lane & 15, kg = lane >> 4;
    LAS float* BC = (LAS float*)lds; LAS unsigned char* VT = lds + 65536; LAS unsigned char* HSs = lds + 81920; LAS float* CB = (LAS float*)(lds + 81920);
    const int tc_lo = with_ctx ? 0 : 4, ntc = NCH - tc_lo, nun = NB * ntc * 4;
    for (int u = vcu; u < nun; u += G) {
        const int b = u / (ntc * 4), tc = tc_lo + (u / 4) % ntc, h = u & 3;
        const int row0 = tc < 4 ? NLAT + b * CTXL + 64 * tc : b * SEQ + 64 * (tc - 4);
        const int dir = wave >> 2, I = wave & 3, t = 16 * I + tl;
        v4u qw[4];
#pragma unroll
        for (int ks = 0; ks < 4; ++ks) qw[ks] = *(const GAS v4u*)(P + (size_t)(row0 + t) * INW + C_CQ + h * 128 + 32 * ks + 8 * kg);
        u32x2 gwv[8];
#pragma unroll
        for (int eb = 0; eb < 8; ++eb) gwv[eb] = *(const GAS u32x2*)(P + (size_t)(row0 + t) * INW + C_CG + h * 128 + 16 * eb + 4 * kg);
#pragma unroll
        for (int i = 0; i < 8; ++i) { const int slot = 8 * wave + i, dd = slot >> 5, row = 2 * (slot & 31) + (lane >> 5), ch = lane & 31;
            glds16(LF + (size_t)(row0 + row) * 1024 + dd * 512 + h * 128 + ch * 4, lds + slot * 1024); }
#pragma unroll
        for (int i = 0; i < 2; ++i) { const int slot = 2 * wave + i, row = 4 * slot + (lane >> 4), cp = lane & 15, sc = ((((cp >> 2) ^ (row & 3)) << 2) | (cp & 3));
            glds16(P + (size_t)(row0 + row) * INW + C_CI + h * 128 + sc * 8, VT + slot * 1024); }
#pragma unroll
        for (int i = 0; i < 8; ++i) { const int slot = 8 * wave + i, dd = slot >> 5, row = 4 * (slot & 31) + (lane >> 4), cp = lane & 15;
            const int cs = dd == 0 ? tc : (tc < 4 ? 3 - tc : 135 - tc);
            glds16(HS + ((size_t)(((b * 2 + dd) * 4 + h) * NCH + cs) * 128 + row) * 128 + ((cp ^ (row & 15)) << 3), HSs + slot * 1024); }
        asm volatile("s_waitcnt vmcnt(8)" ::: "memory"); __syncthreads();
        if (probe_mode == 1) { asm volatile("s_waitcnt vmcnt(0)" :: "v"(qw[0]), "v"(qw[3]) : "memory"); __syncthreads(); continue; }
        if (tid < 256) { const int dd = tid >> 7, d = tid & 127; LAS float* col = BC + dd * 8192 + d; float v[64];
#pragma unroll
            for (int j = 0; j < 64; ++j) v[j] = col[j * 128];
            float a = 0.f;
            if (dd == 0) {
#pragma unroll
                for (int j = 0; j < 64; ++j) { a += v[j]; col[j * 128] = a; }
            } else {
#pragma unroll
                for (int j = 63; j >= 0; --j) { a += v[j]; col[j * 128] = a; }
            }
        }
        asm volatile("s_waitcnt vmcnt(0)" ::: "memory");
        __syncthreads();
        if (probe_mode == 2) { asm volatile("" :: "v"(qw[0]), "v"(qw[3])); continue; }
        const LAS float* bc = BC + dir * 8192;
        const bool hasb = dir == 0 ? (I > 0) : (I < 3); const int brow = dir == 0 ? 16 * I - 1 : 16 * I + 16;
        bf16x8 qh[4], qt[4];
#pragma unroll
        for (int ks = 0; ks < 4; ++ks) { const int dk0 = 32 * ks + 8 * kg;
            const f32x4 b0 = *(const LAS f32x4*)(bc + t * 128 + dk0), b1 = *(const LAS f32x4*)(bc + t * 128 + dk0 + 4);
            f32x4 e0 = (f32x4){0.f, 0.f, 0.f, 0.f}, e1 = e0; if (hasb) { e0 = *(const LAS f32x4*)(bc + brow * 128 + dk0); e1 = *(const LAS f32x4*)(bc + brow * 128 + dk0 + 4); }
            const float q0 = bflo(qw[ks].x), q1 = bfhi(qw[ks].x), q2 = bflo(qw[ks].y), q3 = bfhi(qw[ks].y), q4 = bflo(qw[ks].z), q5 = bfhi(qw[ks].z), q6 = bflo(qw[ks].w), q7 = bfhi(qw[ks].w);
            qh[ks] = pack8(q0 * __expf(b0[0]), q1 * __expf(b0[1]), q2 * __expf(b0[2]), q3 * __expf(b0[3]), q4 * __expf(b1[0]), q5 * __expf(b1[1]), q6 * __expf(b1[2]), q7 * __expf(b1[3]));
            qt[ks] = pack8(q0 * __expf(b0[0] - e0[0]), q1 * __expf(b0[1] - e0[1]), q2 * __expf(b0[2] - e0[2]), q3 * __expf(b0[3] - e0[3]),
                           q4 * __expf(b1[0] - e1[0]), q5 * __expf(b1[1] - e1[1]), q6 * __expf(b1[2] - e1[2]), q7 * __expf(b1[3] - e1[3])); }
        f32x4 acc[8];
#pragma unroll
        for (int eb = 0; eb < 8; ++eb) acc[eb] = (f32x4){0.f, 0.f, 0.f, 0.f};
#pragma unroll
        for (int ks = 0; ks < 4; ++ks)
#pragma unroll
            for (int eb = 0; eb < 8; ++eb) { const int er = 16 * eb + tl;
                const bf16x8 sf = *(const LAS bf16x8*)(HSs + dir * 32768 + er * 256 + (((4 * ks + kg) ^ (er & 15)) << 4)); acc[eb] = MFMA16(sf, qh[ks], acc[eb]); }
        if (probe_mode == 3) { asm volatile("" :: "v"(acc[0]), "v"(acc[7]), "v"(qt[0]), "v"(qt[3])); __syncthreads(); continue; }
        f32x4 att[4];
#pragma unroll
        for (int Jb = 0; Jb < 4; ++Jb) {
            att[Jb] = (f32x4){0.f, 0.f, 0.f, 0.f};
            const bool active = dir == 0 ? (Jb <= I) : (Jb >= I);
            if (active) {
                const int s = 16 * Jb + tl; f32x4 a = (f32x4){0.f, 0.f, 0.f, 0.f};
                const int sp = dir == 0 ? s - 1 : s + 1; const bool hasp = dir == 0 ? (s > 0) : (s < 63);
#pragma unroll
                for (int ks = 0; ks < 4; ++ks) { const int dk0 = 32 * ks + 8 * kg;
                    const f32x4 b0 = *(const LAS f32x4*)(bc + s * 128 + dk0), b1 = *(const LAS f32x4*)(bc + s * 128 + dk0 + 4);
                    f32x4 p0 = (f32x4){0.f, 0.f, 0.f, 0.f}, p1 = p0; if (hasp) { p0 = *(const LAS f32x4*)(bc + sp * 128 + dk0); p1 = *(const LAS f32x4*)(bc + sp * 128 + dk0 + 4); }
                    f32x4 e0 = (f32x4){0.f, 0.f, 0.f, 0.f}, e1 = e0; if (hasb) { e0 = *(const LAS f32x4*)(bc + brow * 128 + dk0); e1 = *(const LAS f32x4*)(bc + brow * 128 + dk0 + 4); }
                    float kv[8];
#pragma unroll
                    for (int j = 0; j < 4; ++j) { kv[j] = (1.f - __expf(b0[j] - p0[j])) * __expf(fminf(e0[j] - b0[j], 80.f)); kv[4 + j] = (1.f - __expf(b1[j] - p1[j])) * __expf(fminf(e1[j] - b1[j], 80.f)); }
                    a = MFMA16(pack8(kv[0], kv[1], kv[2], kv[3], kv[4], kv[5], kv[6], kv[7]), qt[ks], a); }
                if (Jb == I) {
#pragma unroll
                    for (int r = 0; r < 4; ++r) { const int sl = 4 * kg + r; const bool keep = dir == 0 ? (sl <= tl) : (sl >= tl); if (!keep) a[r] = 0.f; }
                }
                att[Jb] = a;
            }
        }
        if (probe_mode == 4) { asm volatile("" :: "v"(acc[0]), "v"(acc[7]), "v"(att[0]), "v"(att[1]), "v"(att[2]), "v"(att[3])); __syncthreads(); continue; }
        { const int q4 = tl >> 2, p4 = tl & 3;
#pragma unroll
            for (int pr = 0; pr < 2; ++pr) {
                const bool any = dir == 0 ? (2 * pr <= I) : (2 * pr + 1 >= I);
                if (any) {
                    const f32x4 a0 = att[2 * pr], a1 = att[2 * pr + 1];
                    const bf16x8 ab = pack8(a0[0], a0[1], a0[2], a0[3], a1[0], a1[1], a1[2], a1[3]);
                    const int r0 = 32 * pr + 4 * kg + q4, r1 = r0 + 16;
#pragma unroll
                    for (int eb = 0; eb < 8; ++eb) {
                        const s16x4 lo = tr_read((LAS const char*)(VT + r0 * 256 + ((((eb >> 1) ^ (r0 & 3)) << 6) | ((eb & 1) << 5) | (p4 << 3))));
                        const s16x4 hh = tr_read((LAS const char*)(VT + r1 * 256 + ((((eb >> 1) ^ (r1 & 3)) << 6) | ((eb & 1) << 5) | (p4 << 3))));
                        acc[eb] = MFMA16(cat8(lo, hh), ab, acc[eb]); }
                }
            }
        }
        __syncthreads();
        if (dir == 1) {
#pragma unroll
            for (int eb = 0; eb < 8; ++eb) *(LAS f32x4*)(CB + ((I * 16 + tl) * 128 + 16 * eb + 4 * kg)) = acc[eb];
        }
        __syncthreads();
        if (dir == 0) {
            float ss = 0.f;
#pragma unroll
            for (int eb = 0; eb < 8; ++eb) { acc[eb] = acc[eb] + *(const LAS f32x4*)(CB + ((I * 16 + tl) * 128 + 16 * eb + 4 * kg)); ss += (acc[eb][0] * acc[eb][0] + acc[eb][1] * acc[eb][1]) + (acc[eb][2] * acc[eb][2] + acc[eb][3] * acc[eb][3]); }
            ss += __shfl_xor(ss, 16); ss += __shfl_xor(ss, 32);
            const float rs = rsqrtf(ss * (1.f / 128.f) + RMS_EPS);
            f32x4 wvs[8];
#pragma unroll
            for (int eb = 0; eb < 8; ++eb) wvs[eb] = *(const GAS f32x4*)(hw + 16 * eb + 4 * kg);
#pragma unroll
            for (int eb = 0; eb < 8; ++eb) { const int e0 = 16 * eb + 4 * kg; const f32x4 wv = wvs[eb];
                const u32x2 gw = gwv[eb];
                u32x2 w; w.x = cvtpk(acc[eb][0] * rs * wv[0] * bflo(gw.x), acc[eb][1] * rs * wv[1] * bfhi(gw.x)); w.y = cvtpk(acc[eb][2] * rs * wv[2] * bflo(gw.y), acc[eb][3] * rs * wv[3] * bfhi(gw.y));
                *(GAS u32x2*)(OC + (size_t)(row0 + t) * 1536 + h * 128 + e0) = w; }
        }
        __syncthreads();
    }
}

#define R2_PROBE_NOROUTER 0
DI void ph_r2(LAS unsigned char* lds, const float* xin, const float* cin, float* XA, const float* XA2, bool do_route, const bf16* YO, unsigned char* H, const float* MODl, const float* ng, const float* wr, const float* br,
              unsigned* cnt, int* TOPE, float* GATE, int* RANK, int* WGB, int l, int nrows, int vcu, int G) {
    const int tid = tid_opaque(), lane = tid & 63, wave = __builtin_amdgcn_readfirstlane(tid >> 6);
    for (int i = tid; i < 1024 * 8; i += NTHR) { const int k = i >> 3, ch = i & 7, slot = ((k >> 8) * 4 + (k & 3)) * 64 + ((k >> 2) & 63);
        *(LAS f32x4*)(lds + slot * 128 + ((ch ^ (slot & 7)) << 4)) = *(const GAS f32x4*)(wr + k * 32 + ch * 4); }
    LAS unsigned* lcnt = (LAS unsigned*)(lds + 131072);
    if (tid < 32) lcnt[tid] = 0u;
    __syncthreads();
#define R2_XP(row_) ((l == 0) ? ((row_) < NLAT ? xin + (size_t)(row_) * 1024 : cin + (size_t)((row_) - NLAT) * 1024) : XA2 + (size_t)(row_) * 1024)
    const int rstep = G * NWAVES;
    int row = vcu * NWAVES + wave;
    f32x4 xn[4]; u32x2 yn[4];
    if (row < nrows) { row_ld(R2_XP(row), lane, xn);
#pragma unroll
        for (int j = 0; j < 4; ++j) yn[j] = ((const GAS u32x2*)(YO + (size_t)row * 1024))[lane + 64 * j]; }
    const int me = (lane >> 1) & 31;
    const float brv = br[me];
    for (; row < nrows; row += rstep) {
        const int mj = row < NLAT ? row / SEQ : 2; const float* md = MODl + mj * 6144;
        f32x4 x[4], y[4], g1[4], m2[4], gg[4], sh[4], sc[4];
#pragma unroll
        for (int j = 0; j < 4; ++j) { x[j] = xn[j]; y[j] = (f32x4){bflo(yn[j].x), bfhi(yn[j].x), bflo(yn[j].y), bfhi(yn[j].y)}; }
#pragma unroll
        for (int j = 0; j < 4; ++j) { g1[j] = ((const GAS f32x4*)(ng + 1024))[lane + 64 * j]; m2[j] = ((const GAS f32x4*)(md + 2048))[lane + 64 * j]; gg[j] = ((const GAS f32x4*)(ng + 2048))[lane + 64 * j];
            sh[j] = ((const GAS f32x4*)(md + 3 * 1024))[lane + 64 * j]; sc[j] = ((const GAS f32x4*)(md + 4 * 1024))[lane + 64 * j]; }
        { const int rn = row + rstep;
          if (rn < nrows) { row_ld(R2_XP(rn), lane, xn);
#pragma unroll
              for (int j = 0; j < 4; ++j) yn[j] = ((const GAS u32x2*)(YO + (size_t)rn * 1024))[lane + 64 * j]; } }
        const float ry = row_rstd(y);
#pragma unroll
        for (int j = 0; j < 4; ++j) x[j] = x[j] + m2[j] * (y[j] * ry * g1[j]);
        row_st(XA + (size_t)row * 1024, lane, x);
        f32x4 h[4];
        { const float r = row_rstd(x);
#pragma unroll
          for (int j = 0; j < 4; ++j) h[j] = x[j] * r * gg[j] * (sc[j] + 1.f) + sh[j]; }
        row_st_f8(H + (size_t)row * 1024, lane, h, F8_ACT);
        if (R2_PROBE_NOROUTER && !do_route) continue;
        float acc[32];
#pragma unroll
        for (int e = 0; e < 32; ++e) acc[e] = 0.f;
        f32x4 wA[8], wB[8];
#define R2_WLD(W, S) do { const int slot_ = (S) * 64 + lane; _Pragma("unroll") for (int ch = 0; ch < 8; ++ch) W[ch] = *(const LAS f32x4*)(lds + slot_ * 128 + ((ch ^ (slot_ & 7)) << 4)); } while (0)
#define R2_FMA(W, HV) do { const float hv_ = (HV); _Pragma("unroll") for (int ch = 0; ch < 8; ++ch) { acc[4 * ch] += hv_ * W[ch][0]; acc[4 * ch + 1] += hv_ * W[ch][1]; acc[4 * ch + 2] += hv_ * W[ch][2]; acc[4 * ch + 3] += hv_ * W[ch][3]; } } while (0)
        R2_WLD(wA, 0);
#pragma unroll
        for (int s2 = 0; s2 < 8; ++s2) {
            R2_WLD(wB, 2 * s2 + 1); R2_FMA(wA, h[(2 * s2) >> 2][(2 * s2) & 3]); __builtin_amdgcn_sched_barrier(0);
            if (s2 < 7) R2_WLD(wA, 2 * s2 + 2); R2_FMA(wB, h[(2 * s2 + 1) >> 2][(2 * s2 + 1) & 3]); __builtin_amdgcn_sched_barrier(0);
        }
#undef R2_WLD
#undef R2_FMA
#define R2_STEP(N, BIT) _Pragma("unroll") for (int i = 0; i < N; ++i) { const float lo = acc[i], hi = acc[i + N]; const bool up = (lane & BIT) != 0; const float keep = up ? hi : lo, send = up ? lo : hi; acc[i] = keep + __shfl_xor(send, BIT); }
        R2_STEP(16, 32) R2_STEP(8, 16) R2_STEP(4, 8) R2_STEP(2, 4) R2_STEP(1, 2)
#undef R2_STEP
        const float lg = acc[0] + __shfl_xor(acc[0], 1) + brv;
        const unsigned lb_ = __float_as_uint(lg);
        unsigned key = ((lb_ ^ (unsigned)(((int)lb_ >> 31) | 0x80000000)) & ~31u) | (unsigned)(31 - me);
        float tv[4]; int te[4];
#pragma unroll
        for (int k = 0; k < 4; ++k) {
            unsigned r = key;
            r = max(r, (unsigned)__builtin_amdgcn_update_dpp(0, (int)r, 0xB1, 0xF, 0xF, true));
            r = max(r, (unsigned)__builtin_amdgcn_update_dpp(0, (int)r, 0x4E, 0xF, 0xF, true));
            r = max(r, (unsigned)__builtin_amdgcn_update_dpp(0, (int)r, 0x141, 0xF, 0xF, true));
            r = max(r, (unsigned)__builtin_amdgcn_update_dpp(0, (int)r, 0x140, 0xF, 0xF, true));
            const unsigned r0 = (unsigned)__builtin_amdgcn_readlane((int)r, 0), r1 = (unsigned)__builtin_amdgcn_readlane((int)r, 16), r2 = (unsigned)__builtin_amdgcn_readlane((int)r, 32), r3 = (unsigned)__builtin_amdgcn_readlane((int)r, 48);
            const unsigned km = max(max(r0, r1), max(r2, r3));
            const int idx = 31 - (int)(km & 31u);
            te[k] = idx; tv[k] = __uint_as_float((unsigned)__builtin_amdgcn_readlane((int)lb_, 2 * idx));
            if (me == idx) key = 0u;
        }
        const float e1 = __expf(tv[1] - tv[0]), e2 = __expf(tv[2] - tv[0]), e3 = __expf(tv[3] - tv[0]), inv = 1.f / (1.f + e1 + e2 + e3);
        if (do_route && lane < 4) { const int ek = lane == 0 ? te[0] : lane == 1 ? te[1] : lane == 2 ? te[2] : te[3]; const float gk = (lane == 0 ? 1.f : lane == 1 ? e1 : lane == 2 ? e2 : e3) * inv;
            const unsigned rk = __hip_atomic_fetch_add(lcnt + ek, 1u, __ATOMIC_RELAXED, __HIP_MEMORY_SCOPE_WORKGROUP);
            TOPE[row * 4 + lane] = ek; GATE[row * 4 + lane] = gk; RANK[row * 4 + lane] = (int)rk; }
    }
#undef R2_XP
    __syncthreads();
    if (do_route && tid < 32) WGB[vcu * 32 + tid] = (int)atomicAdd(cnt + tid, lcnt[tid]);
    __syncthreads();
}
DI void moe_tables(volatile LAS int* tb, const unsigned* cnt) {
    const int tid = tid_opaque();
    if (tid < 32) tb[80 + tid] = (int)__hip_atomic_load(cnt + tid, __ATOMIC_RELAXED, __HIP_MEMORY_SCOPE_AGENT);
    __syncthreads();
    if (tid == 0) { int t = 0;
        for (int e = 0; e < 32; ++e) { const int c = tb[80 + e]; tb[e] = t; tb[40 + e] = t * 256; t += (c + 255) >> 8; }
        tb[32] = t; }
    __syncthreads();
}
DI void ph_r3(volatile LAS int* tb, const unsigned char* H, unsigned char* XG, const int* TOPE, const int* RANK, const int* WGB, int* DEST, int nrows, int vcu, int G) {
    const int lane = tid_opaque() & 63, wave = __builtin_amdgcn_readfirstlane(tid_opaque() >> 6);
    for (int row0 = (vcu * NWAVES + wave) * 4; row0 < nrows; row0 += G * NWAVES * 4) {
        v4u h0[4]; int ek[4], rk[4];
#pragma unroll
        for (int q = 0; q < 4; ++q) { h0[q] = ((const GAS v4u*)(H + (size_t)(row0 + q) * 1024))[lane]; ek[q] = TOPE[(row0 + q) * 4 + (lane & 3)]; rk[q] = RANK[(row0 + q) * 4 + (lane & 3)]; }
#pragma unroll
        for (int q = 0; q < 4; ++q) rk[q] += WGB[(((row0 + q) % (G * NWAVES)) / NWAVES) * 32 + ek[q]];
#pragma unroll
        for (int q = 0; q < 4; ++q) { const int dl = tb[40 + ek[q]] + rk[q];
            if (lane < 4) DEST[(row0 + q) * 4 + lane] = dl;
#pragma unroll
            for (int k = 0; k < 4; ++k) { const int d = __builtin_amdgcn_readlane(dl, k); ((GAS v4u*)(XG + (size_t)d * 1024))[lane] = h0[q]; } }
    }
}
DI void ph_r4(const float* XA, float* XA2, const bf16* YS, const int* DEST, const float* GATE, const float* MODl, const float* ng, float* out, unsigned char* H, bf16* HBn, const float* MODn, const float* ngn, bool last, int nrows, int vcu, int G) {
    const int lane = tid_opaque() & 63, wave = __builtin_amdgcn_readfirstlane(tid_opaque() >> 6);
    const int rstep = G * NWAVES * 2;
    int row0 = (vcu * NWAVES + wave) * 2;
    int dkn = 0, gkn = 0;
    if (row0 < nrows) { dkn = DEST[row0 * 4 + (lane & 7)]; gkn = __float_as_int(GATE[row0 * 4 + (lane & 7)]); }
    for (; row0 < nrows; row0 += rstep) {
        f32x4 f[2][4], x[2][4]; float gk[2][4]; u32x2 yr[2][4][4];
        const int mj = row0 < NLAT ? row0 / SEQ : 2; const float* md = MODl + mj * 6144;
#pragma unroll
        for (int q = 0; q < 2; ++q) {
#pragma unroll
            for (int k = 0; k < 4; ++k) { gk[q][k] = __int_as_float(__builtin_amdgcn_readlane(gkn, 4 * q + k)); const int d_ = __builtin_amdgcn_readlane(dkn, 4 * q + k);
#pragma unroll
                for (int j = 0; j < 4; ++j) yr[q][k][j] = ((const GAS u32x2*)(YS + (size_t)d_ * 1024))[lane + 64 * j]; }
            row_ld(XA + (size_t)(row0 + q) * 1024, lane, x[q]); }
        f32x4 g3[4], m5[4], gg[4], sh[4], sc[4];
#pragma unroll
        for (int j = 0; j < 4; ++j) { g3[j] = ((const GAS f32x4*)(ng + 3 * 1024))[lane + 64 * j]; m5[j] = ((const GAS f32x4*)(md + 5 * 1024))[lane + 64 * j]; }
        if (!last) {
#pragma unroll
            for (int j = 0; j < 4; ++j) { gg[j] = ((const GAS f32x4*)ngn)[lane + 64 * j]; sh[j] = ((const GAS f32x4*)(MODn + mj * 6144))[lane + 64 * j]; sc[j] = ((const GAS f32x4*)(MODn + mj * 6144 + 1024))[lane + 64 * j]; } }
        { const int rn = row0 + rstep;
          if (rn < nrows) { dkn = DEST[rn * 4 + (lane & 7)]; gkn = __float_as_int(GATE[rn * 4 + (lane & 7)]); } }
#pragma unroll
        for (int q = 0; q < 2; ++q) {
#pragma unroll
            for (int j = 0; j < 4; ++j) f[q][j] = (f32x4){0.f, 0.f, 0.f, 0.f};
#pragma unroll
            for (int k = 0; k < 4; ++k)
#pragma unroll
                for (int j = 0; j < 4; ++j) { const u32x2 w = yr[q][k][j]; f[q][j] = f[q][j] + (f32x4){bflo(w.x), bfhi(w.x), bflo(w.y), bfhi(w.y)} * gk[q][k]; } }
#pragma unroll
        for (int q = 0; q < 2; ++q) { const int row = row0 + q;
            const float rf = row_rstd(f[q]);
#pragma unroll
            for (int j = 0; j < 4; ++j) x[q][j] = x[q][j] + m5[j] * (f[q][j] * rf * g3[j]);
            if (last) row_st(out + (size_t)row * 1024, lane, x[q]);
            else { row_st(XA2 + (size_t)row * 1024, lane, x[q]);
                f32x4 h[4]; const float r = row_rstd(x[q]);
#pragma unroll
                for (int j = 0; j < 4; ++j) h[j] = x[q][j] * r * gg[j] * (sc[j] + 1.f) + sh[j];
                if (INP_FP8 || INP_L1_FP8) row_st_f8(H + (size_t)row * 1024, lane, h, F8_ACT); if (!INP_FP8 && !INP_L1_FP8) row_st_bf(HBn + (size_t)row * 1024, lane, h); } }
    }
}

template <int K, bool MERGE> DI void ctx_strip(LAS unsigned char* lds, const bf16* A, int lda, const bf16* Wt, bf16* O, const bf16* Pg, int vcu, int G) {
    const int tid = tid_opaque(), lane = tid & 63, wave = __builtin_amdgcn_readfirstlane(tid >> 6), r16 = lane & 15, kg = lane >> 4;
    constexpr int CH = K / 8;
    for (int blk0 = vcu * NWAVES; blk0 < (NCTX / 16) * 64; blk0 += G * NWAVES) {
        const int blk = blk0 + wave, row0 = NLAT + (blk0 >> 6) * 16, col0 = (blk & 63) * 16;
#pragma unroll
        for (int i = 0; i < 16 * CH / NTHR; ++i) { const int p_ = i * NTHR + tid, r_ = p_ / CH, c_ = (p_ % CH) ^ r_;
            glds16(A + (size_t)(row0 + r_) * lda + c_ * 8, lds + (size_t)(i * NTHR + wave * 64) * 16); }
        const bf16* bp = Wt + (size_t)(col0 + r16) * K + 8 * kg;
        f32x4 acc = (f32x4){0.f, 0.f, 0.f, 0.f}, y = acc;
        bf16x8 bA[16], bB[16];
#define CS_LD(B, K0) _Pragma("unroll") for (int s = 0; s < 16; ++s) B[s] = *(const GAS bf16x8*)(bp + (K0) + 32 * s);
#define CS_BATCH(B, K0) do { float g[4]; \
            if (MERGE) { _Pragma("unroll") for (int j = 0; j < 4; ++j) g[j] = bf2f(*(const GAS unsigned short*)((const unsigned short*)Pg + (size_t)(row0 + 4 * kg + j) * INW + C_GT + ((K0) / 512) * 1024 + col0 + r16)); } \
            _Pragma("unroll") for (int s = 0; s < 16; ++s) { const bf16x8 a = *(const LAS bf16x8*)(lds + (size_t)(r16 * CH + (((K0) / 8 + 4 * s + kg) ^ r16)) * 16); acc = MFMA16(a, B[s], acc); } \
            if (MERGE) { _Pragma("unroll") for (int j = 0; j < 4; ++j) { y[j] += g[j] * acc[j]; acc[j] = 0.f; } } } while (0)
        CS_LD(bA, 0) CS_LD(bB, 512)
        asm volatile("s_waitcnt vmcnt(0)" ::: "memory");
        __syncthreads();
        CS_BATCH(bA, 0);
        if (K > 1024) { CS_LD(bA, 1024) }
        CS_BATCH(bB, 512);
        if (K > 1024) CS_BATCH(bA, 1024);
#undef CS_LD
#undef CS_BATCH
#pragma unroll
        for (int j = 0; j < 4; ++j) *(GAS unsigned short*)((unsigned short*)O + (size_t)(row0 + 4 * kg + j) * 1024 + col0 + r16) = (unsigned short)f2bf(MERGE ? y[j] : acc[j]);
        __syncthreads();
    }
}

#define PROF_MASK 0
#define AB_PROBE -1
#define GEMM_PROBE 0
#define HG3_PROBE 0
#define TS_SEL -1
#define TSB(id) do { if (TS_SEL == (id) && bx == 0 && tid_opaque() == 0) tsum -= (long long)rt(); } while (0)
#define TSE(id) do { if (TS_SEL == (id) && bx == 0 && tid_opaque() == 0) tsum += (long long)rt(); } while (0)
#define REP(bit) for (int rep_ = 0; rep_ < (((PROF_MASK) >> (bit)) & 1 ? 2 : 1); ++rep_)
#ifndef PHM
#define PHM 0x7fff
#endif
struct Args { const float* in[21]; float* out; unsigned char* ws; };
__global__ void __launch_bounds__(NTHR, 2) fwd_mega(Args a) {
    extern __shared__ __attribute__((aligned(16))) unsigned char lds_raw[];
    LAS unsigned char* lds = (LAS unsigned char*)lds_raw;
    volatile LAS unsigned* MISC = (volatile LAS unsigned*)(lds + MISC_OFF);
    volatile LAS int* MTB = (volatile LAS int*)(lds + MISC_OFF + 256);
    const int G = gridDim.x, bx = blockIdx.x, vcu = (G % 8 == 0) ? (bx % 8) * (G / 8) + bx / 8 : bx;
#define AS4 __attribute__((address_space(4)))
#define KARGS() ({ const AS4 char* kp_ = (const AS4 char*)__builtin_amdgcn_kernarg_segment_ptr(); asm volatile("" : "+s"(kp_)); kp_; })
#define IN(i) (*(const float* const AS4*)(KARGS() + 8 * (i)))
#define WSB() (*(unsigned char* const AS4*)(KARGS() + 176))
#define OUTP() (*(float* const AS4*)(KARGS() + 168))
#define ctl ((gu32*)(WSB() + WS_CTL))
#define SM ((float*)(WSB() + WS_SMALL))
#define WIN ((bf16*)(WSB() + WS_WIN))
#define WIN8 ((bf16*)(WSB() + WS_WIN8))
#define VTB ((unsigned char*)(WSB() + WS_WIN8))
#define QK8B ((unsigned char*)(WSB() + WS_QK8))
#define WIN8L ((unsigned char*)(WSB() + WS_WIN8L))
#define WINB ((bf16*)(WSB() + WS_WIN + 16 * MiB))
#define WBR ((bf16*)(WSB() + WS_WBR))
#define WO ((bf16*)(WSB() + WS_WO))
#define WGU ((bf16*)(WSB() + WS_WGU))
#define WDN ((bf16*)(WSB() + WS_WDN))
#define XA ((float*)(WSB() + WS_XA))
#define XA2 ((float*)(WSB() + WS_XA2))
#define H ((unsigned char*)(WSB() + WS_YF))
#define HB ((bf16*)(WSB() + WS_H))
#define P ((bf16*)(WSB() + WS_P))
#define LF ((float*)(WSB() + WS_LF))
#define O3 ((bf16*)(WSB() + WS_O3))
#define HU ((bf16*)(WSB() + WS_HU))
#define HD ((float*)(WSB() + WS_HD))
#define HS ((bf16*)(WSB() + WS_HS))
#define Y ((bf16*)(WSB() + WS_Y))
#define YO ((bf16*)(WSB() + WS_YO))
#define TOPE ((int*)(WSB() + WS_ROUTE))
#define GATE ((float*)(WSB() + WS_ROUTE + 524288 * 1))
#define RANK ((int*)(WSB() + WS_ROUTE + 524288 * 2))
#define DEST ((int*)(WSB() + WS_ROUTE + 524288 * 3))
#define WGBASE ((int*)(WSB() + WS_ROUTE + 524288 * 3 + 393216))
#define XG ((unsigned char*)(WSB() + WS_XG))
#define ACT ((unsigned char*)(WSB() + WS_ACT))
#define YS ((bf16*)(WSB() + WS_YS))
#define x_in IN(0)
#define c_in IN(1)
#define ctx_in IN(2)
#define cctx_in IN(3)

    for (int u = tid_opaque(); u < (LDS_BYTES - LDSCTL_OFF) / 4; u += NTHR) ((LAS unsigned*)(lds + LDSCTL_OFF))[u] = 0u;
    __syncthreads();
    XcdBarrier bar = xcd_barrier_post((unsigned*)(ctl + CW_BAR), MISC + 8);
long long tsum = 0;
#define GRID_BAR() do { TSB(30); XcdBarrier b_; b_.bar = (unsigned*)(ctl + CW_BAR); b_.x = xb_xcc_id(); b_.st = MISC + 8; xcd_barrier(b_); TSE(30); } while (0)

    REP(0) if (PHM & 1) ph_mod(lds, c_in, cctx_in, IN(4), IN(5), SM + SM_MOD, vcu, G);
    if (PHM & 1) ph_tables(SM, IN(11), IN(9), vcu, G);
    GRID_BAR();
    REP(1) if (PHM & 2) {
        const int lane = tid_opaque() & 63, wave = __builtin_amdgcn_readfirstlane(tid_opaque() >> 6);
        LAS float* scr = (LAS float*)(lds + wave * 16896);
        const int gw = vcu * NWAVES + wave, NGW = G * NWAVES;
        const TGroup g0{IN(7), WIN, 1024, INW, INP_L0_FP8 ? 0 : (INP_L1_FP8 ? 1 : 2), 0, 1, INP_FP8, 0}, g1{IN(13), WBR, 512, 1024, 6, 0, 3, 0, 0}, g2{IN(14), WO, 1024, 1024, 2, 0, 1, 0, 0}, g3{IN(17), WGU, 1024, 2048, 64, 1, 1, 1, 0}, g4{IN(19), WDN, 1024, 1024, 64, 0, 1, 1, 0}, g5{IN(7) + (INP_L0_FP8 ? (size_t)0 : (size_t)1024 * INW), (bf16*)(WIN8L + (INP_L0_FP8 ? (size_t)0 : (size_t)INW * 1024)), 1024, INW, (INP_L0_FP8 && !TX_INTERLEAVE) ? 2 : 1, 0, 1, 1, 0};
        const int total = (INP_L0_FP8 ? (TX_INTERLEAVE ? 1 : 2) * 8 * 248 : (INP_L1_FP8 ? 16 * 248 + 8 * 248 : 2 * 16 * 248)) + (TX_INTERLEAVE ? 0 : 6 * 8 * 32 + 2 * 16 * 32 + 64 * 8 * 64 + 64 * 8 * 32);
#if TX_INTERLEAVE
#define P0_DEC(it_, t_) do { int r_ = (it_); if (!p0_decodeX(g0, r_, t_)) p0_decodeX(g5, r_, t_); } while (0)
#else
#define P0_DEC(it_, t_) do { int r_ = (it_); if (!p0_decodeX(g0, r_, t_)) if (!p0_decodeX(g1, r_, t_)) if (!p0_decodeX(g2, r_, t_)) if (!p0_decodeX(g3, r_, t_)) if (!p0_decodeX(g4, r_, t_)) p0_decodeX(g5, r_, t_); } while (0)
#endif
        {
            f32x4 wv[16]; TItem tc, tn;
            int it = gw;
            if (it < total) { P0_DEC(it, tc); p0_item_loadX(tc, lane, wv); }
            while (it < total) {
                p0_item_to_ldsX(tc, scr, lane, wv);
                const int itn = it + NGW;
                if (itn < total) { P0_DEC(itn, tn); p0_item_loadX(tn, lane, wv); }
                LDS_WAIT(); asm volatile("" ::: "memory");
                p0_item_storeX(tc, scr, lane);
                LDS_WAIT(); asm volatile("" ::: "memory");
                tc = tn; it = itn;
            }
        }
        const float* ng = IN(6);
        for (int row = gw; row < NTOK; row += NGW) { const int mj = row < NLAT ? row / SEQ : 2; const float* md = SM + SM_MOD + mj * 6144;
            const float* xp = row < NLAT ? x_in + (size_t)row * 1024 : ctx_in + (size_t)(row - NLAT) * 1024;
            f32x4 x[4], h[4]; row_ld(xp, lane, x); row_modulate(x, ng, md, md + 1024, lane, h); if (INP_FP8 || INP_L0_FP8) row_st_f8(H + (size_t)row * 1024, lane, h, F8_ACT); else row_st_bf(HB + (size_t)row * 1024, lane, h); }
    }
    GRID_BAR();

    for (int l = 0; l < DEPTH; ++l) {
        const bool last = (l == DEPTH - 1);
        const float* MODl = SM + SM_MOD + l * 3 * 6144;
        const float* ng = IN(6) + l * 4096;
        const int nrows = last ? NLAT : NTOK;
#if INP_L1_FP8
        if (l == 1 || INP_L0_FP8) { REP(2) if (PHM & 4) {
          pg8::Gemm g{(const bf16*)H, (const bf16*)(WIN8L + (size_t)l * INW * 1024), NTOK, INW, 1024};
          SubOrder S; S.base.init(NTOK, INW - 512, G, bx); S.skip_from = C_BV / 256; S.skip_n = 2;
          EpiIn E{P, LF, SM + SM_TAB, SM + SM_LB + l * 1024, 0, 1.f / (F8_ACT * F8_W), QK8B};
          pg8::gemm_phase<EpiIn, SubOrder, true, true, 1>(lds, g, S, E);
          { pg8::Gemm gv{(const bf16*)(WIN8L + ((size_t)l * INW + C_BV) * 1024), (const bf16*)H, 512, NTOK, 1024}; pg8::StaticOrder SV; const int sh_ = (66 * 29) % G; SV.init(512, NTOK, G, (bx + G - sh_) % G);
            EpiVT EV{VTB, F8_V / (F8_ACT * F8_W)};
            pg8::gemm_phase<EpiVT, pg8::StaticOrder, true, true, 1>(lds, gv, SV, EV); } } } else
#endif
        REP(2) if (PHM & 4) {
          pg8::Gemm g{INP_FP8 ? (const bf16*)H : (const bf16*)HB, INP_FP8 ? (const bf16*)((const unsigned char*)WIN + (size_t)l * INW * 1024) : (const bf16*)(WIN + (size_t)l * INW * 1024), NTOK, INW, 1024};
#if AB_F8PV
          SubOrder S; S.base.init(NTOK, INW - 512, G, bx); S.skip_from = C_BV / 256; S.skip_n = 2;
          EpiIn E{P, LF, SM + SM_TAB, SM + SM_LB + l * 1024, 0, 1.f, QK8B};
          pg8::gemm_phase<EpiIn, SubOrder, true, true, 2>(lds, g, S, E);
          { pg8::Gemm gv{(const bf16*)(WIN + ((size_t)l * INW + C_BV) * 1024), (const bf16*)HB, 512, NTOK, 1024}; pg8::StaticOrder SV; const int sh_ = (66 * 29) % G; SV.init(512, NTOK, G, (bx + G - sh_) % G);
            EpiVT EV{VTB, F8_V};
            pg8::gemm_phase<EpiVT, pg8::StaticOrder, true, true, 2>(lds, gv, SV, EV); } }
#else
          pg8::StaticOrder S; S.init(NTOK, INW, G, bx);
          EpiIn E{P, LF, SM + SM_TAB, SM + SM_LB + l * 1024, 0, INP_FP8 ? 1.f / (F8_ACT * F8_W) : 1.f};
          pg8::gemm_phase<EpiIn, pg8::StaticOrder, true, true, INP_FP8 ? 1 : 2>(lds, g, S, E); }
#endif
#if GEMM_PROBE == 7 || GEMM_PROBE == 8 || GEMM_PROBE == 9
        { pg8::Gemm g{(const bf16*)HB, (const bf16*)(WIN + (size_t)l * INW * 1024), NTOK, INW, 1024}; pg8::StaticOrder S; S.init(NTOK, INW, G, bx);
          EpiInT<GEMM_PROBE - 7> E{(bf16*)(WSB() + WS_HU), (float*)(WSB() + WS_HU + 256 * MiB), SM + SM_TAB, SM + SM_LB + l * 1024, 0, 1.f};
          pg8::gemm_phase<EpiInT<GEMM_PROBE - 7>, pg8::StaticOrder, true, true, 2>(lds, g, S, E); }
#endif
#if GEMM_PROBE == 1
        { pg8::Gemm g{(const bf16*)HB, (const bf16*)(WIN + (size_t)l * INW * 1024), NTOK, INW, 1024}; pg8::StaticOrder S; S.init(NTOK, INW, G, bx); EpiNull E{(float*)(WSB() + WS_YF)};
          pg8::gemm_phase<EpiNull, pg8::StaticOrder, true, true, 2>(lds, g, S, E); }
#endif
        GRID_BAR();
        REP(3) if (PHM & 8) ph_hg1(lds, P, LF, HU, HD, vcu, G);
        REP(4) if (PHM & 16) ph_attn_a(lds, P, O3, IN(8) + l * 8, !last, vcu, G);
        REP(5) if (PHM & 32) ph_attn_b<0>(lds, P, VTB, QK8B, O3 + 512, IN(10) + l * 128, SM[SM_LAM + l], SM[SM_LAM + 2 + l], !last, vcu, G, TX_INTERLEAVE && rep_ == 0, l);
#if AB_PROBE >= 0
        ph_attn_b<AB_PROBE>(lds, P, VTB, QK8B, (bf16*)(WSB() + WS_YF), IN(10) + l * 128, SM[SM_LAM + l], SM[SM_LAM + 2 + l], !last, vcu, G);
#endif
        GRID_BAR();
        REP(6) if (PHM & 64) ph_hg2(HU, HD, HS, vcu, G);
        GRID_BAR();
        REP(7) if (PHM & 128) ph_hg3(lds, P, LF, HS, O3 + 1024, IN(12) + l * 128, !last, vcu, G, (HG3_PROBE && rep_ == 0) ? HG3_PROBE : 0);
        GRID_BAR();
        REP(8) if (PHM & 256) { if (!last) ctx_strip<1536, true>(lds, O3, 1536, WBR + (size_t)l * 3 * 1024 * 512, Y, P, vcu, G);
          pg8::Gemm g{O3, WBR + (size_t)l * 3 * 1024 * 512, NLAT, 1024, 1536}; pg8::StaticOrder S; S.init(NLAT, 1024, G, bx);
          EpiMerge E{P, Y};
          pg8::gemm_phase<EpiMerge, pg8::StaticOrder, true, true>(lds, g, S, E); }
        GRID_BAR();
#if GEMM_PROBE == 10
        { pg8::Gemm g{O3, WBR + (size_t)l * 3 * 1024 * 512, nrows, 1024, 1536}; pg8::StaticOrder S; S.init(nrows, 1024, G, bx); EpiNull E{(float*)(WSB() + WS_YF)};
          pg8::gemm_phase<EpiNull, pg8::StaticOrder, true, true, 2>(lds, g, S, E); }
#endif
        REP(9) if (PHM & 512) { if (!last) ctx_strip<1024, false>(lds, Y, 1024, WO + (size_t)l * 1024 * 1024, YO, nullptr, vcu, G);
          pg8::Gemm g{Y, WO + (size_t)l * 1024 * 1024, NLAT, 1024, 1024}; pg8::StaticOrder S; S.init(NLAT, 1024, G, bx);
          EpiPlain E{YO, 1024, nullptr, 4, 1.f};
          pg8::gemm_phase<EpiPlain, pg8::StaticOrder, true, true>(lds, g, S, E); }
        GRID_BAR();
        unsigned* cnt = (unsigned*)(ctl + CW_CNT) + l * 32;
        TSB(20); REP(10) if (PHM & 1024) ph_r2(lds, x_in, ctx_in, XA, XA2, rep_ == ((PROF_MASK >> 10) & 1), YO, H, MODl, ng, IN(15) + l * 32768, IN(16) + l * 32, cnt, TOPE, GATE, RANK, WGBASE, l, nrows, vcu, G);
        GRID_BAR(); TSE(20);
        moe_tables(MTB, cnt);
        REP(11) if (PHM & 2048) ph_r3(MTB, H, XG, TOPE, RANK, WGBASE, DEST, nrows, vcu, G);
        GRID_BAR();
        REP(12) if (PHM & 4096) { pg8::Gemm g{(const bf16*)XG, (const bf16*)((const unsigned char*)WGU + (size_t)l * 32 * 2048 * 1024), XG_ROWS, 32 * 2048, 1024}; MoeOrder S{MTB, 8, G, vcu};
          EpiSwiglu E{ACT, IN(18) + (size_t)l * 32 * 2048};
          pg8::gemm_phase<EpiSwiglu, MoeOrder, true, true, 1>(lds, g, S, E); }
#if GEMM_PROBE == 3
        { pg8::Gemm g{(const bf16*)XG, (const bf16*)((const unsigned char*)WGU + (size_t)l * 32 * 2048 * 1024), XG_ROWS, 32 * 2048, 1024}; MoeOrder S{MTB, 8, G, vcu}; EpiNull E{(float*)(WSB() + WS_YO)};
          pg8::gemm_phase<EpiNull, MoeOrder, true, true, 1>(lds, g, S, E); }
#endif
#if GEMM_PROBE == 4 || GEMM_PROBE == 5 || GEMM_PROBE == 6
        { pg8::Gemm g{(const bf16*)XG, (const bf16*)((const unsigned char*)WGU + (size_t)l * 32 * 2048 * 1024), XG_ROWS, 32 * 2048, 1024}; MoeOrder S{MTB, 8, G, vcu};
          EpiSwigluT<GEMM_PROBE - 4> E{(unsigned char*)(WSB() + WS_YS), IN(18) + (size_t)l * 32 * 2048};
          pg8::gemm_phase<EpiSwigluT<GEMM_PROBE - 4>, MoeOrder, true, true, 1>(lds, g, S, E); }
#endif
        GRID_BAR();
        REP(13) if (PHM & 8192) { pg8::Gemm g{(const bf16*)ACT, (const bf16*)((const unsigned char*)WDN + (size_t)l * 32 * 1024 * 1024), XG_ROWS, 32 * 1024, 1024}; MoeOrder S{MTB, 4, G, vcu};
          EpiPlain E{YS, 1024, IN(20) + (size_t)l * 32 * 1024, 4, 1.f / (F8_MID * F8_W)};
          pg8::gemm_phase<EpiPlain, MoeOrder, true, true, 1>(lds, g, S, E); }
        GRID_BAR();
#if GEMM_PROBE == 11
        { pg8::Gemm g{(const bf16*)ACT, (const bf16*)((const unsigned char*)WDN + (size_t)l * 32 * 1024 * 1024), XG_ROWS, 32 * 1024, 1024}; MoeOrder S{MTB, 4, G, vcu}; EpiNull E{(float*)(WSB() + WS_YO)};
          pg8::gemm_phase<EpiNull, MoeOrder, true, true, 1>(lds, g, S, E); }
#endif
        TSB(21); REP(14) if (PHM & 16384) ph_r4(XA, XA2, YS, DEST, GATE, MODl, ng, OUTP(), H, HB, SM + SM_MOD + (l + 1 < DEPTH ? (l + 1) * 3 * 6144 : 0), IN(6) + (l + 1 < DEPTH ? (l + 1) * 4096 : 0), last, nrows, vcu, G);
        if (!last) GRID_BAR();
        TSE(21);
        REP(15) for (int k_ = 0; k_ < (rep_ ? 10 : 0); ++k_) xcd_barrier(bar);
    }
    if (TS_SEL >= 0) {
        if (bx == 0 && tid_opaque() == 0) SM[SM_LAM + 8] = (float)tsum * 0.01f;
        xcd_barrier(bar);
        const float sc = 1.f + sqrtf(SM[SM_LAM + 8] * 1e-4f);
        for (int i = bx * NTHR + tid_opaque(); i < NLAT * DM; i += G * NTHR) OUTP()[i] *= sc;
    }
    if (__hip_atomic_load((gu32*)((unsigned*)(ctl + CW_BAR) + XB_TMO), RLX_AGENT) != 0u) { if (bx == 0) for (int i = tid_opaque(); i < 4096; i += NTHR) OUTP()[i] = __builtin_nanf(""); }
}

#undef ctl
#undef WGBASE
#undef SM
#undef WIN
#undef WIN8
#undef VTB
#undef QK8B
#undef WIN8L
#undef WINB
#undef WBR
#undef WO
#undef WGU
#undef WDN
#undef XA
#undef XA2
#undef H
#undef HB
#undef P
#undef LF
#undef O3
#undef HU
#undef HD
#undef HS
#undef Y
#undef YO
#undef TOPE
#undef GATE
#undef RANK
#undef DEST
#undef XG
#undef ACT
#undef YS
#undef x_in
#undef c_in
#undef ctx_in
#undef cctx_in
extern "C" void kernel_launch(void* const* d_in, const int* in_sizes, int n_in, void* d_out, int out_size, void* d_ws, size_t ws_size, hipStream_t stream) {
    static int grid = 0;
    if (grid == 0) {
        if (n_in != 21 || out_size != NLAT * DM || ws_size < WS_END) { fprintf(stderr, "kernel_launch: unexpected shapes (n_in %d, out %d, ws %zu)\n", n_in, out_size, ws_size); grid = -1; return; }
        int dev = 0, cus = 0, per_cu = 0;
        if (hipGetDevice(&dev) != hipSuccess || hipDeviceGetAttribute(&cus, hipDeviceAttributeMultiprocessorCount, dev) != hipSuccess) { grid = -1; return; }
        if (hipFuncSetAttribute((const void*)fwd_mega, hipFuncAttributeMaxDynamicSharedMemorySize, LDS_BYTES) != hipSuccess) { fprintf(stderr, "kernel_launch: hipFuncSetAttribute failed\n"); grid = -1; return; }
        if (hipOccupancyMaxActiveBlocksPerMultiprocessor(&per_cu, (const void*)fwd_mega, NTHR, LDS_BYTES) != hipSuccess || per_cu < 1) { fprintf(stderr, "kernel_launch: occupancy query reports %d\n", per_cu); per_cu = 1; }
        (void)hipGetLastError();
        grid = cus;
    }
    if (grid < 0) return;
    (void)hipMemsetAsync((char*)d_ws + WS_CTL, 0, CTL_ZERO_BYTES, stream);
    Args a{};
    for (int i = 0; i < 21; ++i) a.in[i] = (const float*)d_in[i];
    a.out = (float*)d_out; a.ws = (unsigned char*)d_ws;
    hipLaunchKernelGGL(fwd_mega, dim3(grid), dim3(NTHR), LDS_BYTES, stream, a);
}
```
